# Optimizing an MI355X kernel written in HIP

```python
import jax
import jax.numpy as jnp
from jax import lax
import numpy as np

D_MODEL = 2048
BATCH = 4
SEQ = 4096
DEPTH = 2

D_MIX = D_MODEL
N_MIXERS = 4
D_GROUP = D_MIX // N_MIXERS
N_IN_SLICES = 11
D_IN = N_IN_SLICES * D_GROUP
ATT_HEADS = 4
ATT_HEAD_DIM = D_GROUP // ATT_HEADS
MOBA_BLOCK = 256
MOBA_TOPK = 3
MOBA_Q_CHUNK = 64
MASK_VALUE = -1e30
RG_BLOCKS = 4
RG_BLOCK_DIM = D_GROUP // RG_BLOCKS
RG_CONV = 4
RG_C = 8.0
RG_A_MIN = 0.9
RG_A_MAX = 0.999
CV_WIDTH = 31
CV_GROUPS = 4
HG_HEADS = 4
HG_HEAD_DIM = D_GROUP // HG_HEADS
HG_CHUNK = 64
D_FF = 5632
LN_EPS = 1e-5
ALPHA = (2 * DEPTH) ** 0.25
BETA = (8 * DEPTH) ** -0.25

kernel_name = 'hybrid_moba_rglru_conformer_hgrn2_block'


def _standardize(x):
    x32 = x.astype(jnp.float32)
    mu = jnp.mean(x32, axis=-1, keepdims=True)
    var = jnp.mean(jnp.square(x32 - mu), axis=-1, keepdims=True)
    return (x32 - mu) * lax.rsqrt(var + LN_EPS)


def layer_norm(x, g, b):
    return (_standardize(x) * g + b).astype(x.dtype)


def swiglu(x, w_gate, w_up, w_down):
    return (jax.nn.silu(x @ w_gate) * (x @ w_up)) @ w_down


def causal_depthwise_conv(x, w, b):
    width, ch = w.shape
    y = lax.conv_general_dilated(
        x, w[:, None, :].astype(x.dtype), window_strides=(1,), padding=[(width - 1, 0)],
        dimension_numbers=('NWC', 'WIO', 'NWC'), feature_group_count=ch)
    return y + b


def split_heads(t, n_heads):
    bsz, seq, width = t.shape
    return t.reshape(bsz, seq, n_heads, width // n_heads)


def moba_attention(q, k, v):
    bsz, seq, nh, dh = q.shape
    nb = -(-seq // MOBA_BLOCK)
    s_pad = nb * MOBA_BLOCK
    pad = ((0, 0), (0, s_pad - seq), (0, 0), (0, 0))
    q, k, v = [jnp.pad(t, pad).transpose(0, 2, 1, 3) for t in (q, k, v)]
    kb = k.reshape(bsz, nh, nb, MOBA_BLOCK, dh)
    vb = v.reshape(bsz, nh, nb, MOBA_BLOCK, dh)
    k_mean = jnp.mean(kb, axis=3)
    topk = min(MOBA_TOPK, nb - 1)
    n_chunks = s_pad // MOBA_Q_CHUNK
    q_chunks = q.reshape(bsz, nh, n_chunks, MOBA_Q_CHUNK, dh).transpose(2, 0, 1, 3, 4)
    scale = dh ** -0.5
    b_idx = jnp.arange(bsz)[:, None, None, None]
    h_idx = jnp.arange(nh)[None, :, None, None]

    def one_chunk(args):
        c, q_c = args
        q_pos = c * MOBA_Q_CHUNK + jnp.arange(MOBA_Q_CHUNK)
        blk = (c * MOBA_Q_CHUNK) // MOBA_BLOCK
        k_own = lax.dynamic_index_in_dim(kb, blk, axis=2, keepdims=False)
        v_own = lax.dynamic_index_in_dim(vb, blk, axis=2, keepdims=False)
        k_pos = blk * MOBA_BLOCK + jnp.arange(MOBA_BLOCK)
        s_own = jnp.einsum('bhqd,bhkd->bhqk', q_c, k_own) * scale
        s_own = jnp.where(k_pos[None, :] <= q_pos[:, None], s_own, MASK_VALUE)
        if topk == 0:
            p_own = jax.nn.softmax(s_own.astype(jnp.float32), axis=-1)
            return jnp.einsum('bhqk,bhkd->bhqd', p_own, v_own)
        gate = jnp.einsum('bhqd,bhnd->bhqn', q_c, k_mean)
        gate = jnp.where(jnp.arange(nb) < blk, gate, MASK_VALUE)
        _, idx = lax.top_k(gate, topk)
        valid = idx < blk
        k_sel = kb[b_idx, h_idx, idx]
        v_sel = vb[b_idx, h_idx, idx]
        s_sel = jnp.einsum('bhqd,bhqnkd->bhqnk', q_c, k_sel) * scale
        s_sel = jnp.where(valid[..., None], s_sel, MASK_VALUE)
        s_all = jnp.concatenate(
            [s_own, s_sel.reshape(bsz, nh, MOBA_Q_CHUNK, topk * MOBA_BLOCK)], axis=-1)
        p = jax.nn.softmax(s_all.astype(jnp.float32), axis=-1)
        p_own = p[..., :MOBA_BLOCK]
        p_sel = p[..., MOBA_BLOCK:].reshape(bsz, nh, MOBA_Q_CHUNK, topk, MOBA_BLOCK)
        return (jnp.einsum('bhqk,bhkd->bhqd', p_own, v_own)
                + jnp.einsum('bhqnk,bhqnkd->bhqd', p_sel, v_sel))

    out = lax.map(one_chunk, (jnp.arange(n_chunks), q_chunks))
    out = out.transpose(1, 0, 3, 2, 4).reshape(bsz, s_pad, nh * dh)
    return out[:, :seq]


def _linear_recurrence_combine(left, right):
    a_l, b_l = left
    a_r, b_r = right
    return a_l * a_r, a_r * b_l + b_r


def rglru_mixer(gate_in, x_in, conv_w, conv_b, w_a, b_a, w_x, b_x, lam):
    bsz, seq, _ = x_in.shape
    xc = causal_depthwise_conv(x_in, conv_w, conv_b)
    xb = xc.reshape(bsz, seq, RG_BLOCKS, RG_BLOCK_DIM)
    r = jax.nn.sigmoid(jnp.einsum('bsgi,gio->bsgo', xb, w_a).reshape(bsz, seq, D_GROUP) + b_a)
    i = jax.nn.sigmoid(jnp.einsum('bsgi,gio->bsgo', xb, w_x).reshape(bsz, seq, D_GROUP) + b_x)
    log_a = -RG_C * r * jax.nn.softplus(-lam)
    a = jnp.exp(log_a)
    u = jnp.sqrt(jnp.maximum(-jnp.expm1(2.0 * log_a), 0.0)) * (i * xc)
    _, h = lax.associative_scan(_linear_recurrence_combine, (a, u), axis=1)
    return h * jax.nn.gelu(gate_in, approximate=True)


def conformer_conv_mixer(val, gate, conv_w, conv_b, norm_g, norm_b):
    bsz, seq, _ = val.shape
    u = causal_depthwise_conv(val * jax.nn.sigmoid(gate), conv_w, conv_b)
    u = _standardize(u.reshape(bsz, seq, CV_GROUPS, D_GROUP // CV_GROUPS)).reshape(bsz, seq, D_GROUP)
    return jax.nn.silu(u * norm_g + norm_b)


def hgrn2_mixer(q, f_logit, v, g, lb, norm_g):
    bsz, seq, _ = q.shape
    nc = seq // HG_CHUNK
    sig = jax.nn.sigmoid(f_logit)
    log_f = jnp.log(lb + (1.0 - lb) * sig)
    k = (1.0 - lb) * (1.0 - sig)

    def chunks(t):
        return t.reshape(bsz, nc, HG_CHUNK, HG_HEADS, HG_HEAD_DIM).transpose(1, 0, 3, 2, 4)

    causal = jnp.tril(jnp.ones((HG_CHUNK, HG_CHUNK), dtype=bool))[:, :, None]

    def step(state, inp):
        q_c, k_c, v_c, lf_c = inp
        b = jnp.cumsum(lf_c, axis=2)
        o_inter = jnp.einsum('bhtk,bhkv->bhtv', q_c * jnp.exp(b), state)
        diff = b[:, :, :, None, :] - b[:, :, None, :, :]
        decay = jnp.where(causal, jnp.exp(jnp.where(causal, diff, 0.0)), 0.0)
        att = jnp.einsum('bhtk,bhsk,bhtsk->bhts', q_c, k_c, decay)
        o = o_inter + jnp.einsum('bhts,bhsv->bhtv', att, v_c)
        b_last = b[:, :, -1:, :]
        state = (jnp.exp(b_last[:, :, 0, :, None]) * state
                 + jnp.einsum('bhsk,bhsv->bhkv', k_c * jnp.exp(b_last - b), v_c))
        return state, o

    s0 = jnp.zeros((bsz, HG_HEADS, HG_HEAD_DIM, HG_HEAD_DIM), jnp.float32)
    _, o = lax.scan(step, s0, (chunks(q), chunks(k), chunks(v), chunks(log_f)))
    o = o.transpose(1, 0, 3, 2, 4).reshape(bsz, seq, HG_HEADS, HG_HEAD_DIM)
    o = o * lax.rsqrt(jnp.mean(jnp.square(o), axis=-1, keepdims=True) + LN_EPS)
    o = o * norm_g.reshape(HG_HEADS, HG_HEAD_DIM)
    return o.reshape(bsz, seq, D_GROUP) * jax.nn.silu(g)


def setup_inputs(seed: int = 0) -> dict:
    key = jax.random.key(seed)
    ks = jax.random.split(key, 24)
    nrm = jax.random.normal
    f32 = jnp.float32
    x = nrm(ks[0], (BATCH, SEQ, D_MODEL), f32)
    ln_g = 1.0 + 0.02 * nrm(ks[1], (DEPTH, 3, D_MODEL), f32)
    ln_b = 0.02 * nrm(ks[2], (DEPTH, 3, D_MODEL), f32)
    ffn_w_gate = nrm(ks[3], (DEPTH, 2, D_MODEL, D_FF), f32) * D_MODEL ** -0.5
    ffn_w_up = nrm(ks[4], (DEPTH, 2, D_MODEL, D_FF), f32) * D_MODEL ** -0.5
    ffn_w_down = nrm(ks[5], (DEPTH, 2, D_FF, D_MODEL), f32) * (D_FF ** -0.5 * BETA)
    w_in = nrm(ks[6], (DEPTH, D_MODEL, D_IN), f32) * D_MODEL ** -0.5
    w_out = nrm(ks[7], (DEPTH, D_MIX, D_MODEL), f32) * (D_MIX ** -0.5 * BETA)
    rg_conv_w = nrm(ks[8], (DEPTH, RG_CONV, D_GROUP), f32) * RG_CONV ** -0.5
    rg_conv_b = 0.02 * nrm(ks[9], (DEPTH, D_GROUP), f32)
    rg_w_a = nrm(ks[10], (DEPTH, RG_BLOCKS, RG_BLOCK_DIM, RG_BLOCK_DIM), f32) * RG_BLOCK_DIM ** -0.5
    rg_b_a = 0.02 * nrm(ks[11], (DEPTH, D_GROUP), f32)
    rg_w_x = nrm(ks[12], (DEPTH, RG_BLOCKS, RG_BLOCK_DIM, RG_BLOCK_DIM), f32) * RG_BLOCK_DIM ** -0.5
    rg_b_x = 0.02 * nrm(ks[13], (DEPTH, D_GROUP), f32)
    a_c = jax.random.uniform(ks[14], (DEPTH, D_GROUP), f32, RG_A_MIN, RG_A_MAX)
    a0 = a_c ** (1.0 / RG_C)
    rg_lambda = jnp.log(a0) - jnp.log1p(-a0)
    cv_w = nrm(ks[15], (DEPTH, CV_WIDTH, D_GROUP), f32) * CV_WIDTH ** -0.5
    cv_b = 0.02 * nrm(ks[16], (DEPTH, D_GROUP), f32)
    cv_ln_g = 1.0 + 0.02 * nrm(ks[17], (DEPTH, D_GROUP), f32)
    cv_ln_b = 0.02 * nrm(ks[18], (DEPTH, D_GROUP), f32)
    hg_lower_bounds = 0.5 * nrm(ks[19], (DEPTH, D_GROUP), f32)
    hg_norm_g = 1.0 + 0.02 * nrm(ks[20], (DEPTH, D_GROUP), f32)
    return {'x': x, 'ln_g': ln_g, 'ln_b': ln_b, 'ffn_w_gate': ffn_w_gate, 'ffn_w_up': ffn_w_up,
            'ffn_w_down': ffn_w_down, 'w_in': w_in, 'w_out': w_out, 'rg_conv_w': rg_conv_w,
            'rg_conv_b': rg_conv_b, 'rg_w_a': rg_w_a, 'rg_b_a': rg_b_a, 'rg_w_x': rg_w_x,
            'rg_b_x': rg_b_x, 'rg_lambda': rg_lambda, 'cv_w': cv_w, 'cv_b': cv_b,
            'cv_ln_g': cv_ln_g, 'cv_ln_b': cv_ln_b, 'hg_lower_bounds': hg_lower_bounds,
            'hg_norm_g': hg_norm_g}


def reference(x, ln_g, ln_b, ffn_w_gate, ffn_w_up, ffn_w_down, w_in, w_out, rg_conv_w,
              rg_conv_b, rg_w_a, rg_b_a, rg_w_x, rg_b_x, rg_lambda, cv_w, cv_b, cv_ln_g,
              cv_ln_b, hg_lower_bounds, hg_norm_g):
    f32 = jnp.float32
    sm = jax.nn.softmax(hg_lower_bounds.astype(f32), axis=0)
    lower_bounds = jnp.cumsum(sm, axis=0) - sm[0:1]
    for l in range(DEPTH):
        x = layer_norm(ALPHA * x + 0.5 * swiglu(x, ffn_w_gate[l, 0], ffn_w_up[l, 0], ffn_w_down[l, 0]),
                       ln_g[l, 0], ln_b[l, 0])
        (a_q, a_k, a_v, b_gate, b_x, c_val, c_gate,
         d_q, d_f, d_i, d_g) = jnp.split((x @ w_in[l]).astype(f32), N_IN_SLICES, axis=-1)
        y_a = moba_attention(split_heads(a_q, ATT_HEADS), split_heads(a_k, ATT_HEADS),
                             split_heads(a_v, ATT_HEADS))
        y_b = rglru_mixer(b_gate, b_x, rg_conv_w[l], rg_conv_b[l], rg_w_a[l], rg_b_a[l],
                          rg_w_x[l], rg_b_x[l], rg_lambda[l])
        y_c = conformer_conv_mixer(c_val, c_gate, cv_w[l], cv_b[l], cv_ln_g[l], cv_ln_b[l])
        y_d = hgrn2_mixer(d_q, d_f, d_i, d_g, lower_bounds[l], hg_norm_g[l])
        y = jnp.concatenate([y_a, y_b, y_c, y_d], axis=-1).astype(x.dtype) @ w_out[l]
        x = layer_norm(ALPHA * x + y, ln_g[l, 1], ln_b[l, 1])
        x = layer_norm(ALPHA * x + 0.5 * swiglu(x, ffn_w_gate[l, 1], ffn_w_up[l, 1], ffn_w_down[l, 1]),
                       ln_g[l, 2], ln_b[l, 2])
    return x
```

```cpp
#include <hip/hip_runtime.h>
#include <hip/hip_cooperative_groups.h>
#include <cstdio>
#include <cstdint>
namespace cg = cooperative_groups;
namespace pg8 {
#define PG8_LAS __attribute__((address_space(3)))
typedef unsigned short bf16_t;
typedef short bf16x8 __attribute__((ext_vector_type(8)));
typedef float f32x4 __attribute__((ext_vector_type(4)));
typedef unsigned u32x4 __attribute__((ext_vector_type(4)));
constexpr int BM = 256, BK = 64, HALF = 128, HTB = HALF * BK * 2  , STAGE_BYTES = 8 * HTB, NXCD = 8, WGM = 8;

__host__ __device__ __forceinline__ int lds_byte(int r, int c) { const int st = (r >> 4) * 2 + (c >> 5), rr = r & 15, cc = c & 31, ob = rr * 64 + cc * 2; return st * 1024 + (ob ^ (((ob >> 9) & 1) << 5)); }
__host__ __device__ __forceinline__ void stage_rc(int b, int& R, int& C) { const int st = b / 1024, sb = b % 1024, swz = sb ^ (((sb >> 9) & 1) << 5); R = (st >> 1) * 16 + swz / 64; C = (st & 1) * 32 + (swz % 64) / 2; }
__host__ __device__ __forceinline__ int perm32(int rho) { const int n = rho >> 4, i = rho & 15; return 8 * (i >> 2) + 4 * n + (i & 3); }

struct Unit { int pm, pn; };
struct Gemm { const bf16_t* A; const bf16_t* Bt; int M, N, K; };

struct StaticOrder {
    int nM, nN, nwg, G, c;
    __host__ __device__ void init(int M, int N, int G_, int c_) { nM = M / BM; nN = N / BM; nwg = nM * nN; G = G_; c = c_; }
    __host__ __device__ bool next(int i, Unit& u) const {
        const long L = (long)i * G + c; if (L >= nwg) return false;
        int wgid = (int)L; { const int q = nwg / NXCD, r = nwg % NXCD, xcd = wgid % NXCD, off = wgid / NXCD; wgid = (xcd < r ? xcd * (q + 1) : r * (q + 1) + (xcd - r) * q) + off; }
        const int nig = WGM * nN, gid = wgid / nig, fm = gid * WGM, gsz = (nM - fm) < WGM ? (nM - fm) : WGM;
        u.pm = fm + ((wgid % nig) % gsz); u.pn = (wgid % nig) / gsz; return true;
    }
    __device__ __forceinline__ void a_ready(const Unit&) const {}
    __device__ __forceinline__ void done(const Unit&) const {}
};
__device__ __forceinline__ unsigned cvt_pk_bf16(float lo, float hi) { unsigned r; asm volatile("v_cvt_pk_bf16_f32 %0, %1, %2" : "=v"(r) : "v"(lo), "v"(hi)); return r; }
template <class Epi, class Sched>
__device__ __forceinline__ void gemm_phase(PG8_LAS unsigned char* lds, const Gemm g, const Sched& S, const Epi& E) {
    int tid_ = threadIdx.x; asm volatile("" : "+v"(tid_)); const int tid = tid_, wid = __builtin_amdgcn_readfirstlane(tid >> 6), lane = tid & 63, wr = wid >> 2, wc = wid & 3, fr = lane & 15, fq = lane >> 4;
    const int K = g.K, nt = K / BK;
    unsigned voffA[2], voffB[2];
#pragma unroll
    for (int i = 0; i < 2; ++i) { int R, C; stage_rc(tid * 16 + i * 8192, R, C); const int Rb = Epi::PERM ? ((R & ~31) + perm32(R & 31)) : R;
        voffA[i] = (unsigned)(R * K + C) * 2u; voffB[i] = (unsigned)(Rb * K + C) * 2u; }
    const size_t kstep = (size_t)(BK * 2);
    const size_t hstep = (size_t)HALF * K * 2;
    const size_t tstep = 2 * hstep;
    const unsigned ldsw = (unsigned)wid * 1024u;
    const int aoff = lds_byte(wr * 64 + fr, fq * 8), boff = lds_byte(wc * 32 + fr, fq * 8);
#define PG8_SA(b, h) (((b) * 2 + (h)) * HTB)
#define PG8_SB(b, h) ((4 + (b) * 2 + (h)) * HTB)
#define PG8_STAGE(bufoff, gbase, voff) do { _Pragma("unroll") for (int _i = 0; _i < 2; ++_i) \
        __builtin_amdgcn_global_load_lds((const unsigned*)((const char*)(gbase) + (voff)[_i]), (PG8_LAS unsigned*)(lds + (bufoff) + ldsw + _i * 8192), 16, 0, 0); } while (0)
#define PG8_LDA(dst, b, h) do { _Pragma("unroll") for (int m = 0; m < 4; ++m) _Pragma("unroll") for (int k = 0; k < 2; ++k) dst[m][k] = *(const PG8_LAS bf16x8*)(lds + PG8_SA(b, h) + aoff + m * 2048 + k * 1024); } while (0)
#define PG8_LDB(dst, b, h) do { _Pragma("unroll") for (int n = 0; n < 2; ++n) _Pragma("unroll") for (int k = 0; k < 2; ++k) dst[n][k] = *(const PG8_LAS bf16x8*)(lds + PG8_SB(b, h) + boff + n * 2048 + k * 1024); } while (0)
#define PG8_MMA(ai, bj, At, Bt) do { __builtin_amdgcn_s_setprio(1); _Pragma("unroll") for (int m = 0; m < 4; ++m) _Pragma("unroll") for (int n = 0; n < 2; ++n) _Pragma("unroll") for (int k = 0; k < 2; ++k) \
        acc[ai][bj][m][n] = __builtin_amdgcn_mfma_f32_16x16x32_bf16(Bt[n][k], At[m][k], acc[ai][bj][m][n], 0, 0, 0); __builtin_amdgcn_s_setprio(0); } while (0)
#define PG8_WAIT_V(n) asm volatile("s_waitcnt vmcnt(" #n ")" ::: "memory")
#define PG8_WAIT_L(n) asm volatile("s_waitcnt lgkmcnt(" #n ")" ::: "memory")
#define PG8_BAR __builtin_amdgcn_s_barrier()
#define PG8_SCHED __builtin_amdgcn_sched_barrier(0)
    Unit cur, nxt; int ui = 0;
    if (!S.next(0, cur)) return;
    f32x4 acc[2][2][4][2];
#pragma unroll
    for (int a = 0; a < 2; ++a)
#pragma unroll
        for (int b = 0; b < 2; ++b)
#pragma unroll
            for (int m = 0; m < 4; ++m)
#pragma unroll
                for (int n = 0; n < 2; ++n) acc[a][b][m][n] = (f32x4){0.f, 0.f, 0.f, 0.f};
    bf16x8 At[4][2], B0[2][2], B1[2][2];
    const char* cA = (const char*)g.A + (size_t)cur.pm * tstep; const char* cB = (const char*)g.Bt + (size_t)cur.pn * tstep;
    S.a_ready(cur);
    PG8_STAGE(PG8_SB(0, 0), cB, voffB); PG8_STAGE(PG8_SA(0, 0), cA, voffA); PG8_STAGE(PG8_SB(0, 1), cB + hstep, voffB); PG8_STAGE(PG8_SA(0, 1), cA + hstep, voffA);
    if (wr == 1) PG8_BAR;
    PG8_WAIT_V(4); PG8_BAR;
    PG8_STAGE(PG8_SB(1, 0), cB + kstep, voffB); PG8_STAGE(PG8_SA(1, 0), cA + kstep, voffA); PG8_STAGE(PG8_SB(1, 1), cB + hstep + kstep, voffB);
    PG8_WAIT_V(6); PG8_BAR;
    for (;;) {
        const bool has_next = S.next(ui + 1, nxt);
        const char* nA = has_next ? (const char*)g.A + (size_t)nxt.pm * tstep : cA; const char* nB = has_next ? (const char*)g.Bt + (size_t)nxt.pn * tstep : cB;
        for (int t = 0; t < nt; t += 2) {
            const bool last = (t == nt - 2);
            const char* a1 = cA + (size_t)(t + 1) * kstep;
            const char* a2 = last ? nA : cA + (size_t)(t + 2) * kstep; const char* b2 = last ? nB : cB + (size_t)(t + 2) * kstep;
            const char* a3 = a2 + kstep; const char* b3 = b2 + kstep;
            if (last && has_next) S.a_ready(nxt);
            PG8_LDB(B0, 0, 0); PG8_SCHED; PG8_LDA(At, 0, 0); PG8_STAGE(PG8_SA(1, 1), a1 + hstep, voffA);
            PG8_WAIT_L(8); PG8_BAR; PG8_WAIT_L(0); PG8_MMA(0, 0, At, B0); PG8_BAR; PG8_SCHED;
            PG8_LDB(B1, 0, 1); PG8_STAGE(PG8_SB(0, 0), b2, voffB);
            PG8_BAR; PG8_WAIT_L(0); PG8_MMA(0, 1, At, B1); PG8_BAR;
            PG8_LDA(At, 0, 1); PG8_STAGE(PG8_SA(0, 0), a2, voffA);
            PG8_BAR; PG8_WAIT_L(0); PG8_MMA(1, 0, At, B0); PG8_BAR; PG8_SCHED;
            PG8_STAGE(PG8_SB(0, 1), b2 + hstep, voffB);
            PG8_WAIT_V(6); PG8_BAR; PG8_MMA(1, 1, At, B1); PG8_BAR;
            PG8_LDB(B0, 1, 0); PG8_SCHED; PG8_LDA(At, 1, 0); PG8_STAGE(PG8_SA(0, 1), a2 + hstep, voffA);
            PG8_WAIT_L(8); PG8_BAR; PG8_WAIT_L(0); PG8_MMA(0, 0, At, B0); PG8_BAR; PG8_SCHED;
            PG8_LDB(B1, 1, 1); PG8_STAGE(PG8_SB(1, 0), b3, voffB);
            PG8_BAR; PG8_WAIT_L(0); PG8_MMA(0, 1, At, B1); PG8_BAR;
            PG8_LDA(At, 1, 1); PG8_STAGE(PG8_SA(1, 0), a3, voffA);
            PG8_BAR; PG8_WAIT_L(0); PG8_MMA(1, 0, At, B0); PG8_BAR; PG8_SCHED;
            PG8_STAGE(PG8_SB(1, 1), b3 + hstep, voffB);
            PG8_WAIT_V(6); PG8_BAR; PG8_MMA(1, 1, At, B1); PG8_BAR;
        }
        if constexpr (!Epi::AFTER_DRAIN) { E(acc, cur, wr, wc, fr, fq); S.done(cur); }
        if (!has_next) break;
#pragma unroll
        for (int a = 0; a < 2; ++a)
#pragma unroll
            for (int b = 0; b < 2; ++b)
#pragma unroll
                for (int m = 0; m < 4; ++m)
#pragma unroll
                    for (int n = 0; n < 2; ++n) acc[a][b][m][n] = (f32x4){0.f, 0.f, 0.f, 0.f};
        cur = nxt; cA = nA; cB = nB; ++ui;
    }
    PG8_WAIT_V(0);
    if (wr == 0) PG8_BAR;
    PG8_BAR;
    if constexpr (Epi::AFTER_DRAIN) { E.fused(acc, cur, wr, wc, fr, fq, lds, wid, lane); S.done(cur); }
#undef PG8_SA
#undef PG8_SB
#undef PG8_STAGE
#undef PG8_LDA
#undef PG8_LDB
#undef PG8_MMA
#undef PG8_WAIT_V
#undef PG8_WAIT_L
#undef PG8_BAR
#undef PG8_SCHED
}
}

using pg8::bf16_t; using pg8::bf16x8; using pg8::f32x4; using pg8::u32x4; using pg8::cvt_pk_bf16;
typedef unsigned u32x2 __attribute__((ext_vector_type(2)));

constexpr int NTOK = 16384, DM = 2048, DFF = 5632, DIN = 5632, SEQ = 4096;
constexpr float LN_EPS = 1e-5f;
constexpr float ALPHA = 1.41421356237f;
constexpr int LDS_BYTES = 147456;
constexpr int NPHASE = 23;

constexpr size_t SZ_GU = (size_t)11264 * 2048 * 2, SZ_DN = (size_t)2048 * 5632 * 2, SZ_IN = (size_t)5632 * 2048 * 2,
                 SZ_OUT = (size_t)2048 * 2048 * 2, SZ_RG = (size_t)4 * 128 * 128 * 2;
constexpr size_t OFF_CTL = 0, OFF_GU = 4096, OFF_DN = OFF_GU + 4 * SZ_GU, OFF_IN = OFF_DN + 4 * SZ_DN, OFF_OUT = OFF_IN + 2 * SZ_IN,
                 OFF_RGA = OFF_OUT + 2 * SZ_OUT, OFF_RGX = OFF_RGA + 2 * SZ_RG, OFF_X = OFF_RGX + 2 * SZ_RG,
                 OFF_XB = OFF_X + (size_t)NTOK * DM * 4, OFF_H = OFF_XB + (size_t)NTOK * DM * 2,
                 OFF_KMEAN = OFF_H + (size_t)NTOK * DFF * 2, OFF_ATILE = OFF_KMEAN + 131072, OFF_HTILE = OFF_ATILE + 524288,
                 WS_END = OFF_HTILE + 524288;
constexpr size_t OUT_HLOC = 0, OUT_CUMA = 33554432, OUT_VT = 67108864;

struct Params { const float* in[21]; float* out; unsigned char* ws; int ph_lo, ph_hi; };

__device__ __forceinline__ float bf2f(unsigned short u) { return __uint_as_float(((unsigned)u) << 16); }
__device__ __forceinline__ unsigned short f2bf(float f) { unsigned u = __float_as_uint(f); u += 0x7FFFu + ((u >> 16) & 1u); return (unsigned short)(u >> 16); }
__device__ __forceinline__ float sigm(float x) { return __builtin_amdgcn_rcpf(1.0f + __expf(-x)); }
__device__ __forceinline__ bf16x8 pack8(float a0, float a1, float a2, float a3, float a4, float a5, float a6, float a7) {
    u32x4 w; w.x = cvt_pk_bf16(a0, a1); w.y = cvt_pk_bf16(a2, a3); w.z = cvt_pk_bf16(a4, a5); w.w = cvt_pk_bf16(a6, a7);
    return __builtin_bit_cast(bf16x8, w);
}
__device__ __forceinline__ int opaque_tid() { int t = threadIdx.x; asm volatile("" : "+v"(t)); return t; }
#define MFMA16(a, b, c) __builtin_amdgcn_mfma_f32_16x16x32_bf16((a), (b), (c), 0, 0, 0)

struct EpiSwiGLU {
    static constexpr bool PERM = true, AFTER_DRAIN = false;
    bf16_t* H;
    __device__ __forceinline__ void operator()(const f32x4 (&acc)[2][2][4][2], const pg8::Unit& u, int wr, int wc, int fr, int fq) const {
        const int row0 = u.pm * 256 + wr * 64 + fr, col0 = u.pn * 128 + wc * 32 + 8 * fq;
#pragma unroll
        for (int ai = 0; ai < 2; ++ai)
#pragma unroll
            for (int m = 0; m < 4; ++m) {
                bf16_t* rowp = H + (size_t)(row0 + ai * 128 + m * 16) * DFF + col0;
                float hv[8];
#pragma unroll
                for (int n = 0; n < 2; ++n)
#pragma unroll
                    for (int j = 0; j < 4; ++j) { const float g = acc[ai][0][m][n][j], up = acc[ai][1][m][n][j]; hv[n * 4 + j] = g * sigm(g) * up; }
                u32x4 w; w.x = cvt_pk_bf16(hv[0], hv[1]); w.y = cvt_pk_bf16(hv[2], hv[3]); w.z = cvt_pk_bf16(hv[4], hv[5]); w.w = cvt_pk_bf16(hv[6], hv[7]);
                *(u32x4*)rowp = w;
            }
    }
};
struct EpiResid {
    static constexpr bool PERM = false, AFTER_DRAIN = false;
    const float* R; float* O; float alpha, s;
    __device__ __forceinline__ void operator()(const f32x4 (&acc)[2][2][4][2], const pg8::Unit& u, int wr, int wc, int fr, int fq) const {
        const int row0 = u.pm * 256 + wr * 64 + fr, col0 = u.pn * 256 + wc * 32 + 4 * fq;
#pragma unroll
        for (int ai = 0; ai < 2; ++ai)
#pragma unroll
            for (int m = 0; m < 4; ++m) {
                const size_t off = (size_t)(row0 + ai * 128 + m * 16) * DM + col0;
#pragma unroll
                for (int bj = 0; bj < 2; ++bj)
#pragma unroll
                    for (int n = 0; n < 2; ++n) { const size_t o2 = off + bj * 128 + n * 16; const f32x4 r = *(const f32x4*)(R + o2); *(f32x4*)(O + o2) = r * alpha + acc[ai][bj][m][n] * s; }
            }
    }
};
struct EpiBf16P {
    static constexpr bool PERM = true, AFTER_DRAIN = false;
    bf16_t* O; int ldc;
    __device__ __forceinline__ void operator()(const f32x4 (&acc)[2][2][4][2], const pg8::Unit& u, int wr, int wc, int fr, int fq) const {
        const int row0 = u.pm * 256 + wr * 64 + fr, col0 = u.pn * 256 + wc * 32 + 8 * fq;
#pragma unroll
        for (int ai = 0; ai < 2; ++ai)
#pragma unroll
            for (int m = 0; m < 4; ++m) {
                bf16_t* rowp = O + (size_t)(row0 + ai * 128 + m * 16) * ldc + col0;
#pragma unroll
                for (int bj = 0; bj < 2; ++bj) { const f32x4 v0 = acc[ai][bj][m][0], v1 = acc[ai][bj][m][1];
                    u32x4 w; w.x = cvt_pk_bf16(v0[0], v0[1]); w.y = cvt_pk_bf16(v0[2], v0[3]); w.z = cvt_pk_bf16(v1[0], v1[1]); w.w = cvt_pk_bf16(v1[2], v1[3]);
                    *(u32x4*)(rowp + bj * 128) = w; }
            }
    }
};

__device__ __forceinline__ void convT_job(const float* __restrict__ src, bf16_t* __restrict__ dst, int K, int N, int mode, float* t) {
    const int tid = opaque_tid(), ntn = N >> 6, ntiles = (K >> 6) * ntn;
    for (int tile = blockIdx.x; tile < ntiles; tile += gridDim.x) {
        const int k0 = (tile / ntn) << 6, n0 = (tile % ntn) << 6;
#pragma unroll
        for (int pp = 0; pp < 2; ++pp) {
            const int k = (tid >> 4) + 32 * pp, n4 = (tid & 15) * 4;
            const float4 v = *(const float4*)(src + (size_t)(k0 + k) * N + n0 + n4);
            t[k * 65 + n4] = v.x; t[k * 65 + n4 + 1] = v.y; t[k * 65 + n4 + 2] = v.z; t[k * 65 + n4 + 3] = v.w;
        }
        __syncthreads();
        const int n = tid >> 3, k8 = (tid & 7) * 8;
        float v[8];
#pragma unroll
        for (int j = 0; j < 8; ++j) v[j] = t[(k8 + j) * 65 + n];
        const int nn = n0 + n;
        const int row = mode == 0 ? nn : (256 * (nn >> 7) + (nn & 127) + (mode == 2 ? 128 : 0));
        u32x4 w; w.x = cvt_pk_bf16(v[0], v[1]); w.y = cvt_pk_bf16(v[2], v[3]); w.z = cvt_pk_bf16(v[4], v[5]); w.w = cvt_pk_bf16(v[6], v[7]);
        *(u32x4*)(dst + (size_t)row * K + k0 + k8) = w;
        __syncthreads();
    }
}
__device__ __forceinline__ void phase_convert(const Params& p, unsigned char* smem) {
    float* t = (float*)smem;
    for (int l = 0; l < 2; ++l) {
        for (int f = 0; f < 2; ++f) {
            const size_t wo = (size_t)(l * 2 + f) * 2048 * 5632;
            bf16_t* gu = (bf16_t*)(p.ws + OFF_GU + (size_t)(l * 2 + f) * SZ_GU);
            convT_job(p.in[3] + wo, gu, 2048, 5632, 1, t);
            convT_job(p.in[4] + wo, gu, 2048, 5632, 2, t);
            convT_job(p.in[5] + wo, (bf16_t*)(p.ws + OFF_DN + (size_t)(l * 2 + f) * SZ_DN), 5632, 2048, 0, t);
        }
        convT_job(p.in[6] + (size_t)l * 2048 * 5632, (bf16_t*)(p.ws + OFF_IN + (size_t)l * SZ_IN), 2048, 5632, 0, t);
        convT_job(p.in[7] + (size_t)l * 2048 * 2048, (bf16_t*)(p.ws + OFF_OUT + (size_t)l * SZ_OUT), 2048, 2048, 0, t);
        for (int g = 0; g < 4; ++g) {
            convT_job(p.in[10] + (size_t)(l * 4 + g) * 16384, (bf16_t*)(p.ws + OFF_RGA + (size_t)l * SZ_RG) + g * 16384, 128, 128, 0, t);
            convT_job(p.in[12] + (size_t)(l * 4 + g) * 16384, (bf16_t*)(p.ws + OFF_RGX + (size_t)l * SZ_RG) + g * 16384, 128, 128, 0, t);
        }
    }
    const float4* xs = (const float4*)p.in[0]; u32x2* xd = (u32x2*)(p.ws + OFF_XB);
    const size_t n4 = (size_t)NTOK * DM / 4;
    for (size_t i = (size_t)blockIdx.x * 512 + threadIdx.x; i < n4; i += (size_t)gridDim.x * 512) {
        const float4 v = xs[i]; u32x2 w; w.x = cvt_pk_bf16(v.x, v.y); w.y = cvt_pk_bf16(v.z, v.w); xd[i] = w;
    }
}

__device__ __forceinline__ void phase_ln(const float* zin, float* xout, bf16_t* xb, const float* __restrict__ g, const float* __restrict__ b) {
    const int tid_ln = opaque_tid(); const int wave = tid_ln >> 6, lane = tid_ln & 63;
    for (int row = blockIdx.x * 8 + wave; row < NTOK; row += gridDim.x * 8) {
        const float4* src = (const float4*)(zin + (size_t)row * DM);
        float4 v[8]; float s = 0.f;
#pragma unroll
        for (int i = 0; i < 8; ++i) { v[i] = src[lane + 64 * i]; s += (v[i].x + v[i].y) + (v[i].z + v[i].w); }
#pragma unroll
        for (int o = 32; o > 0; o >>= 1) s += __shfl_xor(s, o);
        const float mu = s * (1.0f / DM); float q = 0.f;
#pragma unroll
        for (int i = 0; i < 8; ++i) { const float a = v[i].x - mu, bb = v[i].y - mu, c = v[i].z - mu, d = v[i].w - mu; q += (a * a + bb * bb) + (c * c + d * d); }
#pragma unroll
        for (int o = 32; o > 0; o >>= 1) q += __shfl_xor(q, o);
        const float rstd = rsqrtf(q * (1.0f / DM) + LN_EPS);
        float4* dst = (float4*)(xout + (size_t)row * DM); u32x2* dstb = (u32x2*)(xb + (size_t)row * DM);
#pragma unroll
        for (int i = 0; i < 8; ++i) {
            const float4 gg = ((const float4*)g)[lane + 64 * i], bb = ((const float4*)b)[lane + 64 * i]; float4 y;
            y.x = (v[i].x - mu) * rstd * gg.x + bb.x; y.y = (v[i].y - mu) * rstd * gg.y + bb.y; y.z = (v[i].z - mu) * rstd * gg.z + bb.z; y.w = (v[i].w - mu) * rstd * gg.w + bb.w;
            dst[lane + 64 * i] = y; u32x2 w; w.x = cvt_pk_bf16(y.x, y.y); w.y = cvt_pk_bf16(y.z, y.w); dstb[lane + 64 * i] = w;
        }
    }
}

__device__ __forceinline__ void kvpre_item(const Params& p, int item, unsigned char* smem) {
    const int tid = opaque_tid(), d = tid & 127, ks = tid >> 7;
    const int bh = item >> 4, j = item & 15, b = bh >> 2, h = bh & 3;
    const bf16_t* P = (const bf16_t*)(p.ws + OFF_H);
    bf16_t* Vt = (bf16_t*)((unsigned char*)p.out + OUT_VT);
    float* red = (float*)smem;
    const size_t tok0 = (size_t)b * SEQ + j * 256 + ks * 64;
    float ksum = 0.f;
#pragma unroll 1
    for (int gq = 0; gq < 8; ++gq) {
        unsigned short vv[8];
#pragma unroll
        for (int i = 0; i < 8; ++i) { const bf16_t* r = P + (tok0 + gq * 8 + i) * DIN + h * 128 + d; ksum += bf2f(r[512]); vv[i] = r[1024]; }
        u32x4 w; w.x = vv[0] | ((unsigned)vv[1] << 16); w.y = vv[2] | ((unsigned)vv[3] << 16); w.z = vv[4] | ((unsigned)vv[5] << 16); w.w = vv[6] | ((unsigned)vv[7] << 16);
        *(u32x4*)(Vt + ((size_t)bh * 128 + d) * SEQ + j * 256 + ks * 64 + gq * 8) = w;
    }
    red[ks * 128 + d] = ksum;
    __syncthreads();
    if (tid < 128) ((float*)(p.ws + OFF_KMEAN))[((size_t)bh * 16 + j) * 128 + tid] = (red[tid] + red[128 + tid] + red[256 + tid] + red[384 + tid]) * (1.0f / 256.0f);
    __syncthreads();
}

__device__ __forceinline__ void rgpre_item(const Params& p, int layer, int item, unsigned char* smem) {
    const int tid = opaque_tid(), c = tid & 127, sg = tid >> 7, w = tid >> 6, lane = tid & 63, fr = lane & 15, fq = lane >> 4;
    const int g = item & 3, bt = item >> 2, b = bt >> 6, tau = bt & 63;
    const bf16_t* P = (const bf16_t*)(p.ws + OFF_H);
    float* xcf = (float*)smem; bf16_t* xcb = (bf16_t*)(smem + 32768); float* aL = (float*)(smem + 50176); float* uL = (float*)(smem + 82944);
    float* segA = (float*)(smem + 115712); float* segH = (float*)(smem + 117760);
    const bf16_t* Wa = (const bf16_t*)(p.ws + OFF_RGA + (size_t)layer * SZ_RG) + g * 16384;
    const bf16_t* Wx = (const bf16_t*)(p.ws + OFF_RGX + (size_t)layer * SZ_RG) + g * 16384;
    bf16x8 Ba[4], Bx[4];
#pragma unroll
    for (int kk = 0; kk < 4; ++kk) { Ba[kk] = *(const bf16x8*)(Wa + (16 * w + fr) * 128 + 32 * kk + 8 * fq); Bx[kk] = *(const bf16x8*)(Wx + (16 * w + fr) * 128 + 32 * kk + 8 * fq); }
    const int ch = g * 128 + c;
    {
        const float* cw = p.in[8] + (size_t)layer * 4 * 512 + ch;
        const float cw0 = cw[0], cw1 = cw[512], cw2 = cw[1024], cw3 = cw[1536], cb = p.in[9][layer * 512 + ch];
        const bf16_t* Px = P + (size_t)b * SEQ * DIN + 2048 + ch;
        const int tbase = tau * 64 + sg * 16;
        float xw[19];
#pragma unroll
        for (int i = 0; i < 19; ++i) { const int pos = tbase - 3 + i; xw[i] = pos >= 0 ? bf2f(Px[(size_t)pos * DIN]) : 0.f; }
#pragma unroll
        for (int i = 0; i < 16; ++i) { const float xc = cb + cw0 * xw[i] + cw1 * xw[i + 1] + cw2 * xw[i + 2] + cw3 * xw[i + 3]; const int t = sg * 16 + i; xcf[t * 128 + c] = xc; xcb[t * 136 + c] = f2bf(xc); }
    }
    __syncthreads();
    {
        const int col = 16 * w + fr, chl = layer * 512 + g * 128 + col;
        const float ba = p.in[11][chl], bx = p.in[13][chl], lam = p.in[14][chl];
        const float sp = log1pf(__expf(-lam));
#pragma unroll
        for (int tt = 0; tt < 4; ++tt) {
            f32x4 aa = {0.f, 0.f, 0.f, 0.f}, ax = {0.f, 0.f, 0.f, 0.f};
#pragma unroll
            for (int kk = 0; kk < 4; ++kk) { const bf16x8 a = *(const bf16x8*)(xcb + (16 * tt + fr) * 136 + 32 * kk + 8 * fq); aa = MFMA16(a, Ba[kk], aa); ax = MFMA16(a, Bx[kk], ax); }
#pragma unroll
            for (int j = 0; j < 4; ++j) {
                const int t = 16 * tt + 4 * fq + j;
                const float r = sigm(aa[j] + ba), ii = sigm(ax[j] + bx), la = -8.0f * r * sp;
                const float av = __expf(la), u = sqrtf(fmaxf(-expm1f(2.0f * la), 0.f)) * (ii * xcf[t * 128 + col]);
                aL[t * 128 + col] = av; uL[t * 128 + col] = u;
            }
        }
    }
    __syncthreads();
    {
        float hh = 0.f, AA = 1.f;
#pragma unroll
        for (int i = 0; i < 16; ++i) { const int t = sg * 16 + i; const float av = aL[t * 128 + c], u = uL[t * 128 + c]; hh = av * hh + u; AA *= av; uL[t * 128 + c] = hh; aL[t * 128 + c] = AA; }
        segA[sg * 128 + c] = AA; segH[sg * 128 + c] = hh;
    }
    __syncthreads();
    {
        float carry = 0.f, cA = 1.f;
        for (int s2 = 0; s2 < sg; ++s2) { const float a2 = segA[s2 * 128 + c]; carry = a2 * carry + segH[s2 * 128 + c]; cA *= a2; }
        float* HL = (float*)((unsigned char*)p.out + OUT_HLOC); float* CA = (float*)((unsigned char*)p.out + OUT_CUMA);
        float hl = 0.f, ca = 0.f;
#pragma unroll
        for (int i = 0; i < 16; ++i) {
            const int t = sg * 16 + i; const size_t tok = (size_t)b * SEQ + tau * 64 + t;
            const float al = aL[t * 128 + c]; hl = uL[t * 128 + c] + al * carry; ca = al * cA;
            HL[tok * 512 + ch] = hl; CA[tok * 512 + ch] = ca;
        }
        if (sg == 3) { ((float*)(p.ws + OFF_ATILE))[((size_t)b * 64 + tau) * 512 + ch] = ca; ((float*)(p.ws + OFF_HTILE))[((size_t)b * 64 + tau) * 512 + ch] = hl; }
    }
    __syncthreads();
}

__device__ __forceinline__ void convc_item(const Params& p, int layer, int item, unsigned char* smem) {
    const int tid = opaque_tid(), c = tid, w = tid >> 6, lane = tid & 63;
    const int b = item >> 6, tau = item & 63;
    const bf16_t* P = (const bf16_t*)(p.ws + OFF_H);
    bf16_t* Y = (bf16_t*)(p.ws + OFF_XB);
    float* ubuf = (float*)smem; float* stats = (float*)(smem + 131072);
    float wk[31];
#pragma unroll
    for (int k = 0; k < 31; ++k) wk[k] = p.in[15][(size_t)layer * 31 * 512 + k * 512 + c];
    const float cb = p.in[16][layer * 512 + c];
    const bf16_t* Pv = P + (size_t)b * SEQ * DIN + 2560 + c;
    float gw[38];
#pragma unroll
    for (int i = 0; i < 30; ++i) { const int pos = tau * 64 - 30 + i; float v = 0.f; if (pos >= 0) { const bf16_t* r = Pv + (size_t)pos * DIN; v = bf2f(r[0]) * sigm(bf2f(r[512])); } gw[i] = v; }
#pragma unroll 1
    for (int tg = 0; tg < 8; ++tg) {
#pragma unroll
        for (int i = 0; i < 8; ++i) { const bf16_t* r = Pv + (size_t)(tau * 64 + tg * 8 + i) * DIN; gw[30 + i] = bf2f(r[0]) * sigm(bf2f(r[512])); }
#pragma unroll
        for (int o = 0; o < 8; ++o) { float acc = cb;
#pragma unroll
            for (int k = 0; k < 31; ++k) acc += wk[k] * gw[o + k];
            ubuf[(tg * 8 + o) * 512 + c] = acc; }
#pragma unroll
        for (int i = 0; i < 30; ++i) gw[i] = gw[i + 8];
    }
    __syncthreads();
#pragma unroll 1
    for (int i = 0; i < 32; ++i) {
        const int pr = w * 32 + i, t = pr >> 2, grp = pr & 3;
        const float v0 = ubuf[t * 512 + grp * 128 + lane], v1 = ubuf[t * 512 + grp * 128 + 64 + lane];
        float s = v0 + v1;
#pragma unroll
        for (int o = 32; o > 0; o >>= 1) s += __shfl_xor(s, o);
        const float mu = s * (1.0f / 128.0f), d0 = v0 - mu, d1 = v1 - mu; float q = d0 * d0 + d1 * d1;
#pragma unroll
        for (int o = 32; o > 0; o >>= 1) q += __shfl_xor(q, o);
        if (lane == 0) { stats[(t * 4 + grp) * 2] = mu; stats[(t * 4 + grp) * 2 + 1] = rsqrtf(q * (1.0f / 128.0f) + LN_EPS); }
    }
    __syncthreads();
    {
        const float ng = p.in[17][layer * 512 + c], nb = p.in[18][layer * 512 + c]; const int grp = c >> 7;
#pragma unroll 4
        for (int t = 0; t < 64; ++t) {
            const float mu = stats[(t * 4 + grp) * 2], rs = stats[(t * 4 + grp) * 2 + 1];
            const float z = (ubuf[t * 512 + c] - mu) * rs * ng + nb;
            Y[((size_t)b * SEQ + tau * 64 + t) * DM + 1024 + c] = f2bf(z * sigm(z));
        }
    }
    __syncthreads();
}

__device__ __forceinline__ void rgpost_item(const Params& p, int item) {
    const int c = opaque_tid(), b = item >> 6, tau = item & 63;
    const bf16_t* P = (const bf16_t*)(p.ws + OFF_H);
    bf16_t* Y = (bf16_t*)(p.ws + OFF_XB);
    const float* AT = (const float*)(p.ws + OFF_ATILE) + (size_t)b * 64 * 512 + c; const float* HT = (const float*)(p.ws + OFF_HTILE) + (size_t)b * 64 * 512 + c;
    const float* HL = (const float*)((unsigned char*)p.out + OUT_HLOC); const float* CA = (const float*)((unsigned char*)p.out + OUT_CUMA);
    float carry = 0.f;
    for (int s = 0; s < tau; ++s) carry = AT[s * 512] * carry + HT[s * 512];
#pragma unroll 4
    for (int t = 0; t < 64; ++t) {
        const size_t tok = (size_t)b * SEQ + tau * 64 + t;
        const float hv = HL[tok * 512 + c] + CA[tok * 512 + c] * carry;
        const float x = bf2f(P[tok * DIN + 1536 + c]);
        const float u = 0.7978845608f * (x + 0.044715f * x * x * x);
        const float th = 1.0f - 2.0f * __builtin_amdgcn_rcpf(__expf(2.0f * u) + 1.0f);
        Y[tok * DM + 512 + c] = f2bf(hv * 0.5f * x * (1.0f + th));
    }
}

__device__ __forceinline__ void attn_item(const Params& p, int item, unsigned char* smem) {
    const int tid = opaque_tid(), w = tid >> 6, lane = tid & 63, fr = lane & 15, fq = lane >> 4;
    const int qt = 31 - (item >> 4), bh = item & 15, b = bh >> 2, h = bh & 3;
    const int blk = qt >> 1, o = (qt & 1) * 128, q0 = blk * 256 + o;
    const bf16_t* P = (const bf16_t*)(p.ws + OFF_H);
    const bf16_t* Vt = (const bf16_t*)((unsigned char*)p.out + OUT_VT) + (size_t)bh * 128 * SEQ;
    const float* kmean = (const float*)(p.ws + OFF_KMEAN) + (size_t)bh * 16 * 128;
    bf16_t* Y = (bf16_t*)(p.ws + OFF_XB);
    bf16_t* Ks = (bf16_t*)smem; bf16_t* Vs = (bf16_t*)(smem + 34816);
    float* kms = (float*)(smem + 71680); float* gts = (float*)(smem + 79872);
    unsigned* sels = (unsigned*)(smem + 88576); int* tiles = (int*)(smem + 89088); unsigned* um = (unsigned*)(smem + 89344);
    const bf16_t* Pb = P + (size_t)b * SEQ * DIN;

    bf16x8 Qf[4];
    { const bf16_t* qrow = Pb + (size_t)(q0 + 16 * w + fr) * DIN + h * 128;
#pragma unroll
      for (int kk = 0; kk < 4; ++kk) Qf[kk] = *(const bf16x8*)(qrow + 32 * kk + 8 * fq); }
    for (int i = tid; i < blk * 128; i += 512) kms[i] = kmean[i];
    if (tid == 0) um[0] = 0u;
    __syncthreads();
    {
        const int qi = tid & 127, jg = tid >> 7;
        float g4[4] = {0.f, 0.f, 0.f, 0.f};
        if (jg * 4 < blk) {
            const bf16_t* qr = Pb + (size_t)(q0 + qi) * DIN + h * 128;
#pragma unroll 2
            for (int cc = 0; cc < 16; ++cc) {
                const u32x4 raw = *(const u32x4*)(qr + 8 * cc);
                float qv[8];
                qv[0] = __uint_as_float(raw.x << 16); qv[1] = __uint_as_float(raw.x & 0xffff0000u); qv[2] = __uint_as_float(raw.y << 16); qv[3] = __uint_as_float(raw.y & 0xffff0000u);
                qv[4] = __uint_as_float(raw.z << 16); qv[5] = __uint_as_float(raw.z & 0xffff0000u); qv[6] = __uint_as_float(raw.w << 16); qv[7] = __uint_as_float(raw.w & 0xffff0000u);
#pragma unroll
                for (int jj = 0; jj < 4; ++jj) { const int j = jg * 4 + jj; if (j < blk) { const float* km = kms + j * 128 + 8 * cc;
#pragma unroll
                    for (int e = 0; e < 8; ++e) g4[jj] += qv[e] * km[e]; } }
            }
        }
#pragma unroll
        for (int jj = 0; jj < 4; ++jj) gts[qi * 17 + jg * 4 + jj] = g4[jj];
    }
    __syncthreads();
    if (tid < 128) {
        unsigned m = 0u; const int nsel = blk < 3 ? blk : 3;
        for (int s = 0; s < nsel; ++s) { float best = -3.0e38f; int bi = 0;
            for (int j = 0; j < blk; ++j) { const float v = gts[tid * 17 + j]; if (!((m >> j) & 1u) && v > best) { best = v; bi = j; } }
            m |= 1u << bi; }
        sels[tid] = m; if (m) atomicOr(um, m);
    }
    __syncthreads();
    if (tid == 0) { int n = 0; const unsigned u0 = um[0];
        for (int t = 0; t < o / 64 + 2; ++t) tiles[n++] = blk * 256 + t * 64;
        for (int j = 0; j < blk; ++j) if ((u0 >> j) & 1u) for (int t = 0; t < 4; ++t) tiles[n++] = j * 256 + t * 64;
        um[1] = (unsigned)n; }
    __syncthreads();
    const unsigned msel = sels[16 * w + fr]; const int ntiles = (int)um[1];
    const int qpos = q0 + 16 * w + fr;
    const float SC = 0.12751743f;

    f32x4 oacc[8];
#pragma unroll
    for (int dt = 0; dt < 8; ++dt) oacc[dt] = (f32x4){0.f, 0.f, 0.f, 0.f};
    float m_run = -1.0e30f, l_run = 0.f;
    u32x4 kreg[2], vreg[2];
    const int lr = tid >> 3, lc = (tid & 7) * 16, vr = tid >> 2, vc = (tid & 3) * 16;
#define ATT_GLOAD(kpos_) do { const bf16_t* kp_ = Pb + (size_t)((kpos_) + lr) * DIN + 512 + h * 128 + lc; kreg[0] = *(const u32x4*)kp_; kreg[1] = *(const u32x4*)(kp_ + 8); \
        const bf16_t* vp_ = Vt + (size_t)vr * SEQ + (kpos_) + vc; vreg[0] = *(const u32x4*)vp_; vreg[1] = *(const u32x4*)(vp_ + 8); } while (0)
#define ATT_LSTORE(buf_) do { bf16_t* kd_ = Ks + (buf_) * 8704 + lr * 136 + lc; *(u32x4*)kd_ = kreg[0]; *(u32x4*)(kd_ + 8) = kreg[1]; \
        bf16_t* vd_ = Vs + (buf_) * 9216 + vr * 72 + vc; *(u32x4*)vd_ = vreg[0]; *(u32x4*)(vd_ + 8) = vreg[1]; } while (0)
    ATT_GLOAD(tiles[0]); ATT_LSTORE(0);
    __syncthreads();
#pragma unroll 1
    for (int it = 0; it < ntiles; ++it) {
        const int buf = it & 1, kpos = tiles[it];
        if (it + 1 < ntiles) ATT_GLOAD(tiles[it + 1]);
        const bf16_t* Kb = Ks + buf * 8704; const bf16_t* Vb = Vs + buf * 9216;
        f32x4 sacc[4];
#pragma unroll
        for (int T = 0; T < 4; ++T) {
            const int krow = 32 * (T >> 1) + 8 * (fr >> 2) + 4 * (T & 1) + (fr & 3);
            sacc[T] = (f32x4){0.f, 0.f, 0.f, 0.f};
#pragma unroll
            for (int kk = 0; kk < 4; ++kk) { const bf16x8 a = *(const bf16x8*)(Kb + krow * 136 + 32 * kk + 8 * fq); sacc[T] = MFMA16(a, Qf[kk], sacc[T]); }
        }
        const bool own = kpos >= blk * 256; const bool selok = (msel >> (kpos >> 8)) & 1u;
        float mx = m_run;
#pragma unroll
        for (int T = 0; T < 4; ++T)
#pragma unroll
            for (int j = 0; j < 4; ++j) { const int key = kpos + 32 * (T >> 1) + 8 * fq + 4 * (T & 1) + j; const bool ok = own ? (key <= qpos) : selok;
                const float s = ok ? sacc[T][j] * SC : -1.0e30f; sacc[T][j] = s; mx = fmaxf(mx, s); }
        mx = fmaxf(mx, __shfl_xor(mx, 16)); mx = fmaxf(mx, __shfl_xor(mx, 32));
        const float al = __builtin_amdgcn_exp2f(m_run - mx); m_run = mx;
        float ps = 0.f;
#pragma unroll
        for (int T = 0; T < 4; ++T)
#pragma unroll
            for (int j = 0; j < 4; ++j) { const float pv = __builtin_amdgcn_exp2f(sacc[T][j] - mx); sacc[T][j] = pv; ps += pv; }
        l_run = l_run * al + ps;
#pragma unroll
        for (int dt = 0; dt < 8; ++dt) oacc[dt] *= al;
#pragma unroll
        for (int G = 0; G < 2; ++G) {
            const bf16x8 pb = pack8(sacc[2 * G][0], sacc[2 * G][1], sacc[2 * G][2], sacc[2 * G][3], sacc[2 * G + 1][0], sacc[2 * G + 1][1], sacc[2 * G + 1][2], sacc[2 * G + 1][3]);
#pragma unroll
            for (int dt = 0; dt < 8; ++dt) { const bf16x8 a = *(const bf16x8*)(Vb + (16 * dt + fr) * 72 + 32 * G + 8 * fq); oacc[dt] = MFMA16(a, pb, oacc[dt]); }
        }
        if (it + 1 < ntiles) ATT_LSTORE(buf ^ 1);
        __syncthreads();
    }
#undef ATT_GLOAD
#undef ATT_LSTORE
    float l = l_run + __shfl_xor(l_run, 16); l += __shfl_xor(l, 32);
    const float inv = 1.0f / l;
    bf16_t* yrow = Y + ((size_t)b * SEQ + qpos) * DM + h * 128 + 4 * fq;
#pragma unroll
    for (int dt = 0; dt < 8; ++dt) { u32x2 w2; w2.x = cvt_pk_bf16(oacc[dt][0] * inv, oacc[dt][1] * inv); w2.y = cvt_pk_bf16(oacc[dt][2] * inv, oacc[dt][3] * inv); *(u32x2*)(yrow + 16 * dt) = w2; }
}

__device__ __forceinline__ void hgrn_item(const Params& p, int layer, int bh, unsigned char* smem) {
    const int tid = opaque_tid(), c = tid & 127, sg = tid >> 7, w = tid >> 6, lane = tid & 63, fr = lane & 15, fq = lane >> 4;
    const int b = bh >> 2, h = bh & 3;
    const bf16_t* P = (const bf16_t*)(p.ws + OFF_H);
    bf16_t* Y = (bf16_t*)(p.ws + OFF_XB);
    bf16_t* qs = (bf16_t*)smem; bf16_t* ks = (bf16_t*)(smem + 8704); bf16_t* kdT = (bf16_t*)(smem + 17408); bf16_t* vT = (bf16_t*)(smem + 27648);
    bf16_t* att = (bf16_t*)(smem + 37888); float* eL = (float*)(smem + 40448); float* seg = (float*)(smem + 40960); float* red = (float*)(smem + 43008);
    float lb = 0.f;
    if (layer == 1) lb = sigm(p.in[19][512 + h * 128 + c] - p.in[19][h * 128 + c]);
    const float omlb = 1.0f - lb;
    const float ngv = p.in[20][layer * 512 + h * 128 + 16 * w + fr];
    f32x4 S[8];
#pragma unroll
    for (int kt = 0; kt < 8; ++kt) S[kt] = (f32x4){0.f, 0.f, 0.f, 0.f};
    const bf16_t* Pq = P + (size_t)b * SEQ * DIN + 3584 + h * 128;
    unsigned short rq[8], rf[8], rv[8];
#pragma unroll
    for (int i = 0; i < 8; ++i) { const bf16_t* r = Pq + (size_t)(8 * sg + i) * DIN + c; rq[i] = r[0]; rf[i] = r[512]; rv[i] = r[1024]; }
#pragma unroll 1
    for (int chn = 0; chn < 128; ++chn) {
        const int t0 = chn * 32;
        float qv[8], kv[8], bl[8]; float run = 0.f;
#pragma unroll
        for (int i = 0; i < 8; ++i) { const float sg_ = sigm(bf2f(rf[i])); const float f = lb + omlb * sg_; run += __logf(f); bl[i] = run; kv[i] = omlb * (1.0f - sg_); qv[i] = bf2f(rq[i]); }
        seg[sg * 128 + c] = run;
        { u32x4 wv; wv.x = rv[0] | ((unsigned)rv[1] << 16); wv.y = rv[2] | ((unsigned)rv[3] << 16); wv.z = rv[4] | ((unsigned)rv[5] << 16); wv.w = rv[6] | ((unsigned)rv[7] << 16);
          *(u32x4*)(vT + c * 40 + sg * 8) = wv; }
        __syncthreads();
        unsigned short gq[2][4];
        {
            const float s0 = seg[c], s1 = seg[128 + c], s2 = seg[256 + c], s3 = seg[384 + c];
            const float off = (sg > 0 ? s0 : 0.f) + (sg > 1 ? s1 : 0.f) + (sg > 2 ? s2 : 0.f), btot = (s0 + s1) + (s2 + s3);
            float kd[8];
#pragma unroll
            for (int i = 0; i < 8; ++i) { const float bt = off + bl[i];
                qs[(8 * sg + i) * 136 + c] = f2bf(qv[i] * __expf(bt)); ks[(8 * sg + i) * 136 + c] = f2bf(kv[i] * __expf(-bt)); kd[i] = kv[i] * __expf(btot - bt); }
            *(bf16x8*)(kdT + c * 40 + sg * 8) = pack8(kd[0], kd[1], kd[2], kd[3], kd[4], kd[5], kd[6], kd[7]);
            if (sg == 0) eL[c] = __expf(btot);
            if (chn + 1 < 128) {
#pragma unroll
                for (int i = 0; i < 8; ++i) { const bf16_t* r = Pq + (size_t)(t0 + 32 + 8 * sg + i) * DIN + c; rq[i] = r[0]; rf[i] = r[512]; rv[i] = r[1024]; }
            }
#pragma unroll
            for (int tt = 0; tt < 2; ++tt)
#pragma unroll
                for (int j = 0; j < 4; ++j) gq[tt][j] = Pq[(size_t)(t0 + 16 * tt + 4 * fq + j) * DIN + 1536 + 16 * w + fr];
        }
        __syncthreads();
        f32x4 oacc[2] = {(f32x4){0.f, 0.f, 0.f, 0.f}, (f32x4){0.f, 0.f, 0.f, 0.f}};
        if (w < 3) {
            const int tt = (w + 1) >> 1, st = (w == 2) ? 1 : 0;
            f32x4 aa = {0.f, 0.f, 0.f, 0.f};
#pragma unroll
            for (int kk = 0; kk < 4; ++kk) { const bf16x8 a = *(const bf16x8*)(qs + (16 * tt + fr) * 136 + 32 * kk + 8 * fq); const bf16x8 bb = *(const bf16x8*)(ks + (16 * st + fr) * 136 + 32 * kk + 8 * fq); aa = MFMA16(a, bb, aa); }
#pragma unroll
            for (int j = 0; j < 4; ++j) { const int t = 16 * tt + 4 * fq + j, s = 16 * st + fr; att[t * 40 + s] = f2bf(s <= t ? aa[j] : 0.f); }
        } else if (w == 3) {
#pragma unroll
            for (int j = 0; j < 4; ++j) att[(4 * fq + j) * 40 + 16 + fr] = 0;
        }
#pragma unroll
        for (int kp = 0; kp < 4; ++kp) {
            const bf16x8 bS = pack8(S[2 * kp][0], S[2 * kp][1], S[2 * kp][2], S[2 * kp][3], S[2 * kp + 1][0], S[2 * kp + 1][1], S[2 * kp + 1][2], S[2 * kp + 1][3]);
#pragma unroll
            for (int tt = 0; tt < 2; ++tt) {
                const u32x2 lo = *(const u32x2*)(qs + (16 * tt + fr) * 136 + 32 * kp + 4 * fq), hi = *(const u32x2*)(qs + (16 * tt + fr) * 136 + 32 * kp + 16 + 4 * fq);
                u32x4 av; av.x = lo.x; av.y = lo.y; av.z = hi.x; av.w = hi.y;
                oacc[tt] = MFMA16(__builtin_bit_cast(bf16x8, av), bS, oacc[tt]);
            }
        }
        __syncthreads();
        {
            const bf16x8 bv = *(const bf16x8*)(vT + (16 * w + fr) * 40 + 8 * fq);
#pragma unroll
            for (int tt = 0; tt < 2; ++tt) { const bf16x8 a = *(const bf16x8*)(att + (16 * tt + fr) * 40 + 8 * fq); oacc[tt] = MFMA16(a, bv, oacc[tt]); }
#pragma unroll
            for (int tt = 0; tt < 2; ++tt)
#pragma unroll
                for (int j = 0; j < 4; ++j) { float sq = oacc[tt][j] * oacc[tt][j];
                    sq += __shfl_xor(sq, 1); sq += __shfl_xor(sq, 2); sq += __shfl_xor(sq, 4); sq += __shfl_xor(sq, 8);
                    if (fr == 0) red[w * 32 + 16 * tt + 4 * fq + j] = sq; }
#pragma unroll
            for (int kt = 0; kt < 8; ++kt) {
                const f32x4 e4 = *(const f32x4*)(eL + 16 * kt + 4 * fq);
                S[kt] = S[kt] * e4;
                const bf16x8 a = *(const bf16x8*)(kdT + (16 * kt + fr) * 40 + 8 * fq);
                S[kt] = MFMA16(a, bv, S[kt]);
            }
        }
        __syncthreads();
#pragma unroll
        for (int tt = 0; tt < 2; ++tt)
#pragma unroll
            for (int j = 0; j < 4; ++j) {
                const int t = 16 * tt + 4 * fq + j;
                float ss = 0.f;
#pragma unroll
                for (int w2 = 0; w2 < 8; ++w2) ss += red[w2 * 32 + t];
                const float rs = rsqrtf(ss * (1.0f / 128.0f) + LN_EPS);
                const float gg = bf2f(gq[tt][j]);
                Y[((size_t)b * SEQ + t0 + t) * DM + 1536 + h * 128 + 16 * w + fr] = f2bf(oacc[tt][j] * rs * ngv * gg * sigm(gg));
            }
    }
    __syncthreads();
}


#define PH_NOINLINE __forceinline__
__device__ PH_NOINLINE void gemm_gu(const bf16_t* A, const bf16_t* Bt, bf16_t* H) {
    extern __shared__ __attribute__((aligned(16))) unsigned char smem[];
    pg8::Gemm g{A, Bt, NTOK, 11264, 2048}; pg8::StaticOrder S; S.init(NTOK, 11264, (int)gridDim.x, (int)blockIdx.x); EpiSwiGLU E{H};
    pg8::gemm_phase((PG8_LAS unsigned char*)smem, g, S, E);
}
__device__ PH_NOINLINE void gemm_res(const bf16_t* A, const bf16_t* Bt, int K, const float* R, float* O, float s) {
    extern __shared__ __attribute__((aligned(16))) unsigned char smem[];
    pg8::Gemm g{A, Bt, NTOK, 2048, K}; pg8::StaticOrder S; S.init(NTOK, 2048, (int)gridDim.x, (int)blockIdx.x); EpiResid E{R, O, ALPHA, s};
    pg8::gemm_phase((PG8_LAS unsigned char*)smem, g, S, E);
}
__device__ PH_NOINLINE void gemm_in(const bf16_t* A, const bf16_t* Bt, bf16_t* O) {
    extern __shared__ __attribute__((aligned(16))) unsigned char smem[];
    pg8::Gemm g{A, Bt, NTOK, 5632, 2048}; pg8::StaticOrder S; S.init(NTOK, 5632, (int)gridDim.x, (int)blockIdx.x); EpiBf16P E{O, DIN};
    pg8::gemm_phase((PG8_LAS unsigned char*)smem, g, S, E);
}
__device__ __forceinline__ void run_phase(const Params& p, int ph, unsigned char* smem) {
    if (ph == 0) { phase_convert(p, smem); return; }
    const int l = (ph - 1) / 11, k = (ph - 1) % 11;
    bf16_t* XB = (bf16_t*)(p.ws + OFF_XB); bf16_t* H = (bf16_t*)(p.ws + OFF_H); float* X = (float*)(p.ws + OFF_X);
    if (k == 0 || k == 8) {
        const int f = (k == 8);
        gemm_gu(XB, (const bf16_t*)(p.ws + OFF_GU + (size_t)(l * 2 + f) * SZ_GU), H);
    } else if (k == 1 || k == 9) {
        const int f = (k == 9);
        gemm_res(H, (const bf16_t*)(p.ws + OFF_DN + (size_t)(l * 2 + f) * SZ_DN), 5632, (l == 0 && f == 0) ? p.in[0] : X, X, 0.5f);
    } else if (k == 2 || k == 7 || k == 10) {
        const int i = (k == 2) ? 0 : (k == 7 ? 1 : 2);
        float* dst = (l == 1 && i == 2) ? p.out : X;
        phase_ln(X, dst, XB, p.in[1] + (size_t)(l * 3 + i) * DM, p.in[2] + (size_t)(l * 3 + i) * DM);
    } else if (k == 3) {
        gemm_in(XB, (const bf16_t*)(p.ws + OFF_IN + (size_t)l * SZ_IN), H);
    } else if (k == 4) {
        for (int it = blockIdx.x; it < 1536; it += gridDim.x) {
            if (it < 256) kvpre_item(p, it, smem);
            else if (it < 512) convc_item(p, l, it - 256, smem);
            else rgpre_item(p, l, it - 512, smem);
        }
    } else if (k == 5) {
        unsigned* ctr = (unsigned*)(p.ws + OFF_CTL) + l * 64;
        int* s_item = (int*)(smem + LDS_BYTES - 16);
        for (;;) {
            __syncthreads();
            if (threadIdx.x == 0) *s_item = (int)atomicAdd(ctr, 1u);
            __syncthreads();
            const int it = *s_item;
            if (it >= 784) break;
            if (it < 16) hgrn_item(p, l, it, smem);
            else if (it < 528) attn_item(p, it - 16, smem);
            else rgpost_item(p, it - 528);
        }
    } else if (k == 6) {
        gemm_res(XB, (const bf16_t*)(p.ws + OFF_OUT + (size_t)l * SZ_OUT), 2048, X, X, 1.0f);
    }
}

#ifndef MK_N_LAUNCHES
#define MK_N_LAUNCHES 23
#endif

__global__ void __launch_bounds__(512, 2) mega_fwd(Params p) {
    extern __shared__ __attribute__((aligned(16))) unsigned char smem[];
    for (int ph = p.ph_lo; ph < p.ph_hi; ++ph) {
        if (ph > p.ph_lo) cg::this_grid().sync();
        run_phase(p, ph, smem);
    }
}

extern "C" void kernel_launch(void* const* d_in, const int* in_sizes, int n_in, void* d_out, int out_size, void* d_ws, size_t ws_size, hipStream_t stream) {
    static int grid = 0;
    if (grid == 0) {
        if (n_in != 21 || ws_size < WS_END) { fprintf(stderr, "kernel_launch: unexpected n_in %d / ws_size %zu (need %zu)\n", n_in, ws_size, (size_t)WS_END); grid = -1; return; }
        int dev = 0, cus = 0, per_cu = 0;
        hipGetDevice(&dev);
        hipDeviceGetAttribute(&cus, hipDeviceAttributeMultiprocessorCount, dev);
        if (hipFuncSetAttribute((const void*)mega_fwd, hipFuncAttributeMaxDynamicSharedMemorySize, LDS_BYTES) != hipSuccess) { fprintf(stderr, "kernel_launch: hipFuncSetAttribute failed\n"); grid = -1; return; }
        if (hipOccupancyMaxActiveBlocksPerMultiprocessor(&per_cu, (const void*)mega_fwd, 512, LDS_BYTES) != hipSuccess || per_cu < 1) { fprintf(stderr, "kernel_launch: occupancy query says %d\n", per_cu); per_cu = 1; }
        (void)hipGetLastError();
        grid = cus * per_cu;
        fprintf(stderr, "kernel_launch: grid %d (cus %d x %d)\n", grid, cus, per_cu);
    }
    if (grid < 0) return;
    (void)in_sizes; (void)out_size;
    hipMemsetAsync((char*)d_ws + OFF_CTL, 0, 4096, stream);
    Params p{};
    for (int i = 0; i < 21; ++i) p.in[i] = (const float*)d_in[i];
    p.out = (float*)d_out; p.ws = (unsigned char*)d_ws;
#if MK_N_LAUNCHES == 1
    p.ph_lo = 0; p.ph_hi = NPHASE;
    void* args[] = {&p};
    hipError_t e = hipLaunchCooperativeKernel((const void*)mega_fwd, dim3(grid), dim3(512), args, LDS_BYTES, stream);
    if (e != hipSuccess) fprintf(stderr, "kernel_launch: cooperative launch failed: %s (grid %d)\n", hipGetErrorString(e), grid);
#else
    for (int ph = 0; ph < NPHASE; ++ph) {
        p.ph_lo = ph; p.ph_hi = ph + 1;
        hipLaunchKernelGGL(mega_fwd, dim3(grid), dim3(512), LDS_BYTES, stream, p);
    }
#endif
}
```

```cpp
#include <hip/hip_runtime.h>
#include <hip/hip_cooperative_groups.h>
#include <cstdio>
#include <cstdint>
namespace cg = cooperative_groups;
namespace pg8 {
#define PG8_LAS __attribute__((address_space(3)))
typedef unsigned short bf16_t;
typedef short bf16x8 __attribute__((ext_vector_type(8)));
typedef float f32x4 __attribute__((ext_vector_type(4)));
typedef unsigned u32x4 __attribute__((ext_vector_type(4)));
constexpr int BM = 256, BK = 64, HALF = 128, HTB = HALF * BK * 2  , STAGE_BYTES = 8 * HTB, NXCD = 8, WGM = 8;

__host__ __device__ __forceinline__ int lds_byte(int r, int c) { const int st = (r >> 4) * 2 + (c >> 5), rr = r & 15, cc = c & 31, ob = rr * 64 + cc * 2; return st * 1024 + (ob ^ (((ob >> 9) & 1) << 5)); }
__host__ __device__ __forceinline__ void stage_rc(int b, int& R, int& C) { const int st = b / 1024, sb = b % 1024, swz = sb ^ (((sb >> 9) & 1) << 5); R = (st >> 1) * 16 + swz / 64; C = (st & 1) * 32 + (swz % 64) / 2; }
__host__ __device__ __forceinline__ int perm32(int rho) { const int n = rho >> 4, i = rho & 15; return 8 * (i >> 2) + 4 * n + (i & 3); }

struct Unit { int pm, pn; };
struct Gemm { const bf16_t* A; const bf16_t* Bt; int M, N, K; };

struct StaticOrder {
    int nM, nN, nwg, G, c;
    __host__ __device__ void init(int M, int N, int G_, int c_) { nM = M / BM; nN = N / BM; nwg = nM * nN; G = G_; c = c_; }
    __host__ __device__ bool next(int i, Unit& u) const {
        const long L = (long)i * G + c; if (L >= nwg) return false;
        int wgid = (int)L; { const int q = nwg / NXCD, r = nwg % NXCD, xcd = wgid % NXCD, off = wgid / NXCD; wgid = (xcd < r ? xcd * (q + 1) : r * (q + 1) + (xcd - r) * q) + off; }
        const int nig = WGM * nN, gid = wgid / nig, fm = gid * WGM, gsz = (nM - fm) < WGM ? (nM - fm) : WGM;
        u.pm = fm + ((wgid % nig) % gsz); u.pn = (wgid % nig) / gsz; return true;
    }
    __device__ __forceinline__ void a_ready(const Unit&) const {}
    __device__ __forceinline__ void done(const Unit&) const {}
};
__device__ __forceinline__ unsigned cvt_pk_bf16(float lo, float hi) { unsigned r; asm volatile("v_cvt_pk_bf16_f32 %0, %1, %2" : "=v"(r) : "v"(lo), "v"(hi)); return r; }
template <class Epi, class Sched>
__device__ __forceinline__ void gemm_phase(PG8_LAS unsigned char* lds, const Gemm g, const Sched& S, const Epi& E) {
    int tid_ = threadIdx.x; asm volatile("" : "+v"(tid_)); const int tid = tid_, wid = __builtin_amdgcn_readfirstlane(tid >> 6), lane = tid & 63, wr = wid >> 2, wc = wid & 3, fr = lane & 15, fq = lane >> 4;
    const int K = g.K, nt = K / BK;
    unsigned voffA[2], voffB[2];
#pragma unroll
    for (int i = 0; i < 2; ++i) { int R, C; stage_rc(tid * 16 + i * 8192, R, C); const int Rb = Epi::PERM ? ((R & ~31) + perm32(R & 31)) : R;
        voffA[i] = (unsigned)(R * K + C) * 2u; voffB[i] = (unsigned)(Rb * K + C) * 2u; }
    const size_t kstep = (size_t)(BK * 2);
    const size_t hstep = (size_t)HALF * K * 2;
    const size_t tstep = 2 * hstep;
    const unsigned ldsw = (unsigned)wid * 1024u;
    const int aoff = lds_byte(wr * 64 + fr, fq * 8), boff = lds_byte(wc * 32 + fr, fq * 8);
#define PG8_SA(b, h) (((b) * 2 + (h)) * HTB)
#define PG8_SB(b, h) ((4 + (b) * 2 + (h)) * HTB)
#define PG8_STAGE(bufoff, gbase, voff) do { _Pragma("unroll") for (int _i = 0; _i < 2; ++_i) \
        __builtin_amdgcn_global_load_lds((const unsigned*)((const char*)(gbase) + (voff)[_i]), (PG8_LAS unsigned*)(lds + (bufoff) + ldsw + _i * 8192), 16, 0, 0); } while (0)
#define PG8_LDA(dst, b, h) do { _Pragma("unroll") for (int m = 0; m < 4; ++m) _Pragma("unroll") for (int k = 0; k < 2; ++k) dst[m][k] = *(const PG8_LAS bf16x8*)(lds + PG8_SA(b, h) + aoff + m * 2048 + k * 1024); } while (0)
#define PG8_LDB(dst, b, h) do { _Pragma("unroll") for (int n = 0; n < 2; ++n) _Pragma("unroll") for (int k = 0; k < 2; ++k) dst[n][k] = *(const PG8_LAS bf16x8*)(lds + PG8_SB(b, h) + boff + n * 2048 + k * 1024); } while (0)
#define PG8_MMA(ai, bj, At, Bt) do { __builtin_amdgcn_s_setprio(1); _Pragma("unroll") for (int m = 0; m < 4; ++m) _Pragma("unroll") for (int n = 0; n < 2; ++n) _Pragma("unroll") for (int k = 0; k < 2; ++k) \
        acc[ai][bj][m][n] = __builtin_amdgcn_mfma_f32_16x16x32_bf16(Bt[n][k], At[m][k], acc[ai][bj][m][n], 0, 0, 0); __builtin_amdgcn_s_setprio(0); } while (0)
#define PG8_WAIT_V(n) asm volatile("s_waitcnt vmcnt(" #n ")" ::: "memory")
#define PG8_WAIT_L(n) asm volatile("s_waitcnt lgkmcnt(" #n ")" ::: "memory")
#define PG8_BAR __builtin_amdgcn_s_barrier()
#define PG8_SCHED __builtin_amdgcn_sched_barrier(0)
    Unit cur, nxt; int ui = 0;
    if (!S.next(0, cur)) return;
    f32x4 acc[2][2][4][2];
#pragma unroll
    for (int a = 0; a < 2; ++a)
#pragma unroll
        for (int b = 0; b < 2; ++b)
#pragma unroll
            for (int m = 0; m < 4; ++m)
#pragma unroll
                for (int n = 0; n < 2; ++n) acc[a][b][m][n] = (f32x4){0.f, 0.f, 0.f, 0.f};
    bf16x8 At[4][2], B0[2][2], B1[2][2];
    const char* cA = (const char*)g.A + (size_t)cur.pm * tstep; const char* cB = (const char*)g.Bt + (size_t)cur.pn * tstep;
    S.a_ready(cur);
    PG8_STAGE(PG8_SB(0, 0), cB, voffB); PG8_STAGE(PG8_SA(0, 0), cA, voffA); PG8_STAGE(PG8_SB(0, 1), cB + hstep, voffB); PG8_STAGE(PG8_SA(0, 1), cA + hstep, voffA);
    if (wr == 1) PG8_BAR;
    PG8_WAIT_V(4); PG8_BAR;
    PG8_STAGE(PG8_SB(1, 0), cB + kstep, voffB); PG8_STAGE(PG8_SA(1, 0), cA + kstep, voffA); PG8_STAGE(PG8_SB(1, 1), cB + hstep + kstep, voffB);
    PG8_WAIT_V(6); PG8_BAR;
    for (;;) {
        const bool has_next = S.next(ui + 1, nxt);
        const char* nA = has_next ? (const char*)g.A + (size_t)nxt.pm * tstep : cA; const char* nB = has_next ? (const char*)g.Bt + (size_t)nxt.pn * tstep : cB;
        for (int t = 0; t < nt; t += 2) {
            const bool last = (t == nt - 2);
            const char* a1 = cA + (size_t)(t + 1) * kstep;
            const char* a2 = last ? nA : cA + (size_t)(t + 2) * kstep; const char* b2 = last ? nB : cB + (size_t)(t + 2) * kstep;
            const char* a3 = a2 + kstep; const char* b3 = b2 + kstep;
            if (last && has_next) S.a_ready(nxt);
            PG8_LDB(B0, 0, 0); PG8_SCHED; PG8_LDA(At, 0, 0); PG8_STAGE(PG8_SA(1, 1), a1 + hstep, voffA);
            PG8_WAIT_L(8); PG8_BAR; PG8_WAIT_L(0); PG8_MMA(0, 0, At, B0); PG8_BAR; PG8_SCHED;
            PG8_LDB(B1, 0, 1); PG8_STAGE(PG8_SB(0, 0), b2, voffB);
            PG8_BAR; PG8_WAIT_L(0); PG8_MMA(0, 1, At, B1); PG8_BAR;
            PG8_LDA(At, 0, 1); PG8_STAGE(PG8_SA(0, 0), a2, voffA);
            PG8_BAR; PG8_WAIT_L(0); PG8_MMA(1, 0, At, B0); PG8_BAR; PG8_SCHED;
            PG8_STAGE(PG8_SB(0, 1), b2 + hstep, voffB);
            PG8_WAIT_V(6); PG8_BAR; PG8_MMA(1, 1, At, B1); PG8_BAR;
            PG8_LDB(B0, 1, 0); PG8_SCHED; PG8_LDA(At, 1, 0); PG8_STAGE(PG8_SA(0, 1), a2 + hstep, voffA);
            PG8_WAIT_L(8); PG8_BAR; PG8_WAIT_L(0); PG8_MMA(0, 0, At, B0); PG8_BAR; PG8_SCHED;
            PG8_LDB(B1, 1, 1); PG8_STAGE(PG8_SB(1, 0), b3, voffB);
            PG8_BAR; PG8_WAIT_L(0); PG8_MMA(0, 1, At, B1); PG8_BAR;
            PG8_LDA(At, 1, 1); PG8_STAGE(PG8_SA(1, 0), a3, voffA);
            PG8_BAR; PG8_WAIT_L(0); PG8_MMA(1, 0, At, B0); PG8_BAR; PG8_SCHED;
            PG8_STAGE(PG8_SB(1, 1), b3 + hstep, voffB);
            PG8_WAIT_V(6); PG8_BAR; PG8_MMA(1, 1, At, B1); PG8_BAR;
        }
        if constexpr (!Epi::AFTER_DRAIN) { E(acc, cur, wr, wc, fr, fq); S.done(cur); }
        if (!has_next) break;
#pragma unroll
        for (int a = 0; a < 2; ++a)
#pragma unroll
            for (int b = 0; b < 2; ++b)
#pragma unroll
                for (int m = 0; m < 4; ++m)
#pragma unroll
                    for (int n = 0; n < 2; ++n) acc[a][b][m][n] = (f32x4){0.f, 0.f, 0.f, 0.f};
        cur = nxt; cA = nA; cB = nB; ++ui;
    }
    PG8_WAIT_V(0);
    if (wr == 0) PG8_BAR;
    PG8_BAR;
    if constexpr (Epi::AFTER_DRAIN) { E.fused(acc, cur, wr, wc, fr, fq, lds, wid, lane); S.done(cur); }
#undef PG8_SA
#undef PG8_SB
#undef PG8_STAGE
#undef PG8_LDA
#undef PG8_LDB
#undef PG8_MMA
#undef PG8_WAIT_V
#undef PG8_WAIT_L
#undef PG8_BAR
#undef PG8_SCHED
}
}

using pg8::bf16_t; using pg8::bf16x8; using pg8::f32x4; using pg8::u32x4; using pg8::cvt_pk_bf16;
typedef unsigned u32x2 __attribute__((ext_vector_type(2)));

constexpr int NTOK = 16384, DM = 2048, DFF = 5632, DIN = 5632, SEQ = 4096;
constexpr float LN_EPS = 1e-5f;
constexpr float ALPHA = 1.41421356237f;
constexpr int LDS_BYTES = 147456;
constexpr int NPHASE = 25;

constexpr size_t SZ_GU = (size_t)11264 * 2048 * 2, SZ_DN = (size_t)2048 * 5632 * 2, SZ_IN = (size_t)5632 * 2048 * 2,
                 SZ_OUT = (size_t)2048 * 2048 * 2, SZ_RG = (size_t)4 * 128 * 128 * 2;
constexpr size_t OFF_CTL = 0, CTL_BYTES = 32768, OFF_GU = CTL_BYTES, OFF_DN = OFF_GU + 4 * SZ_GU, OFF_IN = OFF_DN + 4 * SZ_DN, OFF_OUT = OFF_IN + 2 * SZ_IN,
                 OFF_RGA = OFF_OUT + 2 * SZ_OUT, OFF_RGX = OFF_RGA + 2 * SZ_RG, OFF_X = OFF_RGX + 2 * SZ_RG,
                 OFF_XB = OFF_X + (size_t)NTOK * DM * 4, OFF_H = OFF_XB + (size_t)NTOK * DM * 2,
                 OFF_KMEAN = OFF_H + (size_t)NTOK * DFF * 2, OFF_ATILE = OFF_KMEAN + 131072, OFF_HTILE = OFF_ATILE + 524288,
                 OFF_HQS = OFF_HTILE + 524288, OFF_HKDT = OFF_HQS + 16777216, OFF_HVT = OFF_HKDT + 16777216, OFF_HEL = OFF_HVT + 16777216,
                 OFF_HGS = OFF_HEL + 1048576, OFF_STATS = OFF_HGS + 33554432, OFF_GB = OFF_STATS + 131072, WS_END = OFF_GB + 16384;
constexpr size_t OUT_HLOC = 0, OUT_CUMA = 33554432, OUT_VT = 67108864, OUT_OI = 83886080;

struct Params { const float* in[21]; float* out; unsigned char* ws; int ph_lo, ph_hi; };

__device__ __forceinline__ float bf2f(unsigned short u) { return __uint_as_float(((unsigned)u) << 16); }
__device__ __forceinline__ unsigned short f2bf(float f) { unsigned u = __float_as_uint(f); u += 0x7FFFu + ((u >> 16) & 1u); return (unsigned short)(u >> 16); }
__device__ __forceinline__ float sigm(float x) { return __builtin_amdgcn_rcpf(1.0f + __expf(-x)); }
__device__ __forceinline__ bf16x8 pack8(float a0, float a1, float a2, float a3, float a4, float a5, float a6, float a7) {
    u32x4 w; w.x = cvt_pk_bf16(a0, a1); w.y = cvt_pk_bf16(a2, a3); w.z = cvt_pk_bf16(a4, a5); w.w = cvt_pk_bf16(a6, a7);
    return __builtin_bit_cast(bf16x8, w);
}
__device__ __forceinline__ int opaque_tid() { int t = threadIdx.x; asm volatile("" : "+v"(t)); return t; }
__device__ __forceinline__ float row16_sum_to15(float x) {
    x += __int_as_float(__builtin_amdgcn_update_dpp(0, __float_as_int(x), 0x111, 0xf, 0xf, true));
    x += __int_as_float(__builtin_amdgcn_update_dpp(0, __float_as_int(x), 0x112, 0xf, 0xf, true));
    x += __int_as_float(__builtin_amdgcn_update_dpp(0, __float_as_int(x), 0x114, 0xf, 0xf, true));
    x += __int_as_float(__builtin_amdgcn_update_dpp(0, __float_as_int(x), 0x118, 0xf, 0xf, true));
    return x;
}
__device__ __forceinline__ void lds_barrier() { asm volatile("s_waitcnt lgkmcnt(0)" ::: "memory"); __builtin_amdgcn_s_barrier(); asm volatile("" ::: "memory"); }
__device__ __forceinline__ u32x2 pack4(f32x4 v) { u32x2 w; w.x = cvt_pk_bf16(v[0], v[1]); w.y = cvt_pk_bf16(v[2], v[3]); return w; }
__device__ __forceinline__ f32x4 unpack4(u32x2 w) { return (f32x4){__uint_as_float(w.x << 16), __uint_as_float(w.x & 0xffff0000u), __uint_as_float(w.y << 16), __uint_as_float(w.y & 0xffff0000u)}; }
typedef _Float16 h16x4 __attribute__((ext_vector_type(4)));
__device__ __forceinline__ u32x2 pack4h(f32x4 v) { const h16x4 h = __builtin_convertvector(v, h16x4); return __builtin_bit_cast(u32x2, h); }
__device__ __forceinline__ f32x4 unpack4h(u32x2 w) { return __builtin_convertvector(__builtin_bit_cast(h16x4, w), f32x4); }
#define MFMA16(a, b, c) __builtin_amdgcn_mfma_f32_16x16x32_bf16((a), (b), (c), 0, 0, 0)

struct EpiSwiGLU {
    static constexpr bool PERM = true, AFTER_DRAIN = false;
    bf16_t* H;
    __device__ __forceinline__ void operator()(const f32x4 (&acc)[2][2][4][2], const pg8::Unit& u, int wr, int wc, int fr, int fq) const {
        const int row0 = u.pm * 256 + wr * 64 + fr, col0 = u.pn * 128 + wc * 32 + 8 * fq;
#pragma unroll
        for (int ai = 0; ai < 2; ++ai)
#pragma unroll
            for (int m = 0; m < 4; ++m) {
                bf16_t* rowp = H + (size_t)(row0 + ai * 128 + m * 16) * DFF + col0;
                float hv[8];
#pragma unroll
                for (int n = 0; n < 2; ++n)
#pragma unroll
                    for (int j = 0; j < 4; ++j) { const float g = acc[ai][0][m][n][j], up = acc[ai][1][m][n][j]; hv[n * 4 + j] = g * sigm(g) * up; }
                u32x4 w; w.x = cvt_pk_bf16(hv[0], hv[1]); w.y = cvt_pk_bf16(hv[2], hv[3]); w.z = cvt_pk_bf16(hv[4], hv[5]); w.w = cvt_pk_bf16(hv[6], hv[7]);
                __builtin_nontemporal_store(w, (u32x4*)rowp);
            }
    }
};
struct EpiResid {
    static constexpr bool PERM = true, AFTER_DRAIN = false;
    unsigned char* ws; const float* Rraw; float* Oalt; float s;
    __device__ __forceinline__ void operator()(const f32x4 (&acc)[2][2][4][2], const pg8::Unit& u, int wr, int wc, int fr_, int fq_) const {
        int fr = fr_, fq = fq_; asm volatile("" : "+v"(fr), "+v"(fq));
        const int row0 = u.pm * 256 + wr * 64 + fr, col0 = u.pn * 256 + wc * 32 + 8 * fq;
        const bool ln = (Rraw == nullptr);
        bf16_t* Z = (bf16_t*)(ws + OFF_X);
        const float* st = (const float*)(ws + OFF_STATS); const float* gb = (const float*)(ws + OFF_GB);
        if (ln) {
#pragma unroll
            for (int bj = 0; bj < 2; ++bj) {
                f32x4 gv[2], bv[2];
#pragma unroll
                for (int n = 0; n < 2; ++n) { gv[n] = *(const f32x4*)(gb + col0 + bj * 128 + 4 * n); bv[n] = *(const f32x4*)(gb + DM + col0 + bj * 128 + 4 * n); }
                u32x4 r[2][4]; float mu[2][4], rs[2][4];
#pragma unroll
                for (int ai = 0; ai < 2; ++ai)
#pragma unroll
                    for (int m = 0; m < 4; ++m) { const int row = row0 + ai * 128 + m * 16; const unsigned off = (unsigned)row * DM + (unsigned)(col0 + bj * 128);
                        { const float2 ms = *(const float2*)(st + 2u * (unsigned)row); mu[ai][m] = ms.x; rs[ai][m] = ms.y; }
                        r[ai][m] = *(const u32x4*)(Z + off); }
                asm volatile("" ::: "memory");
#pragma unroll
                for (int ai = 0; ai < 2; ++ai)
#pragma unroll
                    for (int m = 0; m < 4; ++m) { const unsigned off = (unsigned)(row0 + ai * 128 + m * 16) * DM + (unsigned)(col0 + bj * 128);
                        u32x2 lo, hi; lo.x = r[ai][m].x; lo.y = r[ai][m].y; hi.x = r[ai][m].z; hi.y = r[ai][m].w;
                        const f32x4 x0 = (unpack4h(lo) - mu[ai][m]) * rs[ai][m] * gv[0] + bv[0], x1 = (unpack4h(hi) - mu[ai][m]) * rs[ai][m] * gv[1] + bv[1];
                        const u32x2 o0 = pack4h(x0 * ALPHA + acc[ai][bj][m][0] * s), o1 = pack4h(x1 * ALPHA + acc[ai][bj][m][1] * s);
                        u32x4 w; w.x = o0.x; w.y = o0.y; w.z = o1.x; w.w = o1.y; *(u32x4*)(Z + off) = w; }
            }
        } else {
#pragma unroll
            for (int bj = 0; bj < 2; ++bj)
#pragma unroll
                for (int ai = 0; ai < 2; ++ai) {
                    f32x4 r[4][2];
#pragma unroll
                    for (int m = 0; m < 4; ++m) { const size_t off = (size_t)(row0 + ai * 128 + m * 16) * DM + col0 + bj * 128;
#pragma unroll
                        for (int n = 0; n < 2; ++n) r[m][n] = *(const f32x4*)(Rraw + off + 4 * n); }
                    asm volatile("" ::: "memory");
#pragma unroll
                    for (int m = 0; m < 4; ++m) { const size_t off = (size_t)(row0 + ai * 128 + m * 16) * DM + col0 + bj * 128;
                        const u32x2 o0 = pack4h(r[m][0] * ALPHA + acc[ai][bj][m][0] * s), o1 = pack4h(r[m][1] * ALPHA + acc[ai][bj][m][1] * s);
                        u32x4 w; w.x = o0.x; w.y = o0.y; w.z = o1.x; w.w = o1.y; *(u32x4*)(Z + off) = w; }
                }
        }
    }
};
struct EpiBf16P {
    static constexpr bool PERM = true, AFTER_DRAIN = false;
    bf16_t* O; int ldc;
    __device__ __forceinline__ void operator()(const f32x4 (&acc)[2][2][4][2], const pg8::Unit& u, int wr, int wc, int fr, int fq) const {
        const int row0 = u.pm * 256 + wr * 64 + fr, col0 = u.pn * 256 + wc * 32 + 8 * fq;
#pragma unroll
        for (int ai = 0; ai < 2; ++ai)
#pragma unroll
            for (int m = 0; m < 4; ++m) {
                bf16_t* rowp = O + (size_t)(row0 + ai * 128 + m * 16) * ldc + col0;
#pragma unroll
                for (int bj = 0; bj < 2; ++bj) { const f32x4 v0 = acc[ai][bj][m][0], v1 = acc[ai][bj][m][1];
                    u32x4 w; w.x = cvt_pk_bf16(v0[0], v0[1]); w.y = cvt_pk_bf16(v0[2], v0[3]); w.z = cvt_pk_bf16(v1[0], v1[1]); w.w = cvt_pk_bf16(v1[2], v1[3]);
                    __builtin_nontemporal_store(w, (u32x4*)(rowp + bj * 128)); }
            }
    }
};

__device__ __forceinline__ void convT_job(const float* __restrict__ src, bf16_t* __restrict__ dst, int K, int N, int mode, float* t) {
    const int tid = opaque_tid(), ntn = N >> 6, ntiles = (K >> 7) * ntn;
    const int lk = tid >> 4, ln4 = (tid & 15) * 4;
    float4 pv[4];
#define CVT_LOAD(tile_) do { const int k0_ = ((tile_) / ntn) << 7, n0_ = ((tile_) % ntn) << 6; \
        _Pragma("unroll") for (int pp = 0; pp < 4; ++pp) pv[pp] = *(const float4*)(src + (size_t)(k0_ + lk + 32 * pp) * N + n0_ + ln4); } while (0)
    int tile = blockIdx.x;
    if (tile < ntiles) CVT_LOAD(tile);
#pragma unroll 1
    for (; tile < ntiles; tile += gridDim.x) {
        const int k0 = (tile / ntn) << 7, n0 = (tile % ntn) << 6;
#pragma unroll
        for (int pp = 0; pp < 4; ++pp) { const int k = lk + 32 * pp; t[k * 65 + ln4] = pv[pp].x; t[k * 65 + ln4 + 1] = pv[pp].y; t[k * 65 + ln4 + 2] = pv[pp].z; t[k * 65 + ln4 + 3] = pv[pp].w; }
        if (tile + (int)gridDim.x < ntiles) CVT_LOAD(tile + (int)gridDim.x);
        lds_barrier();
        const int n = tid >> 3, k16 = (tid & 7) * 16;
        float v[16];
#pragma unroll
        for (int j = 0; j < 16; ++j) v[j] = t[(k16 + j) * 65 + n];
        const int nn = n0 + n;
        const int row = mode == 0 ? nn : (256 * (nn >> 7) + (nn & 127) + (mode == 2 ? 128 : 0));
        u32x4 w0, w1; w0.x = cvt_pk_bf16(v[0], v[1]); w0.y = cvt_pk_bf16(v[2], v[3]); w0.z = cvt_pk_bf16(v[4], v[5]); w0.w = cvt_pk_bf16(v[6], v[7]);
        w1.x = cvt_pk_bf16(v[8], v[9]); w1.y = cvt_pk_bf16(v[10], v[11]); w1.z = cvt_pk_bf16(v[12], v[13]); w1.w = cvt_pk_bf16(v[14], v[15]);
        bf16_t* d = dst + (size_t)row * K + k0 + k16;
        *(u32x4*)d = w0; *(u32x4*)(d + 8) = w1;
        lds_barrier();
    }
#undef CVT_LOAD
}
__device__ __forceinline__ void phase_convert(const Params& p, unsigned char* smem) {
    float* t = (float*)smem;
    for (int l = 0; l < 2; ++l) {
        for (int f = 0; f < 2; ++f) {
            const size_t wo = (size_t)(l * 2 + f) * 2048 * 5632;
            bf16_t* gu = (bf16_t*)(p.ws + OFF_GU + (size_t)(l * 2 + f) * SZ_GU);
            convT_job(p.in[3] + wo, gu, 2048, 5632, 1, t);
            convT_job(p.in[4] + wo, gu, 2048, 5632, 2, t);
            convT_job(p.in[5] + wo, (bf16_t*)(p.ws + OFF_DN + (size_t)(l * 2 + f) * SZ_DN), 5632, 2048, 0, t);
        }
        convT_job(p.in[6] + (size_t)l * 2048 * 5632, (bf16_t*)(p.ws + OFF_IN + (size_t)l * SZ_IN), 2048, 5632, 0, t);
        convT_job(p.in[7] + (size_t)l * 2048 * 2048, (bf16_t*)(p.ws + OFF_OUT + (size_t)l * SZ_OUT), 2048, 2048, 0, t);
        for (int g = 0; g < 4; ++g) {
            convT_job(p.in[10] + (size_t)(l * 4 + g) * 16384, (bf16_t*)(p.ws + OFF_RGA + (size_t)l * SZ_RG) + g * 16384, 128, 128, 0, t);
            convT_job(p.in[12] + (size_t)(l * 4 + g) * 16384, (bf16_t*)(p.ws + OFF_RGX + (size_t)l * SZ_RG) + g * 16384, 128, 128, 0, t);
        }
    }
    const float4* xs = (const float4*)p.in[0]; u32x2* xd = (u32x2*)(p.ws + OFF_XB);
    const size_t n4 = (size_t)NTOK * DM / 4, gstr = (size_t)gridDim.x * 512;
    size_t i = (size_t)blockIdx.x * 512 + opaque_tid();
    for (; i + 7 * gstr < n4; i += 8 * gstr) {
        float4 v[8];
#pragma unroll
        for (int k = 0; k < 8; ++k) v[k] = xs[i + k * gstr];
#pragma unroll
        for (int k = 0; k < 8; ++k) { u32x2 w; w.x = cvt_pk_bf16(v[k].x, v[k].y); w.y = cvt_pk_bf16(v[k].z, v[k].w); xd[i + k * gstr] = w; }
    }
    for (; i < n4; i += gstr) { const float4 v = xs[i]; u32x2 w; w.x = cvt_pk_bf16(v.x, v.y); w.y = cvt_pk_bf16(v.z, v.w); xd[i] = w; }
}

__device__ __forceinline__ void phase_ln(const bf16_t* zin, float* xout, bf16_t* xb, float* stats, float* gbtab, const float* __restrict__ g, const float* __restrict__ b) {
    const int tid_ln = opaque_tid(); const int wave = tid_ln >> 6, lane = tid_ln & 63;
    if (gbtab && blockIdx.x == 0) { for (int i = tid_ln; i < DM; i += 512) { gbtab[i] = g[i]; gbtab[DM + i] = b[i]; } }
    const int rstep = gridDim.x * 8;
    int row = blockIdx.x * 8 + wave;
    u32x4 nv[4];
    if (row < NTOK) { const u32x4* src = (const u32x4*)(zin + (size_t)row * DM);
#pragma unroll
        for (int i = 0; i < 4; ++i) nv[i] = src[lane + 64 * i]; }
#pragma unroll 1
    for (; row < NTOK; row += rstep) {
        f32x4 v[8]; float s = 0.f;
#pragma unroll
        for (int i = 0; i < 4; ++i) { u32x2 lo, hi; lo.x = nv[i].x; lo.y = nv[i].y; hi.x = nv[i].z; hi.y = nv[i].w; v[2 * i] = unpack4h(lo); v[2 * i + 1] = unpack4h(hi); }
#pragma unroll
        for (int i = 0; i < 8; ++i) s += (v[i][0] + v[i][1]) + (v[i][2] + v[i][3]);
        if (row + rstep < NTOK) { const u32x4* src = (const u32x4*)(zin + (size_t)(row + rstep) * DM);
#pragma unroll
            for (int i = 0; i < 4; ++i) nv[i] = src[lane + 64 * i]; }
#pragma unroll
        for (int o = 32; o > 0; o >>= 1) s += __shfl_xor(s, o);
        const float mu = s * (1.0f / DM); float q = 0.f;
#pragma unroll
        for (int i = 0; i < 8; ++i) { const f32x4 d = v[i] - mu; q += (d[0] * d[0] + d[1] * d[1]) + (d[2] * d[2] + d[3] * d[3]); }
#pragma unroll
        for (int o = 32; o > 0; o >>= 1) q += __shfl_xor(q, o);
        const float rstd = rsqrtf(q * (1.0f / DM) + LN_EPS);
        if (stats && lane == 0) { stats[2 * row] = mu; stats[2 * row + 1] = rstd; }
#pragma unroll
        for (int i = 0; i < 4; ++i) {
            const int e0 = (lane + 64 * i) * 8;
            const f32x4 g0 = *(const f32x4*)(g + e0), g1 = *(const f32x4*)(g + e0 + 4), b0 = *(const f32x4*)(b + e0), b1 = *(const f32x4*)(b + e0 + 4);
            const f32x4 y0 = (v[2 * i] - mu) * rstd * g0 + b0, y1 = (v[2 * i + 1] - mu) * rstd * g1 + b1;
            if (xout) { *(f32x4*)(xout + (size_t)row * DM + e0) = y0; *(f32x4*)(xout + (size_t)row * DM + e0 + 4) = y1; }
            if (xb) { const u32x2 w0 = pack4(y0), w1 = pack4(y1); u32x4 w; w.x = w0.x; w.y = w0.y; w.z = w1.x; w.w = w1.y; *(u32x4*)(xb + (size_t)row * DM + e0) = w; }
        }
    }
}

__device__ __forceinline__ void kvpre_item(const Params& p, int item, unsigned char* smem) {
    const int tid = opaque_tid(), dgrp = tid & 15, krow = tid >> 4;
    const int bh = item >> 4, j = item & 15, b = bh >> 2, h = bh & 3;
    const bf16_t* P = (const bf16_t*)(p.ws + OFF_H);
    bf16_t* Vt = (bf16_t*)((unsigned char*)p.out + OUT_VT);
    float* red = (float*)smem;
    bf16_t* Vl = (bf16_t*)(smem + 16384);
    const bf16_t* Kb = P + ((size_t)b * SEQ + j * 256 + krow * 8) * DIN + 512 + h * 128 + dgrp * 8;
    u32x4 kr[8], vr[8];
#pragma unroll
    for (int i = 0; i < 8; ++i) { kr[i] = *(const u32x4*)(Kb + (size_t)i * DIN); vr[i] = *(const u32x4*)(Kb + (size_t)i * DIN + 512); }
    float ks[8] = {0.f, 0.f, 0.f, 0.f, 0.f, 0.f, 0.f, 0.f};
#pragma unroll
    for (int i = 0; i < 8; ++i) {
        ks[0] += __uint_as_float(kr[i].x << 16); ks[1] += __uint_as_float(kr[i].x & 0xffff0000u); ks[2] += __uint_as_float(kr[i].y << 16); ks[3] += __uint_as_float(kr[i].y & 0xffff0000u);
        ks[4] += __uint_as_float(kr[i].z << 16); ks[5] += __uint_as_float(kr[i].z & 0xffff0000u); ks[6] += __uint_as_float(kr[i].w << 16); ks[7] += __uint_as_float(kr[i].w & 0xffff0000u);
    }
    *(f32x4*)(red + krow * 128 + dgrp * 8) = (f32x4){ks[0], ks[1], ks[2], ks[3]}; *(f32x4*)(red + krow * 128 + dgrp * 8 + 4) = (f32x4){ks[4], ks[5], ks[6], ks[7]};
#pragma unroll
    for (int e = 0; e < 8; ++e) {
        unsigned hv[8];
#pragma unroll
        for (int i = 0; i < 8; ++i) { const unsigned wsel = (e >> 1) == 0 ? vr[i].x : ((e >> 1) == 1 ? vr[i].y : ((e >> 1) == 2 ? vr[i].z : vr[i].w)); hv[i] = (e & 1) ? (wsel >> 16) : (wsel & 0xffffu); }
        u32x4 wv; wv.x = hv[0] | (hv[1] << 16); wv.y = hv[2] | (hv[3] << 16); wv.z = hv[4] | (hv[5] << 16); wv.w = hv[6] | (hv[7] << 16);
        const int d = dgrp * 8 + e;
        *(u32x4*)(Vl + d * 256 + ((krow ^ dgrp) << 3)) = wv;
    }
    lds_barrier();
    if (tid < 128) { float s = 0.f;
#pragma unroll 8
        for (int r = 0; r < 32; ++r) s += red[r * 128 + tid];
        ((float*)(p.ws + OFF_KMEAN))[((size_t)bh * 16 + j) * 128 + tid] = s * (1.0f / 256.0f); }
#pragma unroll
    for (int r = 0; r < 8; ++r) {
        const int idx = r * 512 + tid, d = idx >> 5, pc = idx & 31, lc = pc ^ ((d >> 3) & 15);
        const u32x4 wv = *(const u32x4*)(Vl + d * 256 + (pc << 3));
        *(u32x4*)(Vt + ((size_t)bh * 128 + d) * SEQ + j * 256 + (lc << 3)) = wv;
    }
    lds_barrier();
}

__device__ __forceinline__ void rgpre_range(const Params& p, int layer, unsigned char* smem) {
    const int tid = opaque_tid(), c = tid & 127, sg = tid >> 7, w = tid >> 6, lane = tid & 63, fr = lane & 15, fq = lane >> 4;
    const bf16_t* P = (const bf16_t*)(p.ws + OFF_H);
    float* xcf = (float*)smem; bf16_t* xcb = (bf16_t*)(smem + 32768); float* aL = (float*)(smem + 50176); float* uL = (float*)(smem + 82944);
    float* segA = (float*)(smem + 115712); float* segH = (float*)(smem + 117760);
    float* HL = (float*)((unsigned char*)p.out + OUT_HLOC); float* CA = (float*)((unsigned char*)p.out + OUT_CUMA);
    bf16x8 Ba[4], Bx[4];
    int g_loaded = -1;
    float cw0 = 0.f, cw1 = 0.f, cw2 = 0.f, cw3 = 0.f, cb = 0.f, ba = 0.f, bx = 0.f, sp = 0.f;
    unsigned short nx[19];
#define RGP_LOAD(item_) do { const int g_ = (item_) & 3, bt_ = (item_) >> 2, b_ = bt_ >> 6, tau_ = bt_ & 63; const bf16_t* Px_ = P + (size_t)b_ * SEQ * DIN + 2048 + g_ * 128 + c; const int tb_ = tau_ * 64 + sg * 16 - 3; \
        _Pragma("unroll") for (int i = 0; i < 19; ++i) { const int pos_ = tb_ + i; nx[i] = pos_ >= 0 ? Px_[(size_t)pos_ * DIN] : (unsigned short)0; } } while (0)
    int item = blockIdx.x;
    if (item < 1024) RGP_LOAD(item);
#pragma unroll 1
    for (; item < 1024; item += gridDim.x) {
        const int g = item & 3, bt = item >> 2, b = bt >> 6, tau = bt & 63;
        const int ch = g * 128 + c;
        if (g != g_loaded) {
            g_loaded = g;
            const bf16_t* Wa = (const bf16_t*)(p.ws + OFF_RGA + (size_t)layer * SZ_RG) + g * 16384;
            const bf16_t* Wx = (const bf16_t*)(p.ws + OFF_RGX + (size_t)layer * SZ_RG) + g * 16384;
#pragma unroll
            for (int kk = 0; kk < 4; ++kk) { Ba[kk] = *(const bf16x8*)(Wa + (16 * w + fr) * 128 + 32 * kk + 8 * fq); Bx[kk] = *(const bf16x8*)(Wx + (16 * w + fr) * 128 + 32 * kk + 8 * fq); }
            const float* cw = p.in[8] + (size_t)layer * 4 * 512 + ch;
            cw0 = cw[0]; cw1 = cw[512]; cw2 = cw[1024]; cw3 = cw[1536]; cb = p.in[9][layer * 512 + ch];
            const int chl = layer * 512 + g * 128 + 16 * w + fr;
            ba = p.in[11][chl]; bx = p.in[13][chl]; { const float e = __expf(-p.in[14][chl]); sp = e < 0.02f ? e * (1.0f - e * (0.5f - e * 0.33333334f)) : __logf(1.0f + e); }
        }
        {
            float xw[19];
#pragma unroll
            for (int i = 0; i < 19; ++i) xw[i] = bf2f(nx[i]);
#pragma unroll
            for (int i = 0; i < 16; ++i) { const float xc = cb + cw0 * xw[i] + cw1 * xw[i + 1] + cw2 * xw[i + 2] + cw3 * xw[i + 3]; const int t = sg * 16 + i; xcf[t * 128 + c] = xc; xcb[t * 136 + c] = f2bf(xc); }
        }
        if (item + (int)gridDim.x < 1024) RGP_LOAD(item + (int)gridDim.x);
        lds_barrier();
        {
            const int col = 16 * w + fr;
#pragma unroll
            for (int tt = 0; tt < 4; ++tt) {
                f32x4 aa = {0.f, 0.f, 0.f, 0.f}, ax = {0.f, 0.f, 0.f, 0.f};
#pragma unroll
                for (int kk = 0; kk < 4; ++kk) { const bf16x8 a = *(const bf16x8*)(xcb + (16 * tt + fr) * 136 + 32 * kk + 8 * fq); aa = MFMA16(a, Ba[kk], aa); ax = MFMA16(a, Bx[kk], ax); }
#pragma unroll
                for (int j = 0; j < 4; ++j) {
                    const int t = 16 * tt + 4 * fq + j;
                    const float r = sigm(aa[j] + ba), ii = sigm(ax[j] + bx), la = -8.0f * r * sp, x2 = 2.0f * la;
                    const float av = __expf(la);
                    const float ser = -x2 * (1.0f + x2 * (0.5f + x2 * (0.16666667f + x2 * (0.041666668f + x2 * (0.0083333338f + x2 * 0.0013888889f)))));
                    const float om = x2 > -0.25f ? ser : 1.0f - __expf(x2);
                    const float u = __builtin_amdgcn_sqrtf(fmaxf(om, 0.f)) * (ii * xcf[t * 128 + col]);
                    aL[t * 128 + col] = av; uL[t * 128 + col] = u;
                }
            }
        }
        lds_barrier();
        {
            float hh = 0.f, AA = 1.f;
#pragma unroll
            for (int i = 0; i < 16; ++i) { const int t = sg * 16 + i; const float av = aL[t * 128 + c], u = uL[t * 128 + c]; hh = av * hh + u; AA *= av; uL[t * 128 + c] = hh; aL[t * 128 + c] = AA; }
            segA[sg * 128 + c] = AA; segH[sg * 128 + c] = hh;
        }
        lds_barrier();
        {
            float carry = 0.f, cA = 1.f;
            for (int s2 = 0; s2 < sg; ++s2) { const float a2 = segA[s2 * 128 + c]; carry = a2 * carry + segH[s2 * 128 + c]; cA *= a2; }
            float hl = 0.f, ca = 0.f;
#pragma unroll
            for (int i = 0; i < 16; ++i) {
                const int t = sg * 16 + i; const size_t tok = (size_t)b * SEQ + tau * 64 + t;
                const float al = aL[t * 128 + c]; hl = uL[t * 128 + c] + al * carry; ca = al * cA;
                HL[tok * 512 + ch] = hl; CA[tok * 512 + ch] = ca;
            }
            if (sg == 3) { ((float*)(p.ws + OFF_ATILE))[((size_t)b * 64 + tau) * 512 + ch] = ca; ((float*)(p.ws + OFF_HTILE))[((size_t)b * 64 + tau) * 512 + ch] = hl; }
        }
        lds_barrier();
    }
#undef RGP_LOAD
}

__device__ __forceinline__ void convc_item(const Params& p, int layer, int item, unsigned char* smem) {
    const int tid = opaque_tid(), c = tid, w = tid >> 6, lane = tid & 63;
    const int b = item >> 7, tau = item & 127;
    const bf16_t* P = (const bf16_t*)(p.ws + OFF_H);
    bf16_t* Y = (bf16_t*)(p.ws + OFF_XB);
    bf16_t* glu = (bf16_t*)smem;
    float* ubuf = (float*)(smem + 63488); float* stats = (float*)(smem + 63488 + 65536);
    {
        const bf16_t* Pv = P + (size_t)b * SEQ * DIN + 2560;
        u32x4 va[8], ga[8];
#pragma unroll
        for (int r = 0; r < 8; ++r) { const int slot = r * 512 + tid, row = slot >> 6, c8 = (slot & 63) * 8, pos = tau * 32 - 30 + row;
            if (row < 62 && pos >= 0) { const bf16_t* q = Pv + (size_t)pos * DIN + c8; va[r] = *(const u32x4*)q; ga[r] = *(const u32x4*)(q + 512); }
            else { va[r] = (u32x4){0u, 0u, 0u, 0u}; ga[r] = (u32x4){0u, 0u, 0u, 0u}; } }
#pragma unroll
        for (int r = 0; r < 8; ++r) { const int slot = r * 512 + tid, row = slot >> 6, c8 = (slot & 63) * 8;
            if (row < 62) {
                float o[8];
                const unsigned vw[4] = {va[r].x, va[r].y, va[r].z, va[r].w}, gw_[4] = {ga[r].x, ga[r].y, ga[r].z, ga[r].w};
#pragma unroll
                for (int e = 0; e < 4; ++e) { o[2 * e] = __uint_as_float(vw[e] << 16) * sigm(__uint_as_float(gw_[e] << 16)); o[2 * e + 1] = __uint_as_float(vw[e] & 0xffff0000u) * sigm(__uint_as_float(gw_[e] & 0xffff0000u)); }
                *(bf16x8*)(glu + row * 512 + c8) = pack8(o[0], o[1], o[2], o[3], o[4], o[5], o[6], o[7]); } }
    }
    float wk[31];
#pragma unroll
    for (int k = 0; k < 31; ++k) wk[k] = p.in[15][(size_t)layer * 31 * 512 + k * 512 + c];
    const float cb = p.in[16][layer * 512 + c];
    lds_barrier();
    float gw[38];
#pragma unroll
    for (int i = 0; i < 30; ++i) gw[i] = bf2f(glu[i * 512 + c]);
#pragma unroll 1
    for (int tg = 0; tg < 4; ++tg) {
#pragma unroll
        for (int i = 0; i < 8; ++i) gw[30 + i] = bf2f(glu[(30 + tg * 8 + i) * 512 + c]);
#pragma unroll
        for (int o = 0; o < 8; ++o) { float acc = cb;
#pragma unroll
            for (int k = 0; k < 31; ++k) acc += wk[k] * gw[o + k];
            ubuf[(tg * 8 + o) * 512 + c] = acc; }
#pragma unroll
        for (int i = 0; i < 30; ++i) gw[i] = gw[i + 8];
    }
    lds_barrier();
#pragma unroll 1
    for (int i = 0; i < 16; ++i) {
        const int pr = w * 16 + i, t = pr >> 2, grp = pr & 3;
        const float v0 = ubuf[t * 512 + grp * 128 + lane], v1 = ubuf[t * 512 + grp * 128 + 64 + lane];
        float s = v0 + v1;
#pragma unroll
        for (int o = 32; o > 0; o >>= 1) s += __shfl_xor(s, o);
        const float mu = s * (1.0f / 128.0f), d0 = v0 - mu, d1 = v1 - mu; float q = d0 * d0 + d1 * d1;
#pragma unroll
        for (int o = 32; o > 0; o >>= 1) q += __shfl_xor(q, o);
        if (lane == 0) { stats[(t * 4 + grp) * 2] = mu; stats[(t * 4 + grp) * 2 + 1] = rsqrtf(q * (1.0f / 128.0f) + LN_EPS); }
    }
    lds_barrier();
    {
        const float ng = p.in[17][layer * 512 + c], nb = p.in[18][layer * 512 + c]; const int grp = c >> 7;
#pragma unroll 8
        for (int t = 0; t < 32; ++t) {
            const float mu = stats[(t * 4 + grp) * 2], rs = stats[(t * 4 + grp) * 2 + 1];
            const float z = (ubuf[t * 512 + c] - mu) * rs * ng + nb;
            Y[((size_t)b * SEQ + tau * 32 + t) * DM + 1024 + c] = f2bf(z * sigm(z));
        }
    }
    lds_barrier();
}

__device__ __forceinline__ void rgpost_item(const Params& p, int item, unsigned char* smem) {
    const int tid = opaque_tid(), c4 = (tid & 127) * 4, sg = tid >> 7, b = item >> 6, tau = item & 63;
    const bf16_t* P = (const bf16_t*)(p.ws + OFF_H);
    bf16_t* Y = (bf16_t*)(p.ws + OFF_XB);
    const float* AT = (const float*)(p.ws + OFF_ATILE) + (size_t)b * 64 * 512 + c4; const float* HT = (const float*)(p.ws + OFF_HTILE) + (size_t)b * 64 * 512 + c4;
    const float* HL = (const float*)((unsigned char*)p.out + OUT_HLOC); const float* CA = (const float*)((unsigned char*)p.out + OUT_CUMA);
    f32x4 pa = {1.f, 1.f, 1.f, 1.f}, ph = {0.f, 0.f, 0.f, 0.f};
    {
        const int sbeg = sg * 16, send = tau < sbeg + 16 ? tau : sbeg + 16;
#pragma unroll 1
        for (int s0 = sbeg; s0 < send; s0 += 8) {
            f32x4 av[8], hv[8];
#pragma unroll
            for (int i = 0; i < 8; ++i) { const bool ok = s0 + i < send; av[i] = ok ? *(const f32x4*)(AT + (s0 + i) * 512) : (f32x4){1.f, 1.f, 1.f, 1.f}; hv[i] = ok ? *(const f32x4*)(HT + (s0 + i) * 512) : (f32x4){0.f, 0.f, 0.f, 0.f}; }
#pragma unroll
            for (int i = 0; i < 8; ++i) { ph = av[i] * ph + hv[i]; pa = pa * av[i]; }
        }
    }
    f32x4* cs = (f32x4*)smem;
    cs[(sg * 128 + (tid & 127)) * 2] = pa; cs[(sg * 128 + (tid & 127)) * 2 + 1] = ph;
    lds_barrier();
    f32x4 carry = {0.f, 0.f, 0.f, 0.f};
#pragma unroll
    for (int q = 0; q < 4; ++q) { const f32x4 a = cs[(q * 128 + (tid & 127)) * 2], hq = cs[(q * 128 + (tid & 127)) * 2 + 1]; carry = a * carry + hq; }
    lds_barrier();
    const size_t tok0 = (size_t)b * SEQ + tau * 64 + sg * 16;
#pragma unroll 1
    for (int t0 = 0; t0 < 16; t0 += 8) {
        f32x4 hl[8], ca[8]; u32x2 gt[8];
#pragma unroll
        for (int i = 0; i < 8; ++i) { const size_t tok = tok0 + t0 + i; hl[i] = *(const f32x4*)(HL + tok * 512 + c4); ca[i] = *(const f32x4*)(CA + tok * 512 + c4); gt[i] = *(const u32x2*)(P + tok * DIN + 1536 + c4); }
#pragma unroll
        for (int i = 0; i < 8; ++i) {
            const f32x4 hv = hl[i] + ca[i] * carry;
            float x[4] = {__uint_as_float(gt[i].x << 16), __uint_as_float(gt[i].x & 0xffff0000u), __uint_as_float(gt[i].y << 16), __uint_as_float(gt[i].y & 0xffff0000u)};
            float y[4];
#pragma unroll
            for (int e = 0; e < 4; ++e) { const float u = 0.7978845608f * (x[e] + 0.044715f * x[e] * x[e] * x[e]); const float th = 1.0f - 2.0f * __builtin_amdgcn_rcpf(__expf(2.0f * u) + 1.0f); y[e] = hv[e] * 0.5f * x[e] * (1.0f + th); }
            u32x2 w2; w2.x = cvt_pk_bf16(y[0], y[1]); w2.y = cvt_pk_bf16(y[2], y[3]);
            *(u32x2*)(Y + (tok0 + t0 + i) * DM + 512 + c4) = w2;
        }
    }
}

__device__ __forceinline__ void attn_item(const Params& p, int item, unsigned char* smem) {
    const int tid = opaque_tid(), w = tid >> 6, lane = tid & 63, fr = lane & 15, fq = lane >> 4;
    const int qt = 31 - (item >> 4), bh = item & 15, b = bh >> 2, h = bh & 3;
    const int blk = qt >> 1, o = (qt & 1) * 128, q0 = blk * 256 + o;
    const bf16_t* P = (const bf16_t*)(p.ws + OFF_H);
    const bf16_t* Vt = (const bf16_t*)((unsigned char*)p.out + OUT_VT) + (size_t)bh * 128 * SEQ;
    const float* kmean = (const float*)(p.ws + OFF_KMEAN) + (size_t)bh * 16 * 128;
    bf16_t* Y = (bf16_t*)(p.ws + OFF_XB);
    bf16_t* Ks = (bf16_t*)smem; bf16_t* Vs = (bf16_t*)(smem + 34816);
    float* kms = (float*)(smem + 71680); float* gts = (float*)(smem + 79872);
    unsigned* sels = (unsigned*)(smem + 88576); int* tiles = (int*)(smem + 89088); unsigned* um = (unsigned*)(smem + 89344);
    const bf16_t* Pb = P + (size_t)b * SEQ * DIN;

    bf16x8 Qf[4];
    { const bf16_t* qrow = Pb + (size_t)(q0 + 16 * w + fr) * DIN + h * 128;
#pragma unroll
      for (int kk = 0; kk < 4; ++kk) Qf[kk] = *(const bf16x8*)(qrow + 32 * kk + 8 * fq); }
    for (int i = tid; i < blk * 128; i += 512) kms[i] = kmean[i];
    if (tid == 0) um[0] = 0u;
    lds_barrier();
    {
        const int qi = tid & 127, jg = tid >> 7;
        float g4[4] = {0.f, 0.f, 0.f, 0.f};
        if (jg * 4 < blk) {
            const bf16_t* qr = Pb + (size_t)(q0 + qi) * DIN + h * 128;
#pragma unroll 2
            for (int cc = 0; cc < 16; ++cc) {
                const u32x4 raw = *(const u32x4*)(qr + 8 * cc);
                float qv[8];
                qv[0] = __uint_as_float(raw.x << 16); qv[1] = __uint_as_float(raw.x & 0xffff0000u); qv[2] = __uint_as_float(raw.y << 16); qv[3] = __uint_as_float(raw.y & 0xffff0000u);
                qv[4] = __uint_as_float(raw.z << 16); qv[5] = __uint_as_float(raw.z & 0xffff0000u); qv[6] = __uint_as_float(raw.w << 16); qv[7] = __uint_as_float(raw.w & 0xffff0000u);
#pragma unroll
                for (int jj = 0; jj < 4; ++jj) { const int j = jg * 4 + jj; if (j < blk) { const float* km = kms + j * 128 + 8 * cc;
#pragma unroll
                    for (int e = 0; e < 8; ++e) g4[jj] += qv[e] * km[e]; } }
            }
        }
#pragma unroll
        for (int jj = 0; jj < 4; ++jj) gts[qi * 17 + jg * 4 + jj] = g4[jj];
    }
    lds_barrier();
    if (tid < 128) {
        unsigned m = 0u; const int nsel = blk < 3 ? blk : 3;
        for (int s = 0; s < nsel; ++s) { float best = -3.0e38f; int bi = 0;
            for (int j = 0; j < blk; ++j) { const float v = gts[tid * 17 + j]; if (!((m >> j) & 1u) && v > best) { best = v; bi = j; } }
            m |= 1u << bi; }
        sels[tid] = m; if (m) atomicOr(um, m);
    }
    lds_barrier();
    if (tid == 0) { int n = 0; const unsigned u0 = um[0];
        for (int t = 0; t < o / 64 + 2; ++t) tiles[n++] = blk * 256 + t * 64;
        for (int j = 0; j < blk; ++j) if ((u0 >> j) & 1u) for (int t = 0; t < 4; ++t) tiles[n++] = j * 256 + t * 64;
        um[1] = (unsigned)n; }
    lds_barrier();
    const unsigned msel = sels[16 * w + fr]; const int ntiles = (int)um[1];
    const int qpos = q0 + 16 * w + fr;
    const float SC = 0.12751743f;

    f32x4 oacc[8];
#pragma unroll
    for (int dt = 0; dt < 8; ++dt) oacc[dt] = (f32x4){0.f, 0.f, 0.f, 0.f};
    float m_run = -1.0e30f, l_run = 0.f;
    struct KVStage { u32x4 k0, k1, v0, v1; };
    KVStage s0, s1, s2;
    const int lr = tid >> 3, lc = (tid & 7) * 16, vr = tid >> 2, vc = (tid & 3) * 16;
    const int lrp = (lr & 32) + ((lr >> 2) & 1) * 16 + ((lr >> 3) & 3) * 4 + (lr & 3);
#define ATT_GLOAD(st_, kpos_) do { const bf16_t* kp_ = Pb + (size_t)((kpos_) + lr) * DIN + 512 + h * 128 + lc; st_.k0 = *(const u32x4*)kp_; st_.k1 = *(const u32x4*)(kp_ + 8); \
        const bf16_t* vp_ = Vt + (size_t)vr * SEQ + (kpos_) + vc; st_.v0 = *(const u32x4*)vp_; st_.v1 = *(const u32x4*)(vp_ + 8); } while (0)
#define ATT_LSTORE(st_, buf_) do { bf16_t* kd_ = Ks + (buf_) * 8704 + lrp * 136 + lc; *(u32x4*)kd_ = st_.k0; *(u32x4*)(kd_ + 8) = st_.k1; \
        bf16_t* vd_ = Vs + (buf_) * 9216 + vr * 72 + vc; *(u32x4*)vd_ = st_.v0; *(u32x4*)(vd_ + 8) = st_.v1; } while (0)
    ATT_GLOAD(s0, tiles[0]); ATT_LSTORE(s0, 0);
    if (1 < ntiles) ATT_GLOAD(s1, tiles[1]);
    if (2 < ntiles) ATT_GLOAD(s2, tiles[2]);
    if (3 < ntiles) ATT_GLOAD(s0, tiles[3]);
    lds_barrier();
#define ATT_BODY(it_, stn_) do { \
        const int buf = (it_) & 1, kpos = tiles[(it_)]; \
        const bf16_t* Kb = Ks + buf * 8704; const bf16_t* Vb = Vs + buf * 9216; \
        const bool own = kpos >= blk * 256; const bool selok = (msel >> (kpos >> 8)) & 1u; \
        if (own || __any(selok)) { \
        f32x4 sacc[4]; \
        _Pragma("unroll") for (int T = 0; T < 4; ++T) { \
            const int krow = 32 * (T >> 1) + 16 * (T & 1) + fr; \
            sacc[T] = (f32x4){0.f, 0.f, 0.f, 0.f}; \
            _Pragma("unroll") for (int kk = 0; kk < 4; ++kk) { const bf16x8 a = *(const bf16x8*)(Kb + krow * 136 + 32 * kk + 8 * fq); sacc[T] = MFMA16(a, Qf[kk], sacc[T]); } \
        } \
        float mx = m_run; \
        _Pragma("unroll") for (int T = 0; T < 4; ++T) \
            _Pragma("unroll") for (int j = 0; j < 4; ++j) { const int key = kpos + 32 * (T >> 1) + 8 * fq + 4 * (T & 1) + j; const bool ok = own ? (key <= qpos) : selok; \
                const float sv = ok ? sacc[T][j] * SC : -1.0e30f; sacc[T][j] = sv; mx = fmaxf(mx, sv); } \
        mx = fmaxf(mx, __shfl_xor(mx, 16)); mx = fmaxf(mx, __shfl_xor(mx, 32)); \
        const float al = __builtin_amdgcn_exp2f(m_run - mx); m_run = mx; \
        float ps = 0.f; \
        _Pragma("unroll") for (int T = 0; T < 4; ++T) \
            _Pragma("unroll") for (int j = 0; j < 4; ++j) { const float pv = __builtin_amdgcn_exp2f(sacc[T][j] - mx); sacc[T][j] = pv; ps += pv; } \
        l_run = l_run * al + ps; \
        _Pragma("unroll") for (int dt = 0; dt < 8; ++dt) oacc[dt] *= al; \
        _Pragma("unroll") for (int G = 0; G < 2; ++G) { \
            const bf16x8 pb = pack8(sacc[2 * G][0], sacc[2 * G][1], sacc[2 * G][2], sacc[2 * G][3], sacc[2 * G + 1][0], sacc[2 * G + 1][1], sacc[2 * G + 1][2], sacc[2 * G + 1][3]); \
            _Pragma("unroll") for (int dt = 0; dt < 8; ++dt) { const bf16x8 a = *(const bf16x8*)(Vb + (16 * dt + fr) * 72 + 32 * G + 8 * fq); oacc[dt] = MFMA16(a, pb, oacc[dt]); } \
        } \
        } \
        if ((it_) + 1 < ntiles) ATT_LSTORE(stn_, buf ^ 1); \
        if ((it_) + 4 < ntiles) ATT_GLOAD(stn_, tiles[(it_) + 4]); \
        lds_barrier(); \
    } while (0)
#pragma unroll 1
    for (int it = 0; it < ntiles; it += 3) {
        ATT_BODY(it, s1);
        if (it + 1 >= ntiles) break;
        ATT_BODY(it + 1, s2);
        if (it + 2 >= ntiles) break;
        ATT_BODY(it + 2, s0);
    }
#undef ATT_BODY
#undef ATT_GLOAD
#undef ATT_LSTORE
    float l = l_run + __shfl_xor(l_run, 16); l += __shfl_xor(l, 32);
    const float inv = 1.0f / l;
    bf16_t* yrow = Y + ((size_t)b * SEQ + qpos) * DM + h * 128 + 4 * fq;
#pragma unroll
    for (int dt = 0; dt < 8; ++dt) { u32x2 w2; w2.x = cvt_pk_bf16(oacc[dt][0] * inv, oacc[dt][1] * inv); w2.y = cvt_pk_bf16(oacc[dt][2] * inv, oacc[dt][3] * inv); *(u32x2*)(yrow + 16 * dt) = w2; }
}

__device__ __forceinline__ void hgpre_range(const Params& p, int layer, unsigned char* smem) {
    const int tid = opaque_tid(), c = tid & 127, sg = tid >> 7, w = tid >> 6, lane = tid & 63, fr = lane & 15, fq = lane >> 4;
    const bf16_t* P = (const bf16_t*)(p.ws + OFF_H);
    bf16_t* qs = (bf16_t*)smem; bf16_t* ks = (bf16_t*)(smem + 8704); bf16_t* vT = (bf16_t*)(smem + 17408);
    bf16_t* att = (bf16_t*)(smem + 27648); float* seg = (float*)(smem + 30208);
    bf16_t* raw = (bf16_t*)(smem + 32768);
    const int lrow = tid >> 4, lcol = (tid & 15) * 8;
    u32x4 pq, pf, pv, pg;
#define HGP_LOAD(item_) do { const int bh_ = (item_) >> 7, chn_ = (item_) & 127; const bf16_t* Pq_ = P + ((size_t)(bh_ >> 2) * SEQ + chn_ * 32 + lrow) * DIN + 3584 + (bh_ & 3) * 128 + lcol; \
        pq = *(const u32x4*)Pq_; pf = *(const u32x4*)(Pq_ + 512); pv = *(const u32x4*)(Pq_ + 1024); pg = *(const u32x4*)(Pq_ + 1536); } while (0)
    int item = blockIdx.x;
    if (item < 2048) HGP_LOAD(item);
#pragma unroll 1
    for (; item < 2048; item += gridDim.x) {
        const int bh = item >> 7, chn = item & 127, h = bh & 3;
        const size_t cidx = (size_t)bh * 128 + chn;
        bf16_t* gQS = (bf16_t*)(p.ws + OFF_HQS) + cidx * 4096; bf16_t* gKDT = (bf16_t*)(p.ws + OFF_HKDT) + cidx * 4096; bf16_t* gVT = (bf16_t*)(p.ws + OFF_HVT) + cidx * 4096;
        float* gEL = (float*)(p.ws + OFF_HEL) + cidx * 128;
        f32x4* gOI = (f32x4*)((unsigned char*)p.out + OUT_OI) + cidx * 1024; f32x4* gGS = (f32x4*)(p.ws + OFF_HGS) + cidx * 1024;
        float lb = 0.f;
        if (layer == 1) lb = sigm(p.in[19][512 + h * 128 + c] - p.in[19][h * 128 + c]);
        const float omlb = 1.0f - lb;
        const float ngv = p.in[20][layer * 512 + h * 128 + 16 * w + fr];
        *(u32x4*)(raw + lrow * 128 + lcol) = pq; *(u32x4*)(raw + 4096 + lrow * 128 + lcol) = pf; *(u32x4*)(raw + 8192 + lrow * 128 + lcol) = pv; *(u32x4*)(raw + 12288 + lrow * 128 + lcol) = pg;
        if (item + (int)gridDim.x < 2048) HGP_LOAD(item + (int)gridDim.x);
        lds_barrier();
        unsigned short nq[8], nf[8], nv[8], ng[8];
#pragma unroll
        for (int i = 0; i < 8; ++i) { const int o_ = (8 * sg + i) * 128 + c; nq[i] = raw[o_]; nf[i] = raw[4096 + o_]; nv[i] = raw[8192 + o_]; }
#pragma unroll
        for (int i = 0; i < 8; ++i) ng[i] = raw[12288 + (16 * (i >> 2) + 4 * fq + (i & 3)) * 128 + 16 * w + fr];
        float qv[8], kv[8], bl[8], gsv[8]; float run = 0.f;
#pragma unroll
        for (int i = 0; i < 8; ++i) { const float sg_ = sigm(bf2f(nf[i])); const float f = lb + omlb * sg_; run += __logf(f); bl[i] = run; kv[i] = omlb * (1.0f - sg_); qv[i] = bf2f(nq[i]); }
#pragma unroll
        for (int i = 0; i < 8; ++i) { const float gg = bf2f(ng[i]); gsv[i] = gg * sigm(gg) * ngv; }
        seg[sg * 128 + c] = run;
        { u32x4 wv; wv.x = nv[0] | ((unsigned)nv[1] << 16); wv.y = nv[2] | ((unsigned)nv[3] << 16); wv.z = nv[4] | ((unsigned)nv[5] << 16); wv.w = nv[6] | ((unsigned)nv[7] << 16);
          *(u32x4*)(vT + c * 40 + sg * 8) = wv; *(u32x4*)(gVT + c * 32 + sg * 8) = wv; }
        lds_barrier();
        {
            const float s0 = seg[c], s1 = seg[128 + c], s2 = seg[256 + c], s3 = seg[384 + c];
            const float off = (sg > 0 ? s0 : 0.f) + (sg > 1 ? s1 : 0.f) + (sg > 2 ? s2 : 0.f), btot = (s0 + s1) + (s2 + s3);
            float kd[8];
#pragma unroll
            for (int i = 0; i < 8; ++i) { const float bt = off + bl[i]; const unsigned short qb = f2bf(qv[i] * __expf(bt));
                qs[(8 * sg + i) * 136 + c] = qb; gQS[(8 * sg + i) * 128 + c] = qb; ks[(8 * sg + i) * 136 + c] = f2bf(kv[i] * __expf(fminf(-bt, 80.0f)));        kd[i] = kv[i] * __expf(btot - bt); }
            *(bf16x8*)(gKDT + c * 32 + sg * 8) = pack8(kd[0], kd[1], kd[2], kd[3], kd[4], kd[5], kd[6], kd[7]);
            if (sg == 0) gEL[c] = __expf(btot);
        }
        lds_barrier();
        if (w < 3) {
            const int tt = (w + 1) >> 1, st = (w == 2) ? 1 : 0;
            f32x4 aa = {0.f, 0.f, 0.f, 0.f};
#pragma unroll
            for (int kk = 0; kk < 4; ++kk) { const bf16x8 a = *(const bf16x8*)(qs + (16 * tt + fr) * 136 + 32 * kk + 8 * fq); const bf16x8 bb = *(const bf16x8*)(ks + (16 * st + fr) * 136 + 32 * kk + 8 * fq); aa = MFMA16(a, bb, aa); }
#pragma unroll
            for (int j = 0; j < 4; ++j) { const int t = 16 * tt + 4 * fq + j, s = 16 * st + fr; att[t * 40 + s] = f2bf(s <= t ? aa[j] : 0.f); }
        } else if (w == 3) {
#pragma unroll
            for (int j = 0; j < 4; ++j) att[(4 * fq + j) * 40 + 16 + fr] = 0;
        }
        lds_barrier();
        {
            const bf16x8 bv = *(const bf16x8*)(vT + (16 * w + fr) * 40 + 8 * fq);
#pragma unroll
            for (int tt = 0; tt < 2; ++tt) {
                const bf16x8 a = *(const bf16x8*)(att + (16 * tt + fr) * 40 + 8 * fq);
                const f32x4 oi = MFMA16(a, bv, ((f32x4){0.f, 0.f, 0.f, 0.f}));
                gOI[(w * 2 + tt) * 64 + lane] = oi;
                gGS[(w * 2 + tt) * 64 + lane] = (f32x4){gsv[4 * tt], gsv[4 * tt + 1], gsv[4 * tt + 2], gsv[4 * tt + 3]};
            }
        }
        lds_barrier();
    }
#undef HGP_LOAD
}

__device__ __forceinline__ void hgrn_item(const Params& p, int layer, int bh, unsigned char* smem, int rep) {
    const int tid = opaque_tid(), w = tid >> 6, lane = tid & 63, fr = lane & 15, fq = lane >> 4;
    (void)layer;
    const bf16_t* gQS = (const bf16_t*)(p.ws + OFF_HQS) + (size_t)bh * 128 * 4096 + tid * 8;
    const bf16_t* gKDT = (const bf16_t*)(p.ws + OFF_HKDT) + (size_t)bh * 128 * 4096 + tid * 8;
    const bf16_t* gVT = (const bf16_t*)(p.ws + OFF_HVT) + (size_t)bh * 128 * 4096 + tid * 8;
    const float* gEL = (const float*)(p.ws + OFF_HEL) + (size_t)bh * 128 * 128 + (tid & 31) * 4;
    f32x4* gOI = (f32x4*)((unsigned char*)p.out + OUT_OI) + (size_t)bh * 128 * 1024 + w * 128 + lane;
    f32x4* gOW = rep ? (f32x4*)(p.ws + OFF_GU) + (size_t)bh * 128 * 1024 + w * 128 + lane : gOI;
    const int oq = (tid >> 4) * 136 + (tid & 15) * 8, ok = (tid >> 2) * 40 + (tid & 3) * 8;
    f32x4 S[8];
#pragma unroll
    for (int kt = 0; kt < 8; ++kt) S[kt] = (f32x4){0.f, 0.f, 0.f, 0.f};
    struct Stage { u32x4 q, k, v; f32x4 e, o0, o1; };
    Stage sa, sb;
#define HG_GLOAD(st_, ch_) do { const size_t co_ = (size_t)(ch_) * 4096; st_.q = *(const u32x4*)(gQS + co_); st_.k = *(const u32x4*)(gKDT + co_); st_.v = *(const u32x4*)(gVT + co_); \
        st_.e = *(const f32x4*)(gEL + (size_t)(ch_) * 128); st_.o0 = gOI[(size_t)(ch_) * 1024]; st_.o1 = gOI[(size_t)(ch_) * 1024 + 64]; } while (0)
#define HG_LSTORE(st_, buf_) do { unsigned char* lb_ = smem + (buf_) * 29696; *(u32x4*)((bf16_t*)lb_ + oq) = st_.q; *(u32x4*)((bf16_t*)(lb_ + 8704) + ok) = st_.k; *(u32x4*)((bf16_t*)(lb_ + 18944) + ok) = st_.v; \
        if (tid < 32) *(f32x4*)((float*)(lb_ + 29184) + tid * 4) = st_.e; } while (0)
    f32x4 oc0, oc1;
    HG_GLOAD(sa, 0); HG_LSTORE(sa, 0); oc0 = sa.o0; oc1 = sa.o1;
    HG_GLOAD(sa, 1); HG_GLOAD(sb, 2);
    __syncthreads();
#define HG_BODY(chn_, stn_) do { \
        const int buf_ = (chn_) & 1; const unsigned char* lb_ = smem + buf_ * 29696; \
        const bf16_t* qs_ = (const bf16_t*)lb_; const bf16_t* kdT_ = (const bf16_t*)(lb_ + 8704); const bf16_t* vT_ = (const bf16_t*)(lb_ + 18944); const float* eL_ = (const float*)(lb_ + 29184); \
        f32x4 oacc0 = oc0, oacc1 = oc1; \
        u32x4 qa0[4], qa1[4]; bf16x8 ka[4], kb[4]; f32x4 e4[4], e5[4]; \
        _Pragma("unroll") for (int kp = 0; kp < 4; ++kp) { \
            const u32x2 lo0 = *(const u32x2*)(qs_ + fr * 136 + 32 * kp + 4 * fq), hi0 = *(const u32x2*)(qs_ + fr * 136 + 32 * kp + 16 + 4 * fq); qa0[kp].x = lo0.x; qa0[kp].y = lo0.y; qa0[kp].z = hi0.x; qa0[kp].w = hi0.y; \
            const u32x2 lo1 = *(const u32x2*)(qs_ + (16 + fr) * 136 + 32 * kp + 4 * fq), hi1 = *(const u32x2*)(qs_ + (16 + fr) * 136 + 32 * kp + 16 + 4 * fq); qa1[kp].x = lo1.x; qa1[kp].y = lo1.y; qa1[kp].z = hi1.x; qa1[kp].w = hi1.y; } \
        const bf16x8 bv = *(const bf16x8*)(vT_ + (16 * w + fr) * 40 + 8 * fq); \
        _Pragma("unroll") for (int kt = 0; kt < 4; ++kt) { ka[kt] = *(const bf16x8*)(kdT_ + (16 * kt + fr) * 40 + 8 * fq); e4[kt] = *(const f32x4*)(eL_ + 16 * kt + 4 * fq); } \
        _Pragma("unroll") for (int kp = 0; kp < 4; ++kp) { \
            const bf16x8 bS = pack8(S[2 * kp][0], S[2 * kp][1], S[2 * kp][2], S[2 * kp][3], S[2 * kp + 1][0], S[2 * kp + 1][1], S[2 * kp + 1][2], S[2 * kp + 1][3]); \
            oacc0 = MFMA16(__builtin_bit_cast(bf16x8, qa0[kp]), bS, oacc0); oacc1 = MFMA16(__builtin_bit_cast(bf16x8, qa1[kp]), bS, oacc1); } \
        __builtin_amdgcn_sched_barrier(0); \
        _Pragma("unroll") for (int kt = 0; kt < 4; ++kt) { kb[kt] = *(const bf16x8*)(kdT_ + (16 * (kt + 4) + fr) * 40 + 8 * fq); e5[kt] = *(const f32x4*)(eL_ + 16 * (kt + 4) + 4 * fq); } \
        _Pragma("unroll") for (int kt = 0; kt < 4; ++kt) { S[kt] = S[kt] * e4[kt]; S[kt] = MFMA16(ka[kt], bv, S[kt]); } \
        _Pragma("unroll") for (int kt = 0; kt < 4; ++kt) { S[kt + 4] = S[kt + 4] * e5[kt]; S[kt + 4] = MFMA16(kb[kt], bv, S[kt + 4]); } \
        gOW[(size_t)(chn_) * 1024] = oacc0; gOW[(size_t)(chn_) * 1024 + 64] = oacc1; \
        if ((chn_) + 1 < 128) { HG_LSTORE(stn_, buf_ ^ 1); oc0 = stn_.o0; oc1 = stn_.o1; } \
        if ((chn_) + 3 < 128) HG_GLOAD(stn_, (chn_) + 3); \
        asm volatile("s_waitcnt lgkmcnt(0)" ::: "memory"); __builtin_amdgcn_s_barrier(); asm volatile("" ::: "memory"); \
    } while (0)
#pragma unroll 1
    for (int chn = 0; chn < 128; chn += 2) {
        HG_BODY(chn, sa);
        HG_BODY(chn + 1, sb);
    }
#undef HG_BODY
#undef HG_GLOAD
#undef HG_LSTORE
    __syncthreads();
}

__device__ __forceinline__ void hgpost_range(const Params& p, unsigned char* smem) {
    const int tid = opaque_tid(), w = tid >> 6, lane = tid & 63, fr = lane & 15, fq = lane >> 4;
    float* red = (float*)smem;
    bf16_t* Yb = (bf16_t*)(p.ws + OFF_XB);
    int item = blockIdx.x;
    f32x4 o0, o1, g0, g1;
#define HPO_LOAD(item_) do { const f32x4* a_ = (const f32x4*)((unsigned char*)p.out + OUT_OI) + (size_t)(item_) * 1024 + w * 128 + lane; const f32x4* b_ = (const f32x4*)(p.ws + OFF_HGS) + (size_t)(item_) * 1024 + w * 128 + lane; \
        o0 = a_[0]; o1 = a_[64]; g0 = b_[0]; g1 = b_[64]; } while (0)
    if (item < 2048) HPO_LOAD(item);
    int par = 0;
#pragma unroll 1
    for (; item < 2048; item += gridDim.x, par ^= 1) {
        const int bh = item >> 7, chn = item & 127;
        const f32x4 c0 = o0, c1 = o1, h0 = g0, h1 = g1;
        if (item + (int)gridDim.x < 2048) HPO_LOAD(item + (int)gridDim.x);
#pragma unroll
        for (int j = 0; j < 4; ++j) { const float s0 = row16_sum_to15(c0[j] * c0[j]), s1 = row16_sum_to15(c1[j] * c1[j]);
            if (fr == 15) { red[par * 256 + (4 * fq + j) * 8 + w] = s0; red[par * 256 + (16 + 4 * fq + j) * 8 + w] = s1; } }
        lds_barrier();
        bf16_t* Y = Yb + ((size_t)(bh >> 2) * SEQ + chn * 32) * DM + 1536 + (bh & 3) * 128 + 16 * w + fr;
#pragma unroll
        for (int j = 0; j < 4; ++j) {
            { const int t = 4 * fq + j; const f32x4 r0 = *(const f32x4*)(red + par * 256 + t * 8), r1 = *(const f32x4*)(red + par * 256 + t * 8 + 4);
              const float ss = ((r0[0] + r0[1]) + (r0[2] + r0[3])) + ((r1[0] + r1[1]) + (r1[2] + r1[3])); const float rs = rsqrtf(ss * (1.0f / 128.0f) + LN_EPS);
              Y[(size_t)t * DM] = f2bf(c0[j] * rs * h0[j]); }
            { const int t = 16 + 4 * fq + j; const f32x4 r0 = *(const f32x4*)(red + par * 256 + t * 8), r1 = *(const f32x4*)(red + par * 256 + t * 8 + 4);
              const float ss = ((r0[0] + r0[1]) + (r0[2] + r0[3])) + ((r1[0] + r1[1]) + (r1[2] + r1[3])); const float rs = rsqrtf(ss * (1.0f / 128.0f) + LN_EPS);
              Y[(size_t)t * DM] = f2bf(c1[j] * rs * h1[j]); }
        }
    }
#undef HPO_LOAD
    lds_barrier();
}

#define PH_NOINLINE __forceinline__
__device__ PH_NOINLINE void gemm_gu(const bf16_t* A, const bf16_t* Bt, bf16_t* H) {
    extern __shared__ __attribute__((aligned(16))) unsigned char smem[];
    pg8::Gemm g{A, Bt, NTOK, 11264, 2048}; pg8::StaticOrder S; S.init(NTOK, 11264, (int)gridDim.x, (int)blockIdx.x); EpiSwiGLU E{H};
    pg8::gemm_phase((PG8_LAS unsigned char*)smem, g, S, E);
}
__device__ PH_NOINLINE void gemm_res(const bf16_t* A, const bf16_t* Bt, int K, unsigned char* ws, const float* Rraw, float* Oalt, float s) {
    extern __shared__ __attribute__((aligned(16))) unsigned char smem[];
    pg8::Gemm g{A, Bt, NTOK, 2048, K}; pg8::StaticOrder S; S.init(NTOK, 2048, (int)gridDim.x, (int)blockIdx.x); EpiResid E{ws, Rraw, Oalt, s};
    pg8::gemm_phase((PG8_LAS unsigned char*)smem, g, S, E);
}
__device__ PH_NOINLINE void gemm_in(const bf16_t* A, const bf16_t* Bt, bf16_t* O) {
    extern __shared__ __attribute__((aligned(16))) unsigned char smem[];
    pg8::Gemm g{A, Bt, NTOK, 5632, 2048}; pg8::StaticOrder S; S.init(NTOK, 5632, (int)gridDim.x, (int)blockIdx.x); EpiBf16P E{O, DIN};
    pg8::gemm_phase((PG8_LAS unsigned char*)smem, g, S, E);
}
__device__ __forceinline__ void run_phase(const Params& p, int ph, unsigned char* smem, int rep) {
    if (ph == 0) { phase_convert(p, smem); return; }
    const int l = (ph - 1) / 12, k = (ph - 1) % 12;
    bf16_t* XB = (bf16_t*)(p.ws + OFF_XB); bf16_t* H = (bf16_t*)(p.ws + OFF_H); float* X = (float*)(p.ws + OFF_X); float* STATS = (float*)(p.ws + OFF_STATS);
    if (k == 0 || k == 9) {
        const int f = (k == 9);
        gemm_gu(XB, (const bf16_t*)(p.ws + OFF_GU + (size_t)(l * 2 + f) * SZ_GU), H);
    } else if (k == 1 || k == 10) {
        const int f = (k == 10);
        gemm_res(H, (const bf16_t*)(p.ws + OFF_DN + (size_t)(l * 2 + f) * SZ_DN), 5632, p.ws, (l == 0 && f == 0) ? p.in[0] : nullptr, rep ? p.out : nullptr, 0.5f);
    } else if (k == 2 || k == 8 || k == 11) {
        const int i = (k == 2) ? 0 : (k == 8 ? 1 : 2);
        const bool last = (l == 1 && i == 2);
        if (rep) { phase_ln((const bf16_t*)X, nullptr, H, (float*)(p.ws + OFF_HGS), nullptr, p.in[1] + (size_t)(l * 3 + i) * DM, p.in[2] + (size_t)(l * 3 + i) * DM); return; }
        phase_ln((const bf16_t*)X, last ? p.out : nullptr, last ? nullptr : XB, last ? nullptr : STATS, last ? nullptr : (float*)(p.ws + OFF_GB), p.in[1] + (size_t)(l * 3 + i) * DM, p.in[2] + (size_t)(l * 3 + i) * DM);
    } else if (k == 3) {
        gemm_in(XB, (const bf16_t*)(p.ws + OFF_IN + (size_t)l * SZ_IN), H);
    } else if (k == 4) {
#ifndef PROBE_SUB4
#define PROBE_SUB4 0
#endif
        if (rep == 0 || PROBE_SUB4 == 0 || PROBE_SUB4 == 1) hgpre_range(p, l, smem);
        if (rep == 0 || PROBE_SUB4 == 0 || PROBE_SUB4 == 4) rgpre_range(p, l, smem);
        for (int it = blockIdx.x; it < 768; it += gridDim.x) {
            if (it < 256) { if (rep == 0 || PROBE_SUB4 == 0 || PROBE_SUB4 == 2) kvpre_item(p, it, smem); }
            else { if (rep == 0 || PROBE_SUB4 == 0 || PROBE_SUB4 == 3) convc_item(p, l, it - 256, smem); }
        }
    } else if (k == 5) {
        unsigned* ctr = (unsigned*)(p.ws + OFF_CTL) + l * 64 + rep * 128;
        int* s_item = (int*)(smem + LDS_BYTES - 16);
        for (;;) {
            __syncthreads();
            if (threadIdx.x == 0) *s_item = (int)atomicAdd(ctr, 1u);
            __syncthreads();
            const int it = *s_item;
            if (it >= 784) break;
#ifdef PROBE_SUB
            if (rep == 1 && !((PROBE_SUB == 1 && it < 16) || (PROBE_SUB == 2 && it >= 16 && it < 528) || (PROBE_SUB == 3 && it >= 528) || (PROBE_SUB == 4 && it >= 16))) continue;
#endif
            if (it < 16) hgrn_item(p, l, it, smem, rep);
            else if (it < 528) attn_item(p, it - 16, smem);
            else rgpost_item(p, it - 528, smem);
        }
    } else if (k == 6) {
        hgpost_range(p, smem);
    } else if (k == 7) {
        gemm_res(XB, (const bf16_t*)(p.ws + OFF_OUT + (size_t)l * SZ_OUT), 2048, p.ws, nullptr, nullptr, 1.0f);
    }
}

#ifndef MK_N_LAUNCHES
#define MK_N_LAUNCHES 1
#endif

#define XB_TMO      128
#define XB_XCNT(j)  (256  + 64 * (j))
#define XB_XSUB(j)  (1280 + 64 * (j))
#define XB_XGEN(j)  (2304 + 64 * (j))
#define XB_TOP      3328
#define XB_TOPGEN   3392
#define XCD_BAR_WORDS 3456
#define XB_SPIN_CAP (1u << 18)
#define LAS __attribute__((address_space(3)))

__device__ __forceinline__ unsigned xb_ld(unsigned* p)              { return __hip_atomic_load(p, __ATOMIC_RELAXED, __HIP_MEMORY_SCOPE_AGENT); }
__device__ __forceinline__ unsigned xb_add(unsigned* p, unsigned v) { return __hip_atomic_fetch_add(p, v, __ATOMIC_RELAXED, __HIP_MEMORY_SCOPE_AGENT); }
__device__ __forceinline__ unsigned xb_xcc_id() { return (unsigned)__builtin_amdgcn_s_getreg((3 << 11) | 20) & 0xFu; }
#define XB_SPIN(cond, bar) do { unsigned _sp = 0; while (cond) { __builtin_amdgcn_s_sleep(1); \
    if ((++_sp & 255u) == 0u) { if (xb_ld(&(bar)[XB_TMO])) break; if (_sp > XB_SPIN_CAP) { atomicAdd(&(bar)[XB_TMO], 1u); break; } } } } while (0)

struct XcdBarrier {
    unsigned* bar; unsigned x;
    volatile LAS unsigned* st;
};

__device__ __forceinline__ XcdBarrier xcd_barrier_post(unsigned* bar, volatile LAS unsigned* st) {
    XcdBarrier b; b.bar = bar; b.x = xb_xcc_id(); b.st = st;
    if (threadIdx.x == 0) (void)xb_add(&bar[XB_XCNT(b.x)], 1u);
    return b;
}
__device__ __forceinline__ void xcd_barrier_complete(unsigned* bar, unsigned x, unsigned& nloc, unsigned& nx) {
    const unsigned G = gridDim.x * gridDim.y * gridDim.z;
    unsigned sum, cnt, mine, sp = 0u;
    for (;;) {
        sum = 0u; cnt = 0u; mine = 0u;
#pragma unroll
        for (unsigned j = 0; j < 16; ++j) { const unsigned c = xb_ld(&bar[XB_XCNT(j)]); sum += c; cnt += (c > 0u) ? 1u : 0u; mine = (j == x) ? c : mine; }
        if (sum == G) break;
        __builtin_amdgcn_s_sleep(1);
        if ((++sp & 255u) == 0u) { if (xb_ld(&bar[XB_TMO])) break; if (sp > XB_SPIN_CAP) { atomicAdd(&bar[XB_TMO], 1u); break; } }
    }
    nloc = mine > 0u ? mine : 1u; nx = cnt > 0u ? cnt : 1u;
}

__device__ __forceinline__ void xcd_barrier(const XcdBarrier& b) {
    asm volatile("s_waitcnt vmcnt(0)" ::: "memory");
    __syncthreads();
    if (threadIdx.x == 0) {
        unsigned* bar = b.bar;
        __builtin_amdgcn_s_waitcnt(0);
        unsigned nloc = b.st[0], nx = b.st[1];
        if (nloc == 0u) { xcd_barrier_complete(bar, b.x, nloc, nx); b.st[0] = nloc; b.st[1] = nx; }
        const unsigned old = xb_add(&bar[XB_XSUB(b.x)], 1u);
        const unsigned gen = old / nloc;
        if (old + 1u == (gen + 1u) * nloc) {
            __builtin_amdgcn_fence(__ATOMIC_RELEASE, "agent");
            asm volatile("s_waitcnt vmcnt(0)" ::: "memory");
            const unsigned og = xb_add(&bar[XB_TOP], 1u);
            const unsigned tg = og / nx;
            if (og + 1u == (tg + 1u) * nx) xb_add(&bar[XB_TOPGEN], 1u);
            else XB_SPIN(xb_ld(&bar[XB_TOPGEN]) == tg, bar);
            __builtin_amdgcn_fence(__ATOMIC_ACQUIRE, "agent");
            xb_add(&bar[XB_XGEN(b.x)], 1u);
            asm volatile("s_waitcnt vmcnt(0)" ::: "memory");
        } else {
            XB_SPIN(xb_ld(&bar[XB_XGEN(b.x)]) == gen, bar);
            __builtin_amdgcn_fence(__ATOMIC_ACQUIRE, "agent");
            asm volatile("s_waitcnt vmcnt(0)" ::: "memory");
        }
    }
    __syncthreads();
}

#ifndef PROBE_DUP
#define PROBE_DUP -1
#endif

__global__ void __launch_bounds__(512, 2) mega_fwd(Params p) {
    extern __shared__ __attribute__((aligned(16))) unsigned char smem[];
    volatile LAS unsigned* st = (volatile LAS unsigned*)(LAS unsigned char*)(smem + LDS_BYTES - 32);
    if (threadIdx.x == 0) { st[0] = 0u; st[1] = 0u; }
    __syncthreads();
    const XcdBarrier xb = xcd_barrier_post((unsigned*)(p.ws + OFF_CTL) + 1024, st);
    for (int ph = p.ph_lo; ph < p.ph_hi; ++ph) {
        if (ph > p.ph_lo) {
            if (p.ph_lo < 0) cg::this_grid().sync();
            xcd_barrier(xb);
        }
        run_phase(p, ph, smem, 0);
        if (PROBE_DUP >= 0 && (ph == 0 ? PROBE_DUP == 100 : (((ph - 1) % 12) == PROBE_DUP && (PROBE_DUP != 5 || ph > 12)))) {
            xcd_barrier(xb);
            run_phase(p, ph, smem, 1);
        }
    }
}

extern "C" void kernel_launch(void* const* d_in, const int* in_sizes, int n_in, void* d_out, int out_size, void* d_ws, size_t ws_size, hipStream_t stream) {
    static int grid = 0;
    if (grid == 0) {
        if (n_in != 21 || ws_size < WS_END) { fprintf(stderr, "kernel_launch: unexpected n_in %d / ws_size %zu (need %zu)\n", n_in, ws_size, (size_t)WS_END); grid = -1; return; }
        int dev = 0, cus = 0, per_cu = 0;
        (void)hipGetDevice(&dev);
        (void)hipDeviceGetAttribute(&cus, hipDeviceAttributeMultiprocessorCount, dev);
        if (hipFuncSetAttribute((const void*)mega_fwd, hipFuncAttributeMaxDynamicSharedMemorySize, LDS_BYTES) != hipSuccess) { fprintf(stderr, "kernel_launch: hipFuncSetAttribute failed\n"); grid = -1; return; }
        if (hipOccupancyMaxActiveBlocksPerMultiprocessor(&per_cu, (const void*)mega_fwd, 512, LDS_BYTES) != hipSuccess || per_cu < 1) { fprintf(stderr, "kernel_launch: occupancy query says %d\n", per_cu); per_cu = 1; }
        (void)hipGetLastError();
        grid = cus * per_cu;
        fprintf(stderr, "kernel_launch: grid %d (cus %d x %d)\n", grid, cus, per_cu);
    }
    if (grid < 0) return;
    (void)in_sizes; (void)out_size;
    (void)hipMemsetAsync((char*)d_ws + OFF_CTL, 0, CTL_BYTES, stream);
    Params p{};
    for (int i = 0; i < 21; ++i) p.in[i] = (const float*)d_in[i];
    p.out = (float*)d_out; p.ws = (unsigned char*)d_ws;
#if MK_N_LAUNCHES == 1
    p.ph_lo = 0; p.ph_hi = NPHASE;
    void* args[] = {&p};
    hipError_t e = hipLaunchCooperativeKernel((const void*)mega_fwd, dim3(grid), dim3(512), args, LDS_BYTES, stream);
    if (e != hipSuccess) fprintf(stderr, "kernel_launch: cooperative launch failed: %s (grid %d)\n", hipGetErrorString(e), grid);
#else
    for (int ph = 0; ph < NPHASE; ++ph) {
        p.ph_lo = ph; p.ph_hi = ph + 1;
        hipLaunchKernelGGL(mega_fwd, dim3(grid), dim3(512), LDS_BYTES, stream, p);
    }
#endif
}
```

```cpp
#include <hip/hip_runtime.h>
#include <hip/hip_cooperative_groups.h>
#include <cstdio>
#include <cstdint>
namespace cg = cooperative_groups;
namespace pg8 {
#define PG8_LAS __attribute__((address_space(3)))
typedef unsigned short bf16_t;
typedef short bf16x8 __attribute__((ext_vector_type(8)));
typedef float f32x4 __attribute__((ext_vector_type(4)));
typedef unsigned u32x4 __attribute__((ext_vector_type(4)));
constexpr int BM = 256, BK = 64, HALF = 128, HTB = HALF * BK * 2  , STAGE_BYTES = 8 * HTB, NXCD = 8, WGM = 8;

__host__ __device__ __forceinline__ int lds_byte(int r, int c) { const int st = (r >> 4) * 2 + (c >> 5), rr = r & 15, cc = c & 31, ob = rr * 64 + cc * 2; return st * 1024 + (ob ^ (((ob >> 9) & 1) << 5)); }
__host__ __device__ __forceinline__ void stage_rc(int b, int& R, int& C) { const int st = b / 1024, sb = b % 1024, swz = sb ^ (((sb >> 9) & 1) << 5); R = (st >> 1) * 16 + swz / 64; C = (st & 1) * 32 + (swz % 64) / 2; }
__host__ __device__ __forceinline__ int perm32(int rho) { const int n = rho >> 4, i = rho & 15; return 8 * (i >> 2) + 4 * n + (i & 3); }

struct Unit { int pm, pn; };
struct Gemm { const bf16_t* A; const bf16_t* Bt; int M, N, K; };

struct StaticOrder {
    int nM, nN, nwg, G, c;
    __host__ __device__ void init(int M, int N, int G_, int c_) { nM = M / BM; nN = N / BM; nwg = nM * nN; G = G_; c = c_; }
    __host__ __device__ bool next(int i, Unit& u) const {
        const long L = (long)i * G + c; if (L >= nwg) return false;
        int wgid = (int)L; { const int q = nwg / NXCD, r = nwg % NXCD, xcd = wgid % NXCD, off = wgid / NXCD; wgid = (xcd < r ? xcd * (q + 1) : r * (q + 1) + (xcd - r) * q) + off; }
        const int nig = WGM * nN, gid = wgid / nig, fm = gid * WGM, gsz = (nM - fm) < WGM ? (nM - fm) : WGM;
        u.pm = fm + ((wgid % nig) % gsz); u.pn = (wgid % nig) / gsz; return true;
    }
    __device__ __forceinline__ void a_ready(const Unit&) const {}
    __device__ __forceinline__ void done(const Unit&) const {}
};
__device__ __forceinline__ unsigned cvt_pk_bf16(float lo, float hi) { unsigned r; asm volatile("v_cvt_pk_bf16_f32 %0, %1, %2" : "=v"(r) : "v"(lo), "v"(hi)); return r; }
template <class Epi, class Sched>
__device__ __forceinline__ void gemm_phase(PG8_LAS unsigned char* lds, const Gemm g, const Sched& S, const Epi& E) {
    int tid_ = threadIdx.x; asm volatile("" : "+v"(tid_)); const int tid = tid_, wid = __builtin_amdgcn_readfirstlane(tid >> 6), lane = tid & 63, wr = wid >> 2, wc = wid & 3, fr = lane & 15, fq = lane >> 4;
    const int K = g.K, nt = K / BK;
    unsigned voffA[2], voffB[2];
#pragma unroll
    for (int i = 0; i < 2; ++i) { int R, C; stage_rc(tid * 16 + i * 8192, R, C); const int Rb = Epi::PERM ? ((R & ~31) + perm32(R & 31)) : R;
        voffA[i] = (unsigned)(R * K + C) * 2u; voffB[i] = (unsigned)(Rb * K + C) * 2u; }
    const size_t kstep = (size_t)(BK * 2);
    const size_t hstep = (size_t)HALF * K * 2;
    const size_t tstep = 2 * hstep;
    const unsigned ldsw = (unsigned)wid * 1024u;
    const int aoff = lds_byte(wr * 64 + fr, fq * 8), boff = lds_byte(wc * 32 + fr, fq * 8);
#define PG8_SA(b, h) (((b) * 2 + (h)) * HTB)
#define PG8_SB(b, h) ((4 + (b) * 2 + (h)) * HTB)
#define PG8_STAGE(bufoff, gbase, voff) do { _Pragma("unroll") for (int _i = 0; _i < 2; ++_i) \
        __builtin_amdgcn_global_load_lds((const unsigned*)((const char*)(gbase) + (voff)[_i]), (PG8_LAS unsigned*)(lds + (bufoff) + ldsw + _i * 8192), 16, 0, 0); } while (0)
#define PG8_LDA(dst, b, h) do { _Pragma("unroll") for (int m = 0; m < 4; ++m) _Pragma("unroll") for (int k = 0; k < 2; ++k) dst[m][k] = *(const PG8_LAS bf16x8*)(lds + PG8_SA(b, h) + aoff + m * 2048 + k * 1024); } while (0)
#define PG8_LDB(dst, b, h) do { _Pragma("unroll") for (int n = 0; n < 2; ++n) _Pragma("unroll") for (int k = 0; k < 2; ++k) dst[n][k] = *(const PG8_LAS bf16x8*)(lds + PG8_SB(b, h) + boff + n * 2048 + k * 1024); } while (0)
#define PG8_MMA(ai, bj, At, Bt) do { __builtin_amdgcn_s_setprio(1); _Pragma("unroll") for (int m = 0; m < 4; ++m) _Pragma("unroll") for (int n = 0; n < 2; ++n) _Pragma("unroll") for (int k = 0; k < 2; ++k) \
        acc[ai][bj][m][n] = __builtin_amdgcn_mfma_f32_16x16x32_bf16(Bt[n][k], At[m][k], acc[ai][bj][m][n], 0, 0, 0); __builtin_amdgcn_s_setprio(0); } while (0)
#define PG8_WAIT_V(n) asm volatile("s_waitcnt vmcnt(" #n ")" ::: "memory")
#define PG8_WAIT_L(n) asm volatile("s_waitcnt lgkmcnt(" #n ")" ::: "memory")
#define PG8_BAR __builtin_amdgcn_s_barrier()
#define PG8_SCHED __builtin_amdgcn_sched_barrier(0)
    Unit cur, nxt; int ui = 0;
    if (!S.next(0, cur)) return;
    f32x4 acc[2][2][4][2];
#pragma unroll
    for (int a = 0; a < 2; ++a)
#pragma unroll
        for (int b = 0; b < 2; ++b)
#pragma unroll
            for (int m = 0; m < 4; ++m)
#pragma unroll
                for (int n = 0; n < 2; ++n) acc[a][b][m][n] = (f32x4){0.f, 0.f, 0.f, 0.f};
    bf16x8 At[4][2], B0[2][2], B1[2][2];
    const char* cA = (const char*)g.A + (size_t)cur.pm * tstep; const char* cB = (const char*)g.Bt + (size_t)cur.pn * tstep;
    S.a_ready(cur);
    PG8_STAGE(PG8_SB(0, 0), cB, voffB); PG8_STAGE(PG8_SA(0, 0), cA, voffA); PG8_STAGE(PG8_SB(0, 1), cB + hstep, voffB); PG8_STAGE(PG8_SA(0, 1), cA + hstep, voffA);
    if (wr == 1) PG8_BAR;
    PG8_WAIT_V(4); PG8_BAR;
    PG8_STAGE(PG8_SB(1, 0), cB + kstep, voffB); PG8_STAGE(PG8_SA(1, 0), cA + kstep, voffA); PG8_STAGE(PG8_SB(1, 1), cB + hstep + kstep, voffB);
    PG8_WAIT_V(6); PG8_BAR;
    for (;;) {
        const bool has_next = S.next(ui + 1, nxt);
        const char* nA = has_next ? (const char*)g.A + (size_t)nxt.pm * tstep : cA; const char* nB = has_next ? (const char*)g.Bt + (size_t)nxt.pn * tstep : cB;
        for (int t = 0; t < nt; t += 2) {
            const bool last = (t == nt - 2);
            const char* a1 = cA + (size_t)(t + 1) * kstep;
            const char* a2 = last ? nA : cA + (size_t)(t + 2) * kstep; const char* b2 = last ? nB : cB + (size_t)(t + 2) * kstep;
            const char* a3 = a2 + kstep; const char* b3 = b2 + kstep;
            if (last && has_next) S.a_ready(nxt);
            PG8_LDB(B0, 0, 0); PG8_SCHED; PG8_LDA(At, 0, 0); PG8_STAGE(PG8_SA(1, 1), a1 + hstep, voffA);
            PG8_WAIT_L(8); PG8_BAR; PG8_WAIT_L(0); PG8_MMA(0, 0, At, B0); PG8_BAR; PG8_SCHED;
            PG8_LDB(B1, 0, 1); PG8_STAGE(PG8_SB(0, 0), b2, voffB);
            PG8_BAR; PG8_WAIT_L(0); PG8_MMA(0, 1, At, B1); PG8_BAR;
            PG8_LDA(At, 0, 1); PG8_STAGE(PG8_SA(0, 0), a2, voffA);
            PG8_BAR; PG8_WAIT_L(0); PG8_MMA(1, 0, At, B0); PG8_BAR; PG8_SCHED;
            PG8_STAGE(PG8_SB(0, 1), b2 + hstep, voffB);
            PG8_WAIT_V(6); PG8_BAR; PG8_MMA(1, 1, At, B1); PG8_BAR;
            PG8_LDB(B0, 1, 0); PG8_SCHED; PG8_LDA(At, 1, 0); PG8_STAGE(PG8_SA(0, 1), a2 + hstep, voffA);
            PG8_WAIT_L(8); PG8_BAR; PG8_WAIT_L(0); PG8_MMA(0, 0, At, B0); PG8_BAR; PG8_SCHED;
            PG8_LDB(B1, 1, 1); PG8_STAGE(PG8_SB(1, 0), b3, voffB);
            PG8_BAR; PG8_WAIT_L(0); PG8_MMA(0, 1, At, B1); PG8_BAR;
            PG8_LDA(At, 1, 1); PG8_STAGE(PG8_SA(1, 0), a3, voffA);
            PG8_BAR; PG8_WAIT_L(0); PG8_MMA(1, 0, At, B0); PG8_BAR; PG8_SCHED;
            PG8_STAGE(PG8_SB(1, 1), b3 + hstep, voffB);
            PG8_WAIT_V(6); PG8_BAR; PG8_MMA(1, 1, At, B1); PG8_BAR;
        }
        if constexpr (!Epi::AFTER_DRAIN) { E(acc, cur, wr, wc, fr, fq); S.done(cur); }
        if (!has_next) break;
#pragma unroll
        for (int a = 0; a < 2; ++a)
#pragma unroll
            for (int b = 0; b < 2; ++b)
#pragma unroll
                for (int m = 0; m < 4; ++m)
#pragma unroll
                    for (int n = 0; n < 2; ++n) acc[a][b][m][n] = (f32x4){0.f, 0.f, 0.f, 0.f};
        cur = nxt; cA = nA; cB = nB; ++ui;
    }
    PG8_WAIT_V(0);
    if (wr == 0) PG8_BAR;
    PG8_BAR;
    if constexpr (Epi::AFTER_DRAIN) { E.fused(acc, cur, wr, wc, fr, fq, lds, wid, lane); S.done(cur); }
#undef PG8_SA
#undef PG8_SB
#undef PG8_STAGE
#undef PG8_LDA
#undef PG8_LDB
#undef PG8_MMA
#undef PG8_WAIT_V
#undef PG8_WAIT_L
#undef PG8_BAR
#undef PG8_SCHED
}
}

using pg8::bf16_t; using pg8::bf16x8; using pg8::f32x4; using pg8::u32x4; using pg8::cvt_pk_bf16;
typedef unsigned u32x2 __attribute__((ext_vector_type(2)));

constexpr int NTOK = 16384, DM = 2048, DFF = 5632, DIN = 5632, SEQ = 4096;
constexpr float LN_EPS = 1e-5f;
constexpr float ALPHA = 1.41421356237f;
constexpr int LDS_BYTES = 147456;
constexpr int NPHASE = 25;

constexpr size_t SZ_GU = (size_t)11264 * 2048 * 2, SZ_DN = (size_t)2048 * 5632 * 2, SZ_IN = (size_t)5632 * 2048 * 2,
                 SZ_OUT = (size_t)2048 * 2048 * 2, SZ_RG = (size_t)4 * 128 * 128 * 2;
constexpr size_t OFF_CTL = 0, CTL_BYTES = 32768, OFF_GU = CTL_BYTES, OFF_DN = OFF_GU + 4 * SZ_GU, OFF_IN = OFF_DN + 4 * SZ_DN, OFF_OUT = OFF_IN + 2 * SZ_IN,
                 OFF_RGA = OFF_OUT + 2 * SZ_OUT, OFF_RGX = OFF_RGA + 2 * SZ_RG, OFF_X = OFF_RGX + 2 * SZ_RG,
                 OFF_XB = OFF_X + (size_t)NTOK * DM * 4, OFF_H = OFF_XB + (size_t)NTOK * DM * 2,
                 OFF_KMEAN = OFF_H + (size_t)NTOK * DFF * 2, OFF_ATILE = OFF_KMEAN + 131072, OFF_HTILE = OFF_ATILE + 524288,
                 OFF_HQS = OFF_HTILE + 524288, OFF_HKDT = OFF_HQS + 16777216, OFF_HVT = OFF_HKDT + 16777216, OFF_HEL = OFF_HVT + 16777216,
                 OFF_HGS = OFF_HEL + 1048576, OFF_STATS = OFF_HGS + 33554432, OFF_GB = OFF_STATS + 131072, WS_END = OFF_GB + 16384;
constexpr size_t OUT_HLOC = 0, OUT_CUMA = 33554432, OUT_VT = 67108864, OUT_OI = 83886080;

struct Params { const float* in[21]; float* out; unsigned char* ws; int ph_lo, ph_hi; };

__device__ __forceinline__ float bf2f(unsigned short u) { return __uint_as_float(((unsigned)u) << 16); }
__device__ __forceinline__ unsigned short f2bf(float f) { unsigned u = __float_as_uint(f); u += 0x7FFFu + ((u >> 16) & 1u); return (unsigned short)(u >> 16); }
__device__ __forceinline__ float sigm(float x) { return __builtin_amdgcn_rcpf(1.0f + __expf(-x)); }
__device__ __forceinline__ bf16x8 pack8(float a0, float a1, float a2, float a3, float a4, float a5, float a6, float a7) {
    u32x4 w; w.x = cvt_pk_bf16(a0, a1); w.y = cvt_pk_bf16(a2, a3); w.z = cvt_pk_bf16(a4, a5); w.w = cvt_pk_bf16(a6, a7);
    return __builtin_bit_cast(bf16x8, w);
}
__device__ __forceinline__ int opaque_tid() { int t = threadIdx.x; asm volatile("" : "+v"(t)); return t; }
__device__ __forceinline__ float row16_sum_to15(float x) {
    x += __int_as_float(__builtin_amdgcn_update_dpp(0, __float_as_int(x), 0x111, 0xf, 0xf, true));
    x += __int_as_float(__builtin_amdgcn_update_dpp(0, __float_as_int(x), 0x112, 0xf, 0xf, true));
    x += __int_as_float(__builtin_amdgcn_update_dpp(0, __float_as_int(x), 0x114, 0xf, 0xf, true));
    x += __int_as_float(__builtin_amdgcn_update_dpp(0, __float_as_int(x), 0x118, 0xf, 0xf, true));
    return x;
}
__device__ __forceinline__ void lds_barrier() { asm volatile("s_waitcnt lgkmcnt(0)" ::: "memory"); __builtin_amdgcn_s_barrier(); asm volatile("" ::: "memory"); }
__device__ __forceinline__ u32x2 pack4(f32x4 v) { u32x2 w; w.x = cvt_pk_bf16(v[0], v[1]); w.y = cvt_pk_bf16(v[2], v[3]); return w; }
__device__ __forceinline__ f32x4 unpack4(u32x2 w) { return (f32x4){__uint_as_float(w.x << 16), __uint_as_float(w.x & 0xffff0000u), __uint_as_float(w.y << 16), __uint_as_float(w.y & 0xffff0000u)}; }
typedef _Float16 h16x4 __attribute__((ext_vector_type(4)));
__device__ __forceinline__ u32x2 pack4h(f32x4 v) { const h16x4 h = __builtin_convertvector(v, h16x4); return __builtin_bit_cast(u32x2, h); }
__device__ __forceinline__ f32x4 unpack4h(u32x2 w) { return __builtin_convertvector(__builtin_bit_cast(h16x4, w), f32x4); }
#define MFMA16(a, b, c) __builtin_amdgcn_mfma_f32_16x16x32_bf16((a), (b), (c), 0, 0, 0)

struct EpiSwiGLU {
    static constexpr bool PERM = true, AFTER_DRAIN = false;
    bf16_t* H;
    __device__ __forceinline__ void operator()(const f32x4 (&acc)[2][2][4][2], const pg8::Unit& u, int wr, int wc, int fr, int fq) const {
        const int row0 = u.pm * 256 + wr * 64 + fr, col0 = u.pn * 128 + wc * 32 + 8 * fq;
#pragma unroll
        for (int ai = 0; ai < 2; ++ai)
#pragma unroll
            for (int m = 0; m < 4; ++m) {
                bf16_t* rowp = H + (size_t)(row0 + ai * 128 + m * 16) * DFF + col0;
                float hv[8];
#pragma unroll
                for (int n = 0; n < 2; ++n)
#pragma unroll
                    for (int j = 0; j < 4; ++j) { const float g = acc[ai][0][m][n][j], up = acc[ai][1][m][n][j]; hv[n * 4 + j] = g * sigm(g) * up; }
                u32x4 w; w.x = cvt_pk_bf16(hv[0], hv[1]); w.y = cvt_pk_bf16(hv[2], hv[3]); w.z = cvt_pk_bf16(hv[4], hv[5]); w.w = cvt_pk_bf16(hv[6], hv[7]);
                *(u32x4*)rowp = w;
            }
    }
};
struct EpiResid {
    static constexpr bool PERM = true, AFTER_DRAIN = false;
    unsigned char* ws; const float* Rraw; float* Oalt; float s;
    __device__ __forceinline__ void operator()(const f32x4 (&acc)[2][2][4][2], const pg8::Unit& u, int wr, int wc, int fr_, int fq_) const {
        int fr = fr_, fq = fq_; asm volatile("" : "+v"(fr), "+v"(fq));
        const int row0 = u.pm * 256 + wr * 64 + fr, col0 = u.pn * 256 + wc * 32 + 8 * fq;
        const bool ln = (Rraw == nullptr);
        bf16_t* Z = (bf16_t*)(ws + OFF_X);
        const float* st = (const float*)(ws + OFF_STATS); const float* gb = (const float*)(ws + OFF_GB);
        if (ln) {
#pragma unroll
            for (int bj = 0; bj < 2; ++bj) {
                f32x4 gv[2], bv[2];
#pragma unroll
                for (int n = 0; n < 2; ++n) { gv[n] = *(const f32x4*)(gb + col0 + bj * 128 + 4 * n); bv[n] = *(const f32x4*)(gb + DM + col0 + bj * 128 + 4 * n); }
                u32x4 r[2][4]; float mu[2][4], rs[2][4];
#pragma unroll
                for (int ai = 0; ai < 2; ++ai)
#pragma unroll
                    for (int m = 0; m < 4; ++m) { const int row = row0 + ai * 128 + m * 16; const unsigned off = (unsigned)row * DM + (unsigned)(col0 + bj * 128);
                        { const float2 ms = *(const float2*)(st + 2u * (unsigned)row); mu[ai][m] = ms.x; rs[ai][m] = ms.y; }
                        r[ai][m] = *(const u32x4*)(Z + off); }
                asm volatile("" ::: "memory");
#pragma unroll
                for (int ai = 0; ai < 2; ++ai)
#pragma unroll
                    for (int m = 0; m < 4; ++m) { const unsigned off = (unsigned)(row0 + ai * 128 + m * 16) * DM + (unsigned)(col0 + bj * 128);
                        u32x2 lo, hi; lo.x = r[ai][m].x; lo.y = r[ai][m].y; hi.x = r[ai][m].z; hi.y = r[ai][m].w;
                        const f32x4 x0 = (unpack4h(lo) - mu[ai][m]) * rs[ai][m] * gv[0] + bv[0], x1 = (unpack4h(hi) - mu[ai][m]) * rs[ai][m] * gv[1] + bv[1];
                        const u32x2 o0 = pack4h(x0 * ALPHA + acc[ai][bj][m][0] * s), o1 = pack4h(x1 * ALPHA + acc[ai][bj][m][1] * s);
                        u32x4 w; w.x = o0.x; w.y = o0.y; w.z = o1.x; w.w = o1.y; *(u32x4*)(Z + off) = w; }
            }
        } else {
#pragma unroll
            for (int bj = 0; bj < 2; ++bj)
#pragma unroll
                for (int ai = 0; ai < 2; ++ai) {
                    f32x4 r[4][2];
#pragma unroll
                    for (int m = 0; m < 4; ++m) { const size_t off = (size_t)(row0 + ai * 128 + m * 16) * DM + col0 + bj * 128;
#pragma unroll
                        for (int n = 0; n < 2; ++n) r[m][n] = *(const f32x4*)(Rraw + off + 4 * n); }
                    asm volatile("" ::: "memory");
#pragma unroll
                    for (int m = 0; m < 4; ++m) { const size_t off = (size_t)(row0 + ai * 128 + m * 16) * DM + col0 + bj * 128;
                        const u32x2 o0 = pack4h(r[m][0] * ALPHA + acc[ai][bj][m][0] * s), o1 = pack4h(r[m][1] * ALPHA + acc[ai][bj][m][1] * s);
                        u32x4 w; w.x = o0.x; w.y = o0.y; w.z = o1.x; w.w = o1.y; *(u32x4*)(Z + off) = w; }
                }
        }
    }
};
struct EpiBf16P {
    static constexpr bool PERM = true, AFTER_DRAIN = false;
    bf16_t* O; int ldc;
    __device__ __forceinline__ void operator()(const f32x4 (&acc)[2][2][4][2], const pg8::Unit& u, int wr, int wc, int fr, int fq) const {
        const int row0 = u.pm * 256 + wr * 64 + fr, col0 = u.pn * 256 + wc * 32 + 8 * fq;
#pragma unroll
        for (int ai = 0; ai < 2; ++ai)
#pragma unroll
            for (int m = 0; m < 4; ++m) {
                bf16_t* rowp = O + (size_t)(row0 + ai * 128 + m * 16) * ldc + col0;
#pragma unroll
                for (int bj = 0; bj < 2; ++bj) { const f32x4 v0 = acc[ai][bj][m][0], v1 = acc[ai][bj][m][1];
                    u32x4 w; w.x = cvt_pk_bf16(v0[0], v0[1]); w.y = cvt_pk_bf16(v0[2], v0[3]); w.z = cvt_pk_bf16(v1[0], v1[1]); w.w = cvt_pk_bf16(v1[2], v1[3]);
                    *(u32x4*)(rowp + bj * 128) = w; }
            }
    }
};

__device__ __forceinline__ void convT_job(const float* __restrict__ src, bf16_t* __restrict__ dst, int K, int N, int mode, float* t) {
    const int tid = opaque_tid(), ntn = N >> 6, ntiles = (K >> 7) * ntn;
    const int lk = tid >> 4, ln4 = (tid & 15) * 4;
    float4 pv[4];
#define CVT_LOAD(tile_) do { const int k0_ = ((tile_) / ntn) << 7, n0_ = ((tile_) % ntn) << 6; \
        _Pragma("unroll") for (int pp = 0; pp < 4; ++pp) pv[pp] = *(const float4*)(src + (size_t)(k0_ + lk + 32 * pp) * N + n0_ + ln4); } while (0)
    int tile = blockIdx.x;
    if (tile < ntiles) CVT_LOAD(tile);
#pragma unroll 1
    for (; tile < ntiles; tile += gridDim.x) {
        const int k0 = (tile / ntn) << 7, n0 = (tile % ntn) << 6;
#pragma unroll
        for (int pp = 0; pp < 4; ++pp) { const int k = lk + 32 * pp; t[k * 65 + ln4] = pv[pp].x; t[k * 65 + ln4 + 1] = pv[pp].y; t[k * 65 + ln4 + 2] = pv[pp].z; t[k * 65 + ln4 + 3] = pv[pp].w; }
        if (tile + (int)gridDim.x < ntiles) CVT_LOAD(tile + (int)gridDim.x);
        lds_barrier();
        const int n = tid >> 3, k16 = (tid & 7) * 16;
        float v[16];
#pragma unroll
        for (int j = 0; j < 16; ++j) v[j] = t[(k16 + j) * 65 + n];
        const int nn = n0 + n;
        const int row = mode == 0 ? nn : (256 * (nn >> 7) + (nn & 127) + (mode == 2 ? 128 : 0));
        u32x4 w0, w1; w0.x = cvt_pk_bf16(v[0], v[1]); w0.y = cvt_pk_bf16(v[2], v[3]); w0.z = cvt_pk_bf16(v[4], v[5]); w0.w = cvt_pk_bf16(v[6], v[7]);
        w1.x = cvt_pk_bf16(v[8], v[9]); w1.y = cvt_pk_bf16(v[10], v[11]); w1.z = cvt_pk_bf16(v[12], v[13]); w1.w = cvt_pk_bf16(v[14], v[15]);
        bf16_t* d = dst + (size_t)row * K + k0 + k16;
        *(u32x4*)d = w0; *(u32x4*)(d + 8) = w1;
        lds_barrier();
    }
#undef CVT_LOAD
}
__device__ __forceinline__ void phase_convert(const Params& p, unsigned char* smem) {
    float* t = (float*)smem;
    for (int l = 0; l < 2; ++l) {
        for (int f = 0; f < 2; ++f) {
            const size_t wo = (size_t)(l * 2 + f) * 2048 * 5632;
            bf16_t* gu = (bf16_t*)(p.ws + OFF_GU + (size_t)(l * 2 + f) * SZ_GU);
            convT_job(p.in[3] + wo, gu, 2048, 5632, 1, t);
            convT_job(p.in[4] + wo, gu, 2048, 5632, 2, t);
            convT_job(p.in[5] + wo, (bf16_t*)(p.ws + OFF_DN + (size_t)(l * 2 + f) * SZ_DN), 5632, 2048, 0, t);
        }
        convT_job(p.in[6] + (size_t)l * 2048 * 5632, (bf16_t*)(p.ws + OFF_IN + (size_t)l * SZ_IN), 2048, 5632, 0, t);
        convT_job(p.in[7] + (size_t)l * 2048 * 2048, (bf16_t*)(p.ws + OFF_OUT + (size_t)l * SZ_OUT), 2048, 2048, 0, t);
        for (int g = 0; g < 4; ++g) {
            convT_job(p.in[10] + (size_t)(l * 4 + g) * 16384, (bf16_t*)(p.ws + OFF_RGA + (size_t)l * SZ_RG) + g * 16384, 128, 128, 0, t);
            convT_job(p.in[12] + (size_t)(l * 4 + g) * 16384, (bf16_t*)(p.ws + OFF_RGX + (size_t)l * SZ_RG) + g * 16384, 128, 128, 0, t);
        }
    }
    const float4* xs = (const float4*)p.in[0]; u32x2* xd = (u32x2*)(p.ws + OFF_XB);
    const size_t n4 = (size_t)NTOK * DM / 4, gstr = (size_t)gridDim.x * 512;
    size_t i = (size_t)blockIdx.x * 512 + opaque_tid();
    for (; i + 7 * gstr < n4; i += 8 * gstr) {
        float4 v[8];
#pragma unroll
        for (int k = 0; k < 8; ++k) v[k] = xs[i + k * gstr];
#pragma unroll
        for (int k = 0; k < 8; ++k) { u32x2 w; w.x = cvt_pk_bf16(v[k].x, v[k].y); w.y = cvt_pk_bf16(v[k].z, v[k].w); xd[i + k * gstr] = w; }
    }
    for (; i < n4; i += gstr) { const float4 v = xs[i]; u32x2 w; w.x = cvt_pk_bf16(v.x, v.y); w.y = cvt_pk_bf16(v.z, v.w); xd[i] = w; }
}

__device__ __forceinline__ void phase_ln(const bf16_t* zin, float* xout, bf16_t* xb, float* stats, float* gbtab, const float* __restrict__ g, const float* __restrict__ b) {
    const int tid_ln = opaque_tid(); const int wave = tid_ln >> 6, lane = tid_ln & 63;
    if (gbtab && blockIdx.x == 0) { for (int i = tid_ln; i < DM; i += 512) { gbtab[i] = g[i]; gbtab[DM + i] = b[i]; } }
    const int rstep = gridDim.x * 8;
    int row = blockIdx.x * 8 + wave;
    u32x4 nv[4];
    if (row < NTOK) { const u32x4* src = (const u32x4*)(zin + (size_t)row * DM);
#pragma unroll
        for (int i = 0; i < 4; ++i) nv[i] = src[lane + 64 * i]; }
#pragma unroll 1
    for (; row < NTOK; row += rstep) {
        f32x4 v[8]; float s = 0.f;
#pragma unroll
        for (int i = 0; i < 4; ++i) { u32x2 lo, hi; lo.x = nv[i].x; lo.y = nv[i].y; hi.x = nv[i].z; hi.y = nv[i].w; v[2 * i] = unpack4h(lo); v[2 * i + 1] = unpack4h(hi); }
#pragma unroll
        for (int i = 0; i < 8; ++i) s += (v[i][0] + v[i][1]) + (v[i][2] + v[i][3]);
        if (row + rstep < NTOK) { const u32x4* src = (const u32x4*)(zin + (size_t)(row + rstep) * DM);
#pragma unroll
            for (int i = 0; i < 4; ++i) nv[i] = src[lane + 64 * i]; }
#pragma unroll
        for (int o = 32; o > 0; o >>= 1) s += __shfl_xor(s, o);
        const float mu = s * (1.0f / DM); float q = 0.f;
#pragma unroll
        for (int i = 0; i < 8; ++i) { const f32x4 d = v[i] - mu; q += (d[0] * d[0] + d[1] * d[1]) + (d[2] * d[2] + d[3] * d[3]); }
#pragma unroll
        for (int o = 32; o > 0; o >>= 1) q += __shfl_xor(q, o);
        const float rstd = rsqrtf(q * (1.0f / DM) + LN_EPS);
        if (stats && lane == 0) { stats[2 * row] = mu; stats[2 * row + 1] = rstd; }
#pragma unroll
        for (int i = 0; i < 4; ++i) {
            const int e0 = (lane + 64 * i) * 8;
            const f32x4 g0 = *(const f32x4*)(g + e0), g1 = *(const f32x4*)(g + e0 + 4), b0 = *(const f32x4*)(b + e0), b1 = *(const f32x4*)(b + e0 + 4);
            const f32x4 y0 = (v[2 * i] - mu) * rstd * g0 + b0, y1 = (v[2 * i + 1] - mu) * rstd * g1 + b1;
            if (xout) { *(f32x4*)(xout + (size_t)row * DM + e0) = y0; *(f32x4*)(xout + (size_t)row * DM + e0 + 4) = y1; }
            if (xb) { const u32x2 w0 = pack4(y0), w1 = pack4(y1); u32x4 w; w.x = w0.x; w.y = w0.y; w.z = w1.x; w.w = w1.y; *(u32x4*)(xb + (size_t)row * DM + e0) = w; }
        }
    }
}

__device__ __forceinline__ void kvpre_item(const Params& p, int item, unsigned char* smem) {
    const int tid = opaque_tid(), dgrp = tid & 15, krow = tid >> 4;
    const int bh = item >> 4, j = item & 15, b = bh >> 2, h = bh & 3;
    const bf16_t* P = (const bf16_t*)(p.ws + OFF_H);
    bf16_t* Vt = (bf16_t*)((unsigned char*)p.out + OUT_VT);
    float* red = (float*)smem;
    bf16_t* Vl = (bf16_t*)(smem + 16384);
    const bf16_t* Kb = P + ((size_t)b * SEQ + j * 256 + krow * 8) * DIN + 512 + h * 128 + dgrp * 8;
    u32x4 kr[8], vr[8];
#pragma unroll
    for (int i = 0; i < 8; ++i) { kr[i] = *(const u32x4*)(Kb + (size_t)i * DIN); vr[i] = *(const u32x4*)(Kb + (size_t)i * DIN + 512); }
    float ks[8] = {0.f, 0.f, 0.f, 0.f, 0.f, 0.f, 0.f, 0.f};
#pragma unroll
    for (int i = 0; i < 8; ++i) {
        ks[0] += __uint_as_float(kr[i].x << 16); ks[1] += __uint_as_float(kr[i].x & 0xffff0000u); ks[2] += __uint_as_float(kr[i].y << 16); ks[3] += __uint_as_float(kr[i].y & 0xffff0000u);
        ks[4] += __uint_as_float(kr[i].z << 16); ks[5] += __uint_as_float(kr[i].z & 0xffff0000u); ks[6] += __uint_as_float(kr[i].w << 16); ks[7] += __uint_as_float(kr[i].w & 0xffff0000u);
    }
    *(f32x4*)(red + krow * 128 + dgrp * 8) = (f32x4){ks[0], ks[1], ks[2], ks[3]}; *(f32x4*)(red + krow * 128 + dgrp * 8 + 4) = (f32x4){ks[4], ks[5], ks[6], ks[7]};
#pragma unroll
    for (int e = 0; e < 8; ++e) {
        unsigned hv[8];
#pragma unroll
        for (int i = 0; i < 8; ++i) { const unsigned wsel = (e >> 1) == 0 ? vr[i].x : ((e >> 1) == 1 ? vr[i].y : ((e >> 1) == 2 ? vr[i].z : vr[i].w)); hv[i] = (e & 1) ? (wsel >> 16) : (wsel & 0xffffu); }
        u32x4 wv; wv.x = hv[0] | (hv[1] << 16); wv.y = hv[2] | (hv[3] << 16); wv.z = hv[4] | (hv[5] << 16); wv.w = hv[6] | (hv[7] << 16);
        const int d = dgrp * 8 + e;
        *(u32x4*)(Vl + d * 256 + ((krow ^ dgrp) << 3)) = wv;
    }
    lds_barrier();
    if (tid < 128) { float s = 0.f;
#pragma unroll 8
        for (int r = 0; r < 32; ++r) s += red[r * 128 + tid];
        ((float*)(p.ws + OFF_KMEAN))[((size_t)bh * 16 + j) * 128 + tid] = s * (1.0f / 256.0f); }
#pragma unroll
    for (int r = 0; r < 8; ++r) {
        const int idx = r * 512 + tid, d = idx >> 5, pc = idx & 31, lc = pc ^ ((d >> 3) & 15);
        const u32x4 wv = *(const u32x4*)(Vl + d * 256 + (pc << 3));
        *(u32x4*)(Vt + ((size_t)bh * 128 + d) * SEQ + j * 256 + (lc << 3)) = wv;
    }
    lds_barrier();
}

__device__ __forceinline__ void rgpre_range(const Params& p, int layer, unsigned char* smem) {
    const int tid = opaque_tid(), c = tid & 127, sg = tid >> 7, w = tid >> 6, lane = tid & 63, fr = lane & 15, fq = lane >> 4;
    const bf16_t* P = (const bf16_t*)(p.ws + OFF_H);
    float* xcf = (float*)smem; bf16_t* xcb = (bf16_t*)(smem + 32768); float* aL = (float*)(smem + 50176); float* uL = (float*)(smem + 82944);
    float* segA = (float*)(smem + 115712); float* segH = (float*)(smem + 117760);
    float* HL = (float*)((unsigned char*)p.out + OUT_HLOC); float* CA = (float*)((unsigned char*)p.out + OUT_CUMA);
    bf16x8 Ba[4], Bx[4];
    int g_loaded = -1;
    float cw0 = 0.f, cw1 = 0.f, cw2 = 0.f, cw3 = 0.f, cb = 0.f, ba = 0.f, bx = 0.f, sp = 0.f;
    unsigned short nx[19];
#define RGP_LOAD(item_) do { const int g_ = (item_) & 3, bt_ = (item_) >> 2, b_ = bt_ >> 6, tau_ = bt_ & 63; const bf16_t* Px_ = P + (size_t)b_ * SEQ * DIN + 2048 + g_ * 128 + c; const int tb_ = tau_ * 64 + sg * 16 - 3; \
        _Pragma("unroll") for (int i = 0; i < 19; ++i) { const int pos_ = tb_ + i; nx[i] = pos_ >= 0 ? Px_[(size_t)pos_ * DIN] : (unsigned short)0; } } while (0)
    int item = blockIdx.x;
    if (item < 1024) RGP_LOAD(item);
#pragma unroll 1
    for (; item < 1024; item += gridDim.x) {
        const int g = item & 3, bt = item >> 2, b = bt >> 6, tau = bt & 63;
        const int ch = g * 128 + c;
        if (g != g_loaded) {
            g_loaded = g;
            const bf16_t* Wa = (const bf16_t*)(p.ws + OFF_RGA + (size_t)layer * SZ_RG) + g * 16384;
            const bf16_t* Wx = (const bf16_t*)(p.ws + OFF_RGX + (size_t)layer * SZ_RG) + g * 16384;
#pragma unroll
            for (int kk = 0; kk < 4; ++kk) { Ba[kk] = *(const bf16x8*)(Wa + (16 * w + fr) * 128 + 32 * kk + 8 * fq); Bx[kk] = *(const bf16x8*)(Wx + (16 * w + fr) * 128 + 32 * kk + 8 * fq); }
            const float* cw = p.in[8] + (size_t)layer * 4 * 512 + ch;
            cw0 = cw[0]; cw1 = cw[512]; cw2 = cw[1024]; cw3 = cw[1536]; cb = p.in[9][layer * 512 + ch];
            const int chl = layer * 512 + g * 128 + 16 * w + fr;
            ba = p.in[11][chl]; bx = p.in[13][chl]; { const float e = __expf(-p.in[14][chl]); sp = e < 0.02f ? e * (1.0f - e * (0.5f - e * 0.33333334f)) : __logf(1.0f + e); }
        }
        {
            float xw[19];
#pragma unroll
            for (int i = 0; i < 19; ++i) xw[i] = bf2f(nx[i]);
#pragma unroll
            for (int i = 0; i < 16; ++i) { const float xc = cb + cw0 * xw[i] + cw1 * xw[i + 1] + cw2 * xw[i + 2] + cw3 * xw[i + 3]; const int t = sg * 16 + i; xcf[t * 128 + c] = xc; xcb[t * 136 + c] = f2bf(xc); }
        }
        if (item + (int)gridDim.x < 1024) RGP_LOAD(item + (int)gridDim.x);
        lds_barrier();
        {
            const int col = 16 * w + fr;
#pragma unroll
            for (int tt = 0; tt < 4; ++tt) {
                f32x4 aa = {0.f, 0.f, 0.f, 0.f}, ax = {0.f, 0.f, 0.f, 0.f};
#pragma unroll
                for (int kk = 0; kk < 4; ++kk) { const bf16x8 a = *(const bf16x8*)(xcb + (16 * tt + fr) * 136 + 32 * kk + 8 * fq); aa = MFMA16(a, Ba[kk], aa); ax = MFMA16(a, Bx[kk], ax); }
#pragma unroll
                for (int j = 0; j < 4; ++j) {
                    const int t = 16 * tt + 4 * fq + j;
                    const float r = sigm(aa[j] + ba), ii = sigm(ax[j] + bx), la = -8.0f * r * sp, x2 = 2.0f * la;
                    const float av = __expf(la);
                    const float ser = -x2 * (1.0f + x2 * (0.5f + x2 * (0.16666667f + x2 * (0.041666668f + x2 * (0.0083333338f + x2 * 0.0013888889f)))));
                    const float om = x2 > -0.25f ? ser : 1.0f - __expf(x2);
                    const float u = __builtin_amdgcn_sqrtf(fmaxf(om, 0.f)) * (ii * xcf[t * 128 + col]);
                    aL[t * 128 + col] = av; uL[t * 128 + col] = u;
                }
            }
        }
        lds_barrier();
        {
            float hh = 0.f, AA = 1.f;
#pragma unroll
            for (int i = 0; i < 16; ++i) { const int t = sg * 16 + i; const float av = aL[t * 128 + c], u = uL[t * 128 + c]; hh = av * hh + u; AA *= av; uL[t * 128 + c] = hh; aL[t * 128 + c] = AA; }
            segA[sg * 128 + c] = AA; segH[sg * 128 + c] = hh;
        }
        lds_barrier();
        {
            float carry = 0.f, cA = 1.f;
            for (int s2 = 0; s2 < sg; ++s2) { const float a2 = segA[s2 * 128 + c]; carry = a2 * carry + segH[s2 * 128 + c]; cA *= a2; }
            float hl = 0.f, ca = 0.f;
#pragma unroll
            for (int i = 0; i < 16; ++i) {
                const int t = sg * 16 + i; const size_t tok = (size_t)b * SEQ + tau * 64 + t;
                const float al = aL[t * 128 + c]; hl = uL[t * 128 + c] + al * carry; ca = al * cA;
                HL[tok * 512 + ch] = hl; CA[tok * 512 + ch] = ca;
            }
            if (sg == 3) { ((float*)(p.ws + OFF_ATILE))[((size_t)b * 64 + tau) * 512 + ch] = ca; ((float*)(p.ws + OFF_HTILE))[((size_t)b * 64 + tau) * 512 + ch] = hl; }
        }
        lds_barrier();
    }
#undef RGP_LOAD
}

__device__ __forceinline__ void convc_item(const Params& p, int layer, int item, unsigned char* smem) {
    const int tid = opaque_tid(), c = tid, w = tid >> 6, lane = tid & 63;
    const int b = item >> 7, tau = item & 127;
    const bf16_t* P = (const bf16_t*)(p.ws + OFF_H);
    bf16_t* Y = (bf16_t*)(p.ws + OFF_XB);
    bf16_t* glu = (bf16_t*)smem;
    float* ubuf = (float*)(smem + 63488); float* stats = (float*)(smem + 63488 + 65536);
    {
        const bf16_t* Pv = P + (size_t)b * SEQ * DIN + 2560;
        u32x4 va[8], ga[8];
#pragma unroll
        for (int r = 0; r < 8; ++r) { const int slot = r * 512 + tid, row = slot >> 6, c8 = (slot & 63) * 8, pos = tau * 32 - 30 + row;
            if (row < 62 && pos >= 0) { const bf16_t* q = Pv + (size_t)pos * DIN + c8; va[r] = *(const u32x4*)q; ga[r] = *(const u32x4*)(q + 512); }
            else { va[r] = (u32x4){0u, 0u, 0u, 0u}; ga[r] = (u32x4){0u, 0u, 0u, 0u}; } }
#pragma unroll
        for (int r = 0; r < 8; ++r) { const int slot = r * 512 + tid, row = slot >> 6, c8 = (slot & 63) * 8;
            if (row < 62) {
                float o[8];
                const unsigned vw[4] = {va[r].x, va[r].y, va[r].z, va[r].w}, gw_[4] = {ga[r].x, ga[r].y, ga[r].z, ga[r].w};
#pragma unroll
                for (int e = 0; e < 4; ++e) { o[2 * e] = __uint_as_float(vw[e] << 16) * sigm(__uint_as_float(gw_[e] << 16)); o[2 * e + 1] = __uint_as_float(vw[e] & 0xffff0000u) * sigm(__uint_as_float(gw_[e] & 0xffff0000u)); }
                *(bf16x8*)(glu + row * 512 + c8) = pack8(o[0], o[1], o[2], o[3], o[4], o[5], o[6], o[7]); } }
    }
    float wk[31];
#pragma unroll
    for (int k = 0; k < 31; ++k) wk[k] = p.in[15][(size_t)layer * 31 * 512 + k * 512 + c];
    const float cb = p.in[16][layer * 512 + c];
    lds_barrier();
    float gw[38];
#pragma unroll
    for (int i = 0; i < 30; ++i) gw[i] = bf2f(glu[i * 512 + c]);
#pragma unroll 1
    for (int tg = 0; tg < 4; ++tg) {
#pragma unroll
        for (int i = 0; i < 8; ++i) gw[30 + i] = bf2f(glu[(30 + tg * 8 + i) * 512 + c]);
#pragma unroll
        for (int o = 0; o < 8; ++o) { float acc = cb;
#pragma unroll
            for (int k = 0; k < 31; ++k) acc += wk[k] * gw[o + k];
            ubuf[(tg * 8 + o) * 512 + c] = acc; }
#pragma unroll
        for (int i = 0; i < 30; ++i) gw[i] = gw[i + 8];
    }
    lds_barrier();
#pragma unroll 1
    for (int i = 0; i < 16; ++i) {
        const int pr = w * 16 + i, t = pr >> 2, grp = pr & 3;
        const float v0 = ubuf[t * 512 + grp * 128 + lane], v1 = ubuf[t * 512 + grp * 128 + 64 + lane];
        float s = v0 + v1;
#pragma unroll
        for (int o = 32; o > 0; o >>= 1) s += __shfl_xor(s, o);
        const float mu = s * (1.0f / 128.0f), d0 = v0 - mu, d1 = v1 - mu; float q = d0 * d0 + d1 * d1;
#pragma unroll
        for (int o = 32; o > 0; o >>= 1) q += __shfl_xor(q, o);
        if (lane == 0) { stats[(t * 4 + grp) * 2] = mu; stats[(t * 4 + grp) * 2 + 1] = rsqrtf(q * (1.0f / 128.0f) + LN_EPS); }
    }
    lds_barrier();
    {
        const float ng = p.in[17][layer * 512 + c], nb = p.in[18][layer * 512 + c]; const int grp = c >> 7;
#pragma unroll 8
        for (int t = 0; t < 32; ++t) {
            const float mu = stats[(t * 4 + grp) * 2], rs = stats[(t * 4 + grp) * 2 + 1];
            const float z = (ubuf[t * 512 + c] - mu) * rs * ng + nb;
            Y[((size_t)b * SEQ + tau * 32 + t) * DM + 1024 + c] = f2bf(z * sigm(z));
        }
    }
    lds_barrier();
}

__device__ __forceinline__ void rgpost_item(const Params& p, int item, unsigned char* smem) {
    const int tid = opaque_tid(), c4 = (tid & 127) * 4, sg = tid >> 7, b = item >> 6, tau = item & 63;
    const bf16_t* P = (const bf16_t*)(p.ws + OFF_H);
    bf16_t* Y = (bf16_t*)(p.ws + OFF_XB);
    const float* AT = (const float*)(p.ws + OFF_ATILE) + (size_t)b * 64 * 512 + c4; const float* HT = (const float*)(p.ws + OFF_HTILE) + (size_t)b * 64 * 512 + c4;
    const float* HL = (const float*)((unsigned char*)p.out + OUT_HLOC); const float* CA = (const float*)((unsigned char*)p.out + OUT_CUMA);
    f32x4 pa = {1.f, 1.f, 1.f, 1.f}, ph = {0.f, 0.f, 0.f, 0.f};
    {
        const int sbeg = sg * 16, send = tau < sbeg + 16 ? tau : sbeg + 16;
#pragma unroll 1
        for (int s0 = sbeg; s0 < send; s0 += 8) {
            f32x4 av[8], hv[8];
#pragma unroll
            for (int i = 0; i < 8; ++i) { const bool ok = s0 + i < send; av[i] = ok ? *(const f32x4*)(AT + (s0 + i) * 512) : (f32x4){1.f, 1.f, 1.f, 1.f}; hv[i] = ok ? *(const f32x4*)(HT + (s0 + i) * 512) : (f32x4){0.f, 0.f, 0.f, 0.f}; }
#pragma unroll
            for (int i = 0; i < 8; ++i) { ph = av[i] * ph + hv[i]; pa = pa * av[i]; }
        }
    }
    f32x4* cs = (f32x4*)smem;
    cs[(sg * 128 + (tid & 127)) * 2] = pa; cs[(sg * 128 + (tid & 127)) * 2 + 1] = ph;
    lds_barrier();
    f32x4 carry = {0.f, 0.f, 0.f, 0.f};
#pragma unroll
    for (int q = 0; q < 4; ++q) { const f32x4 a = cs[(q * 128 + (tid & 127)) * 2], hq = cs[(q * 128 + (tid & 127)) * 2 + 1]; carry = a * carry + hq; }
    lds_barrier();
    const size_t tok0 = (size_t)b * SEQ + tau * 64 + sg * 16;
#pragma unroll 1
    for (int t0 = 0; t0 < 16; t0 += 8) {
        f32x4 hl[8], ca[8]; u32x2 gt[8];
#pragma unroll
        for (int i = 0; i < 8; ++i) { const size_t tok = tok0 + t0 + i; hl[i] = *(const f32x4*)(HL + tok * 512 + c4); ca[i] = *(const f32x4*)(CA + tok * 512 + c4); gt[i] = *(const u32x2*)(P + tok * DIN + 1536 + c4); }
#pragma unroll
        for (int i = 0; i < 8; ++i) {
            const f32x4 hv = hl[i] + ca[i] * carry;
            float x[4] = {__uint_as_float(gt[i].x << 16), __uint_as_float(gt[i].x & 0xffff0000u), __uint_as_float(gt[i].y << 16), __uint_as_float(gt[i].y & 0xffff0000u)};
            float y[4];
#pragma unroll
            for (int e = 0; e < 4; ++e) { const float u = 0.7978845608f * (x[e] + 0.044715f * x[e] * x[e] * x[e]); const float th = 1.0f - 2.0f * __builtin_amdgcn_rcpf(__expf(2.0f * u) + 1.0f); y[e] = hv[e] * 0.5f * x[e] * (1.0f + th); }
            u32x2 w2; w2.x = cvt_pk_bf16(y[0], y[1]); w2.y = cvt_pk_bf16(y[2], y[3]);
            *(u32x2*)(Y + (tok0 + t0 + i) * DM + 512 + c4) = w2;
        }
    }
}

__device__ __forceinline__ void attn_item(const Params& p, int item, unsigned char* smem) {
    const int tid = opaque_tid(), w = tid >> 6, lane = tid & 63, fr = lane & 15, fq = lane >> 4;
    const int qt = 31 - (item >> 4), bh = item & 15, b = bh >> 2, h = bh & 3;
    const int blk = qt >> 1, o = (qt & 1) * 128, q0 = blk * 256 + o;
    const bf16_t* P = (const bf16_t*)(p.ws + OFF_H);
    const bf16_t* Vt = (const bf16_t*)((unsigned char*)p.out + OUT_VT) + (size_t)bh * 128 * SEQ;
    const float* kmean = (const float*)(p.ws + OFF_KMEAN) + (size_t)bh * 16 * 128;
    bf16_t* Y = (bf16_t*)(p.ws + OFF_XB);
    bf16_t* Ks = (bf16_t*)smem; bf16_t* Vs = (bf16_t*)(smem + 34816);
    float* kms = (float*)(smem + 71680); float* gts = (float*)(smem + 79872);
    unsigned* sels = (unsigned*)(smem + 88576); int* tiles = (int*)(smem + 89088); unsigned* um = (unsigned*)(smem + 89344);
    const bf16_t* Pb = P + (size_t)b * SEQ * DIN;

    bf16x8 Qf[4];
    { const bf16_t* qrow = Pb + (size_t)(q0 + 16 * w + fr) * DIN + h * 128;
#pragma unroll
      for (int kk = 0; kk < 4; ++kk) Qf[kk] = *(const bf16x8*)(qrow + 32 * kk + 8 * fq); }
    for (int i = tid; i < blk * 128; i += 512) kms[i] = kmean[i];
    if (tid == 0) um[0] = 0u;
    lds_barrier();
    {
        const int qi = tid & 127, jg = tid >> 7;
        float g4[4] = {0.f, 0.f, 0.f, 0.f};
        if (jg * 4 < blk) {
            const bf16_t* qr = Pb + (size_t)(q0 + qi) * DIN + h * 128;
#pragma unroll 2
            for (int cc = 0; cc < 16; ++cc) {
                const u32x4 raw = *(const u32x4*)(qr + 8 * cc);
                float qv[8];
                qv[0] = __uint_as_float(raw.x << 16); qv[1] = __uint_as_float(raw.x & 0xffff0000u); qv[2] = __uint_as_float(raw.y << 16); qv[3] = __uint_as_float(raw.y & 0xffff0000u);
                qv[4] = __uint_as_float(raw.z << 16); qv[5] = __uint_as_float(raw.z & 0xffff0000u); qv[6] = __uint_as_float(raw.w << 16); qv[7] = __uint_as_float(raw.w & 0xffff0000u);
#pragma unroll
                for (int jj = 0; jj < 4; ++jj) { const int j = jg * 4 + jj; if (j < blk) { const float* km = kms + j * 128 + 8 * cc;
#pragma unroll
                    for (int e = 0; e < 8; ++e) g4[jj] += qv[e] * km[e]; } }
            }
        }
#pragma unroll
        for (int jj = 0; jj < 4; ++jj) gts[qi * 17 + jg * 4 + jj] = g4[jj];
    }
    lds_barrier();
    if (tid < 128) {
        unsigned m = 0u; const int nsel = blk < 3 ? blk : 3;
        for (int s = 0; s < nsel; ++s) { float best = -3.0e38f; int bi = 0;
            for (int j = 0; j < blk; ++j) { const float v = gts[tid * 17 + j]; if (!((m >> j) & 1u) && v > best) { best = v; bi = j; } }
            m |= 1u << bi; }
        sels[tid] = m; if (m) atomicOr(um, m);
    }
    lds_barrier();
    if (tid == 0) { int n = 0; const unsigned u0 = um[0];
        for (int t = 0; t < o / 64 + 2; ++t) tiles[n++] = blk * 256 + t * 64;
        for (int j = 0; j < blk; ++j) if ((u0 >> j) & 1u) for (int t = 0; t < 4; ++t) tiles[n++] = j * 256 + t * 64;
        um[1] = (unsigned)n; }
    lds_barrier();
    const unsigned msel = sels[16 * w + fr]; const int ntiles = (int)um[1];
    const int qpos = q0 + 16 * w + fr;
    const float SC = 0.12751743f;

    f32x4 oacc[8];
#pragma unroll
    for (int dt = 0; dt < 8; ++dt) oacc[dt] = (f32x4){0.f, 0.f, 0.f, 0.f};
    float m_run = -1.0e30f, l_run = 0.f;
    struct KVStage { u32x4 k0, k1, v0, v1; };
    KVStage s0, s1, s2;
    const int lr = tid >> 3, lc = (tid & 7) * 16, vr = tid >> 2, vc = (tid & 3) * 16;
    const int lrp = (lr & 32) + ((lr >> 2) & 1) * 16 + ((lr >> 3) & 3) * 4 + (lr & 3);
#define ATT_GLOAD(st_, kpos_) do { const bf16_t* kp_ = Pb + (size_t)((kpos_) + lr) * DIN + 512 + h * 128 + lc; st_.k0 = *(const u32x4*)kp_; st_.k1 = *(const u32x4*)(kp_ + 8); \
        const bf16_t* vp_ = Vt + (size_t)vr * SEQ + (kpos_) + vc; st_.v0 = *(const u32x4*)vp_; st_.v1 = *(const u32x4*)(vp_ + 8); } while (0)
#define ATT_LSTORE(st_, buf_) do { bf16_t* kd_ = Ks + (buf_) * 8704 + lrp * 136 + lc; *(u32x4*)kd_ = st_.k0; *(u32x4*)(kd_ + 8) = st_.k1; \
        bf16_t* vd_ = Vs + (buf_) * 9216 + vr * 72 + vc; *(u32x4*)vd_ = st_.v0; *(u32x4*)(vd_ + 8) = st_.v1; } while (0)
    ATT_GLOAD(s0, tiles[0]); ATT_LSTORE(s0, 0);
    if (1 < ntiles) ATT_GLOAD(s1, tiles[1]);
    if (2 < ntiles) ATT_GLOAD(s2, tiles[2]);
    if (3 < ntiles) ATT_GLOAD(s0, tiles[3]);
    lds_barrier();
#define ATT_BODY(it_, stn_) do { \
        const int buf = (it_) & 1, kpos = tiles[(it_)]; \
        const bf16_t* Kb = Ks + buf * 8704; const bf16_t* Vb = Vs + buf * 9216; \
        const bool own = kpos >= blk * 256; const bool selok = (msel >> (kpos >> 8)) & 1u; \
        if (own ? (kpos <= q0 + 16 * w + 15) : __any(selok)) {        \
        f32x4 sacc[4]; \
        _Pragma("unroll") for (int T = 0; T < 4; ++T) { \
            const int krow = 32 * (T >> 1) + 16 * (T & 1) + fr; \
            sacc[T] = (f32x4){0.f, 0.f, 0.f, 0.f}; \
            _Pragma("unroll") for (int kk = 0; kk < 4; ++kk) { const bf16x8 a = *(const bf16x8*)(Kb + krow * 136 + 32 * kk + 8 * fq); sacc[T] = MFMA16(a, Qf[kk], sacc[T]); } \
        } \
        float mx = m_run; \
        _Pragma("unroll") for (int T = 0; T < 4; ++T) \
            _Pragma("unroll") for (int j = 0; j < 4; ++j) { const int key = kpos + 32 * (T >> 1) + 8 * fq + 4 * (T & 1) + j; const bool ok = own ? (key <= qpos) : selok; \
                const float sv = ok ? sacc[T][j] * SC : -1.0e30f; sacc[T][j] = sv; mx = fmaxf(mx, sv); } \
        mx = fmaxf(mx, __shfl_xor(mx, 16)); mx = fmaxf(mx, __shfl_xor(mx, 32)); \
        const float al = __builtin_amdgcn_exp2f(m_run - mx); m_run = mx; \
        float ps = 0.f; \
        _Pragma("unroll") for (int T = 0; T < 4; ++T) \
            _Pragma("unroll") for (int j = 0; j < 4; ++j) { const float pv = __builtin_amdgcn_exp2f(sacc[T][j] - mx); sacc[T][j] = pv; ps += pv; } \
        l_run = l_run * al + ps; \
        _Pragma("unroll") for (int dt = 0; dt < 8; ++dt) oacc[dt] *= al; \
        _Pragma("unroll") for (int G = 0; G < 2; ++G) { \
            const bf16x8 pb = pack8(sacc[2 * G][0], sacc[2 * G][1], sacc[2 * G][2], sacc[2 * G][3], sacc[2 * G + 1][0], sacc[2 * G + 1][1], sacc[2 * G + 1][2], sacc[2 * G + 1][3]); \
            _Pragma("unroll") for (int dt = 0; dt < 8; ++dt) { const bf16x8 a = *(const bf16x8*)(Vb + (16 * dt + fr) * 72 + 32 * G + 8 * fq); oacc[dt] = MFMA16(a, pb, oacc[dt]); } \
        } \
        } \
        if ((it_) + 1 < ntiles) ATT_LSTORE(stn_, buf ^ 1); \
        if ((it_) + 4 < ntiles) ATT_GLOAD(stn_, tiles[(it_) + 4]); \
        lds_barrier(); \
    } while (0)
#pragma unroll 1
    for (int it = 0; it < ntiles; it += 3) {
        ATT_BODY(it, s1);
        if (it + 1 >= ntiles) break;
        ATT_BODY(it + 1, s2);
        if (it + 2 >= ntiles) break;
        ATT_BODY(it + 2, s0);
    }
#undef ATT_BODY
#undef ATT_GLOAD
#undef ATT_LSTORE
    float l = l_run + __shfl_xor(l_run, 16); l += __shfl_xor(l, 32);
    const float inv = 1.0f / l;
    bf16_t* yrow = Y + ((size_t)b * SEQ + qpos) * DM + h * 128 + 4 * fq;
#pragma unroll
    for (int dt = 0; dt < 8; ++dt) { u32x2 w2; w2.x = cvt_pk_bf16(oacc[dt][0] * inv, oacc[dt][1] * inv); w2.y = cvt_pk_bf16(oacc[dt][2] * inv, oacc[dt][3] * inv); *(u32x2*)(yrow + 16 * dt) = w2; }
}

__device__ __forceinline__ void hgpre_range(const Params& p, int layer, unsigned char* smem) {
    const int tid = opaque_tid(), c = tid & 127, sg = tid >> 7, w = tid >> 6, lane = tid & 63, fr = lane & 15, fq = lane >> 4;
    const bf16_t* P = (const bf16_t*)(p.ws + OFF_H);
    bf16_t* qs = (bf16_t*)smem; bf16_t* ks = (bf16_t*)(smem + 8704); bf16_t* vT = (bf16_t*)(smem + 17408);
    bf16_t* att = (bf16_t*)(smem + 27648); float* seg = (float*)(smem + 30208);
    bf16_t* raw = (bf16_t*)(smem + 32768);
    const int lrow = tid >> 4, lcol = (tid & 15) * 8;
    u32x4 pq, pf, pv, pg;
#define HGP_LOAD(item_) do { const int bh_ = (item_) >> 7, chn_ = (item_) & 127; const bf16_t* Pq_ = P + ((size_t)(bh_ >> 2) * SEQ + chn_ * 32 + lrow) * DIN + 3584 + (bh_ & 3) * 128 + lcol; \
        pq = *(const u32x4*)Pq_; pf = *(const u32x4*)(Pq_ + 512); pv = *(const u32x4*)(Pq_ + 1024); pg = *(const u32x4*)(Pq_ + 1536); } while (0)
    int item = blockIdx.x;
    if (item < 2048) HGP_LOAD(item);
#pragma unroll 1
    for (; item < 2048; item += gridDim.x) {
        const int bh = item >> 7, chn = item & 127, h = bh & 3;
        const size_t cidx = (size_t)bh * 128 + chn;
        bf16_t* gQS = (bf16_t*)(p.ws + OFF_HQS) + cidx * 4096; bf16_t* gKDT = (bf16_t*)(p.ws + OFF_HKDT) + cidx * 4096; bf16_t* gVT = (bf16_t*)(p.ws + OFF_HVT) + cidx * 4096;
        float* gEL = (float*)(p.ws + OFF_HEL) + cidx * 128;
        f32x4* gOI = (f32x4*)((unsigned char*)p.out + OUT_OI) + cidx * 1024; f32x4* gGS = (f32x4*)(p.ws + OFF_HGS) + cidx * 1024;
        float lb = 0.f;
        if (layer == 1) lb = sigm(p.in[19][512 + h * 128 + c] - p.in[19][h * 128 + c]);
        const float omlb = 1.0f - lb;
        const float ngv = p.in[20][layer * 512 + h * 128 + 16 * w + fr];
        *(u32x4*)(raw + lrow * 128 + lcol) = pq; *(u32x4*)(raw + 4096 + lrow * 128 + lcol) = pf; *(u32x4*)(raw + 8192 + lrow * 128 + lcol) = pv; *(u32x4*)(raw + 12288 + lrow * 128 + lcol) = pg;
        if (item + (int)gridDim.x < 2048) HGP_LOAD(item + (int)gridDim.x);
        lds_barrier();
        unsigned short nq[8], nf[8], nv[8], ng[8];
#pragma unroll
        for (int i = 0; i < 8; ++i) { const int o_ = (8 * sg + i) * 128 + c; nq[i] = raw[o_]; nf[i] = raw[4096 + o_]; nv[i] = raw[8192 + o_]; }
#pragma unroll
        for (int i = 0; i < 8; ++i) ng[i] = raw[12288 + (16 * (i >> 2) + 4 * fq + (i & 3)) * 128 + 16 * w + fr];
        float qv[8], kv[8], bl[8], gsv[8]; float run = 0.f;
#pragma unroll
        for (int i = 0; i < 8; ++i) { const float sg_ = sigm(bf2f(nf[i])); const float f = lb + omlb * sg_; run += __logf(f); bl[i] = run; kv[i] = omlb * (1.0f - sg_); qv[i] = bf2f(nq[i]); }
#pragma unroll
        for (int i = 0; i < 8; ++i) { const float gg = bf2f(ng[i]); gsv[i] = gg * sigm(gg) * ngv; }
        seg[sg * 128 + c] = run;
        { u32x4 wv; wv.x = nv[0] | ((unsigned)nv[1] << 16); wv.y = nv[2] | ((unsigned)nv[3] << 16); wv.z = nv[4] | ((unsigned)nv[5] << 16); wv.w = nv[6] | ((unsigned)nv[7] << 16);
          *(u32x4*)(vT + c * 40 + sg * 8) = wv; *(u32x4*)(gVT + c * 32 + sg * 8) = wv; }
        lds_barrier();
        {
            const float s0 = seg[c], s1 = seg[128 + c], s2 = seg[256 + c], s3 = seg[384 + c];
            const float off = (sg > 0 ? s0 : 0.f) + (sg > 1 ? s1 : 0.f) + (sg > 2 ? s2 : 0.f), btot = (s0 + s1) + (s2 + s3);
            float kd[8];
#pragma unroll
            for (int i = 0; i < 8; ++i) { const float bt = off + bl[i]; const unsigned short qb = f2bf(qv[i] * __expf(bt));
                qs[(8 * sg + i) * 136 + c] = qb; gQS[(8 * sg + i) * 128 + c] = qb; ks[(8 * sg + i) * 136 + c] = f2bf(kv[i] * __expf(fminf(-bt, 80.0f)));        kd[i] = kv[i] * __expf(btot - bt); }
            *(bf16x8*)(gKDT + c * 32 + sg * 8) = pack8(kd[0], kd[1], kd[2], kd[3], kd[4], kd[5], kd[6], kd[7]);
            if (sg == 0) gEL[c] = __expf(btot);
        }
        lds_barrier();
        if (w < 3) {
            const int tt = (w + 1) >> 1, st = (w == 2) ? 1 : 0;
            f32x4 aa = {0.f, 0.f, 0.f, 0.f};
#pragma unroll
            for (int kk = 0; kk < 4; ++kk) { const bf16x8 a = *(const bf16x8*)(qs + (16 * tt + fr) * 136 + 32 * kk + 8 * fq); const bf16x8 bb = *(const bf16x8*)(ks + (16 * st + fr) * 136 + 32 * kk + 8 * fq); aa = MFMA16(a, bb, aa); }
#pragma unroll
            for (int j = 0; j < 4; ++j) { const int t = 16 * tt + 4 * fq + j, s = 16 * st + fr; att[t * 40 + s] = f2bf(s <= t ? aa[j] : 0.f); }
        } else if (w == 3) {
#pragma unroll
            for (int j = 0; j < 4; ++j) att[(4 * fq + j) * 40 + 16 + fr] = 0;
        }
        lds_barrier();
        {
            const bf16x8 bv = *(const bf16x8*)(vT + (16 * w + fr) * 40 + 8 * fq);
#pragma unroll
            for (int tt = 0; tt < 2; ++tt) {
                const bf16x8 a = *(const bf16x8*)(att + (16 * tt + fr) * 40 + 8 * fq);
                const f32x4 oi = MFMA16(a, bv, ((f32x4){0.f, 0.f, 0.f, 0.f}));
                gOI[(w * 2 + tt) * 64 + lane] = oi;
                gGS[(w * 2 + tt) * 64 + lane] = (f32x4){gsv[4 * tt], gsv[4 * tt + 1], gsv[4 * tt + 2], gsv[4 * tt + 3]};
            }
        }
        lds_barrier();
    }
#undef HGP_LOAD
}

__device__ __forceinline__ void hgrn_item(const Params& p, int layer, int bh, unsigned char* smem, int rep) {
    const int tid = opaque_tid(), w = tid >> 6, lane = tid & 63, fr = lane & 15, fq = lane >> 4;
    (void)layer;
    const bf16_t* gQS = (const bf16_t*)(p.ws + OFF_HQS) + (size_t)bh * 128 * 4096 + tid * 8;
    const bf16_t* gKDT = (const bf16_t*)(p.ws + OFF_HKDT) + (size_t)bh * 128 * 4096 + tid * 8;
    const bf16_t* gVT = (const bf16_t*)(p.ws + OFF_HVT) + (size_t)bh * 128 * 4096 + tid * 8;
    const float* gEL = (const float*)(p.ws + OFF_HEL) + (size_t)bh * 128 * 128 + (tid & 31) * 4;
    f32x4* gOI = (f32x4*)((unsigned char*)p.out + OUT_OI) + (size_t)bh * 128 * 1024 + w * 128 + lane;
    f32x4* gOW = rep ? (f32x4*)(p.ws + OFF_GU) + (size_t)bh * 128 * 1024 + w * 128 + lane : gOI;
    const int oq = (tid >> 4) * 136 + (tid & 15) * 8, ok = (tid >> 2) * 40 + (tid & 3) * 8;
    f32x4 S[8];
#pragma unroll
    for (int kt = 0; kt < 8; ++kt) S[kt] = (f32x4){0.f, 0.f, 0.f, 0.f};
    struct Stage { u32x4 q, k, v; f32x4 e, o0, o1; };
    Stage sa, sb;
#define HG_GLOAD(st_, ch_) do { const size_t co_ = (size_t)(ch_) * 4096; st_.q = *(const u32x4*)(gQS + co_); st_.k = *(const u32x4*)(gKDT + co_); st_.v = *(const u32x4*)(gVT + co_); \
        st_.e = *(const f32x4*)(gEL + (size_t)(ch_) * 128); st_.o0 = gOI[(size_t)(ch_) * 1024]; st_.o1 = gOI[(size_t)(ch_) * 1024 + 64]; } while (0)
#define HG_LSTORE(st_, buf_) do { unsigned char* lb_ = smem + (buf_) * 29696; *(u32x4*)((bf16_t*)lb_ + oq) = st_.q; *(u32x4*)((bf16_t*)(lb_ + 8704) + ok) = st_.k; *(u32x4*)((bf16_t*)(lb_ + 18944) + ok) = st_.v; \
        if (tid < 32) *(f32x4*)((float*)(lb_ + 29184) + tid * 4) = st_.e; } while (0)
    f32x4 oc0, oc1;
    HG_GLOAD(sa, 0); HG_LSTORE(sa, 0); oc0 = sa.o0; oc1 = sa.o1;
    HG_GLOAD(sa, 1); HG_GLOAD(sb, 2);
    __syncthreads();
#define HG_BODY(chn_, stn_) do { \
        const int buf_ = (chn_) & 1; const unsigned char* lb_ = smem + buf_ * 29696; \
        const bf16_t* qs_ = (const bf16_t*)lb_; const bf16_t* kdT_ = (const bf16_t*)(lb_ + 8704); const bf16_t* vT_ = (const bf16_t*)(lb_ + 18944); const float* eL_ = (const float*)(lb_ + 29184); \
        f32x4 oacc0 = oc0, oacc1 = oc1; \
        u32x4 qa0[4], qa1[4]; bf16x8 ka[4], kb[4]; f32x4 e4[4], e5[4]; \
        _Pragma("unroll") for (int kp = 0; kp < 4; ++kp) { \
            const u32x2 lo0 = *(const u32x2*)(qs_ + fr * 136 + 32 * kp + 4 * fq), hi0 = *(const u32x2*)(qs_ + fr * 136 + 32 * kp + 16 + 4 * fq); qa0[kp].x = lo0.x; qa0[kp].y = lo0.y; qa0[kp].z = hi0.x; qa0[kp].w = hi0.y; \
            const u32x2 lo1 = *(const u32x2*)(qs_ + (16 + fr) * 136 + 32 * kp + 4 * fq), hi1 = *(const u32x2*)(qs_ + (16 + fr) * 136 + 32 * kp + 16 + 4 * fq); qa1[kp].x = lo1.x; qa1[kp].y = lo1.y; qa1[kp].z = hi1.x; qa1[kp].w = hi1.y; } \
        const bf16x8 bv = *(const bf16x8*)(vT_ + (16 * w + fr) * 40 + 8 * fq); \
        _Pragma("unroll") for (int kt = 0; kt < 4; ++kt) { ka[kt] = *(const bf16x8*)(kdT_ + (16 * kt + fr) * 40 + 8 * fq); e4[kt] = *(const f32x4*)(eL_ + 16 * kt + 4 * fq); } \
        _Pragma("unroll") for (int kp = 0; kp < 4; ++kp) { \
            const bf16x8 bS = pack8(S[2 * kp][0], S[2 * kp][1], S[2 * kp][2], S[2 * kp][3], S[2 * kp + 1][0], S[2 * kp + 1][1], S[2 * kp + 1][2], S[2 * kp + 1][3]); \
            oacc0 = MFMA16(__builtin_bit_cast(bf16x8, qa0[kp]), bS, oacc0); oacc1 = MFMA16(__builtin_bit_cast(bf16x8, qa1[kp]), bS, oacc1); } \
        __builtin_amdgcn_sched_barrier(0); \
        _Pragma("unroll") for (int kt = 0; kt < 4; ++kt) { kb[kt] = *(const bf16x8*)(kdT_ + (16 * (kt + 4) + fr) * 40 + 8 * fq); e5[kt] = *(const f32x4*)(eL_ + 16 * (kt + 4) + 4 * fq); } \
        _Pragma("unroll") for (int kt = 0; kt < 4; ++kt) { S[kt] = S[kt] * e4[kt]; S[kt] = MFMA16(ka[kt], bv, S[kt]); } \
        _Pragma("unroll") for (int kt = 0; kt < 4; ++kt) { S[kt + 4] = S[kt + 4] * e5[kt]; S[kt + 4] = MFMA16(kb[kt], bv, S[kt + 4]); } \
        gOW[(size_t)(chn_) * 1024] = oacc0; gOW[(size_t)(chn_) * 1024 + 64] = oacc1; \
        if ((chn_) + 1 < 128) { HG_LSTORE(stn_, buf_ ^ 1); oc0 = stn_.o0; oc1 = stn_.o1; } \
        if ((chn_) + 3 < 128) HG_GLOAD(stn_, (chn_) + 3); \
        asm volatile("s_waitcnt lgkmcnt(0)" ::: "memory"); __builtin_amdgcn_s_barrier(); asm volatile("" ::: "memory"); \
    } while (0)
#pragma unroll 1
    for (int chn = 0; chn < 128; chn += 2) {
        HG_BODY(chn, sa);
        HG_BODY(chn + 1, sb);
    }
#undef HG_BODY
#undef HG_GLOAD
#undef HG_LSTORE
    __syncthreads();
}

__device__ __forceinline__ void hgpost_range(const Params& p, unsigned char* smem) {
    const int tid = opaque_tid(), w = tid >> 6, lane = tid & 63, fr = lane & 15, fq = lane >> 4;
    float* red = (float*)smem;
    bf16_t* Yb = (bf16_t*)(p.ws + OFF_XB);
    int item = blockIdx.x;
    f32x4 o0, o1, g0, g1;
#define HPO_LOAD(item_) do { const f32x4* a_ = (const f32x4*)((unsigned char*)p.out + OUT_OI) + (size_t)(item_) * 1024 + w * 128 + lane; const f32x4* b_ = (const f32x4*)(p.ws + OFF_HGS) + (size_t)(item_) * 1024 + w * 128 + lane; \
        o0 = a_[0]; o1 = a_[64]; g0 = b_[0]; g1 = b_[64]; } while (0)
    if (item < 2048) HPO_LOAD(item);
    int par = 0;
#pragma unroll 1
    for (; item < 2048; item += gridDim.x, par ^= 1) {
        const int bh = item >> 7, chn = item & 127;
        const f32x4 c0 = o0, c1 = o1, h0 = g0, h1 = g1;
        if (item + (int)gridDim.x < 2048) HPO_LOAD(item + (int)gridDim.x);
#pragma unroll
        for (int j = 0; j < 4; ++j) { const float s0 = row16_sum_to15(c0[j] * c0[j]), s1 = row16_sum_to15(c1[j] * c1[j]);
            if (fr == 15) { red[par * 256 + (4 * fq + j) * 8 + w] = s0; red[par * 256 + (16 + 4 * fq + j) * 8 + w] = s1; } }
        lds_barrier();
        bf16_t* Y = Yb + ((size_t)(bh >> 2) * SEQ + chn * 32) * DM + 1536 + (bh & 3) * 128 + 16 * w + fr;
#pragma unroll
        for (int j = 0; j < 4; ++j) {
            { const int t = 4 * fq + j; const f32x4 r0 = *(const f32x4*)(red + par * 256 + t * 8), r1 = *(const f32x4*)(red + par * 256 + t * 8 + 4);
              const float ss = ((r0[0] + r0[1]) + (r0[2] + r0[3])) + ((r1[0] + r1[1]) + (r1[2] + r1[3])); const float rs = rsqrtf(ss * (1.0f / 128.0f) + LN_EPS);
              Y[(size_t)t * DM] = f2bf(c0[j] * rs * h0[j]); }
            { const int t = 16 + 4 * fq + j; const f32x4 r0 = *(const f32x4*)(red + par * 256 + t * 8), r1 = *(const f32x4*)(red + par * 256 + t * 8 + 4);
              const float ss = ((r0[0] + r0[1]) + (r0[2] + r0[3])) + ((r1[0] + r1[1]) + (r1[2] + r1[3])); const float rs = rsqrtf(ss * (1.0f / 128.0f) + LN_EPS);
              Y[(size_t)t * DM] = f2bf(c1[j] * rs * h1[j]); }
        }
    }
#undef HPO_LOAD
    lds_barrier();
}

#define PH_NOINLINE __forceinline__
__device__ PH_NOINLINE void gemm_gu(const bf16_t* A, const bf16_t* Bt, bf16_t* H) {
    extern __shared__ __attribute__((aligned(16))) unsigned char smem[];
    pg8::Gemm g{A, Bt, NTOK, 11264, 2048}; pg8::StaticOrder S; S.init(NTOK, 11264, (int)gridDim.x, (int)blockIdx.x); EpiSwiGLU E{H};
    pg8::gemm_phase((PG8_LAS unsigned char*)smem, g, S, E);
}
__device__ PH_NOINLINE void gemm_res(const bf16_t* A, const bf16_t* Bt, int K, unsigned char* ws, const float* Rraw, float* Oalt, float s) {
    extern __shared__ __attribute__((aligned(16))) unsigned char smem[];
    pg8::Gemm g{A, Bt, NTOK, 2048, K}; pg8::StaticOrder S; S.init(NTOK, 2048, (int)gridDim.x, (int)blockIdx.x); EpiResid E{ws, Rraw, Oalt, s};
    pg8::gemm_phase((PG8_LAS unsigned char*)smem, g, S, E);
}
__device__ PH_NOINLINE void gemm_in(const bf16_t* A, const bf16_t* Bt, bf16_t* O) {
    extern __shared__ __attribute__((aligned(16))) unsigned char smem[];
    pg8::Gemm g{A, Bt, NTOK, 5632, 2048}; pg8::StaticOrder S; S.init(NTOK, 5632, (int)gridDim.x, (int)blockIdx.x); EpiBf16P E{O, DIN};
    pg8::gemm_phase((PG8_LAS unsigned char*)smem, g, S, E);
}
__device__ __forceinline__ void run_phase(const Params& p, int ph, unsigned char* smem, int rep) {
    if (ph == 0) { phase_convert(p, smem); return; }
    const int l = (ph - 1) / 12, k = (ph - 1) % 12;
    bf16_t* XB = (bf16_t*)(p.ws + OFF_XB); bf16_t* H = (bf16_t*)(p.ws + OFF_H); float* X = (float*)(p.ws + OFF_X); float* STATS = (float*)(p.ws + OFF_STATS);
    if (k == 0 || k == 9) {
        const int f = (k == 9);
        gemm_gu(XB, (const bf16_t*)(p.ws + OFF_GU + (size_t)(l * 2 + f) * SZ_GU), H);
    } else if (k == 1 || k == 10) {
        const int f = (k == 10);
        gemm_res(H, (const bf16_t*)(p.ws + OFF_DN + (size_t)(l * 2 + f) * SZ_DN), 5632, p.ws, (l == 0 && f == 0) ? p.in[0] : nullptr, rep ? p.out : nullptr, 0.5f);
    } else if (k == 2 || k == 8 || k == 11) {
        const int i = (k == 2) ? 0 : (k == 8 ? 1 : 2);
        const bool last = (l == 1 && i == 2);
        if (rep) { phase_ln((const bf16_t*)X, nullptr, H, (float*)(p.ws + OFF_HGS), nullptr, p.in[1] + (size_t)(l * 3 + i) * DM, p.in[2] + (size_t)(l * 3 + i) * DM); return; }
        phase_ln((const bf16_t*)X, last ? p.out : nullptr, last ? nullptr : XB, last ? nullptr : STATS, last ? nullptr : (float*)(p.ws + OFF_GB), p.in[1] + (size_t)(l * 3 + i) * DM, p.in[2] + (size_t)(l * 3 + i) * DM);
    } else if (k == 3) {
        gemm_in(XB, (const bf16_t*)(p.ws + OFF_IN + (size_t)l * SZ_IN), H);
    } else if (k == 4) {
#ifndef PROBE_SUB4
#define PROBE_SUB4 0
#endif
        if (rep == 0 || PROBE_SUB4 == 0 || PROBE_SUB4 == 1) hgpre_range(p, l, smem);
        if (rep == 0 || PROBE_SUB4 == 0 || PROBE_SUB4 == 4) rgpre_range(p, l, smem);
        for (int it = blockIdx.x; it < 768; it += gridDim.x) {
            if (it < 256) { if (rep == 0 || PROBE_SUB4 == 0 || PROBE_SUB4 == 2) kvpre_item(p, it, smem); }
            else { if (rep == 0 || PROBE_SUB4 == 0 || PROBE_SUB4 == 3) convc_item(p, l, it - 256, smem); }
        }
    } else if (k == 5) {
        unsigned* ctr = (unsigned*)(p.ws + OFF_CTL) + l * 64 + rep * 128;
        int* s_item = (int*)(smem + LDS_BYTES - 16);
        for (;;) {
            __syncthreads();
            if (threadIdx.x == 0) *s_item = (int)atomicAdd(ctr, 1u);
            __syncthreads();
            const int it = *s_item;
            if (it >= 784) break;
#ifdef PROBE_SUB
            if (rep == 1 && !((PROBE_SUB == 1 && it < 16) || (PROBE_SUB == 2 && it >= 16 && it < 528) || (PROBE_SUB == 3 && it >= 528) || (PROBE_SUB == 4 && it >= 16))) continue;
#endif
            if (it < 16) hgrn_item(p, l, it, smem, rep);
            else if (it < 528) attn_item(p, it - 16, smem);
            else rgpost_item(p, it - 528, smem);
        }
    } else if (k == 6) {
        hgpost_range(p, smem);
    } else if (k == 7) {
        gemm_res(XB, (const bf16_t*)(p.ws + OFF_OUT + (size_t)l * SZ_OUT), 2048, p.ws, nullptr, nullptr, 1.0f);
    }
}

#ifndef MK_N_LAUNCHES
#define MK_N_LAUNCHES 1
#endif

#define XB_TMO      128
#define XB_XCNT(j)  (256  + 64 * (j))
#define XB_XSUB(j)  (1280 + 64 * (j))
#define XB_XGEN(j)  (2304 + 64 * (j))
#define XB_TOP      3328
#define XB_TOPGEN   3392
#define XCD_BAR_WORDS 3456
#define XB_SPIN_CAP (1u << 18)
#define LAS __attribute__((address_space(3)))

__device__ __forceinline__ unsigned xb_ld(unsigned* p)              { return __hip_atomic_load(p, __ATOMIC_RELAXED, __HIP_MEMORY_SCOPE_AGENT); }
__device__ __forceinline__ unsigned xb_add(unsigned* p, unsigned v) { return __hip_atomic_fetch_add(p, v, __ATOMIC_RELAXED, __HIP_MEMORY_SCOPE_AGENT); }
__device__ __forceinline__ unsigned xb_xcc_id() { return (unsigned)__builtin_amdgcn_s_getreg((3 << 11) | 20) & 0xFu; }
#define XB_SPIN(cond, bar) do { unsigned _sp = 0; while (cond) { __builtin_amdgcn_s_sleep(1); \
    if ((++_sp & 255u) == 0u) { if (xb_ld(&(bar)[XB_TMO])) break; if (_sp > XB_SPIN_CAP) { atomicAdd(&(bar)[XB_TMO], 1u); break; } } } } while (0)

struct XcdBarrier {
    unsigned* bar; unsigned x;
    volatile LAS unsigned* st;
};

__device__ __forceinline__ XcdBarrier xcd_barrier_post(unsigned* bar, volatile LAS unsigned* st) {
    XcdBarrier b; b.bar = bar; b.x = xb_xcc_id(); b.st = st;
    if (threadIdx.x == 0) (void)xb_add(&bar[XB_XCNT(b.x)], 1u);
    return b;
}
__device__ __forceinline__ void xcd_barrier_complete(unsigned* bar, unsigned x, unsigned& nloc, unsigned& nx) {
    const unsigned G = gridDim.x * gridDim.y * gridDim.z;
    unsigned sum, cnt, mine, sp = 0u;
    for (;;) {
        sum = 0u; cnt = 0u; mine = 0u;
#pragma unroll
        for (unsigned j = 0; j < 16; ++j) { const unsigned c = xb_ld(&bar[XB_XCNT(j)]); sum += c; cnt += (c > 0u) ? 1u : 0u; mine = (j == x) ? c : mine; }
        if (sum == G) break;
        __builtin_amdgcn_s_sleep(1);
        if ((++sp & 255u) == 0u) { if (xb_ld(&bar[XB_TMO])) break; if (sp > XB_SPIN_CAP) { atomicAdd(&bar[XB_TMO], 1u); break; } }
    }
    nloc = mine > 0u ? mine : 1u; nx = cnt > 0u ? cnt : 1u;
}

__device__ __forceinline__ void xcd_barrier(const XcdBarrier& b) {
    asm volatile("s_waitcnt vmcnt(0)" ::: "memory");
    __syncthreads();
    if (threadIdx.x == 0) {
        unsigned* bar = b.bar;
        __builtin_amdgcn_s_waitcnt(0);
        unsigned nloc = b.st[0], nx = b.st[1];
        if (nloc == 0u) { xcd_barrier_complete(bar, b.x, nloc, nx); b.st[0] = nloc; b.st[1] = nx; }
        const unsigned old = xb_add(&bar[XB_XSUB(b.x)], 1u);
        const unsigned gen = old / nloc;
        if (old + 1u == (gen + 1u) * nloc) {
            __builtin_amdgcn_fence(__ATOMIC_RELEASE, "agent");
            asm volatile("s_waitcnt vmcnt(0)" ::: "memory");
            const unsigned og = xb_add(&bar[XB_TOP], 1u);
            const unsigned tg = og / nx;
            if (og + 1u == (tg + 1u) * nx) xb_add(&bar[XB_TOPGEN], 1u);
            else XB_SPIN(xb_ld(&bar[XB_TOPGEN]) == tg, bar);
            __builtin_amdgcn_fence(__ATOMIC_ACQUIRE, "agent");
            xb_add(&bar[XB_XGEN(b.x)], 1u);
            asm volatile("s_waitcnt vmcnt(0)" ::: "memory");
        } else {
            XB_SPIN(xb_ld(&bar[XB_XGEN(b.x)]) == gen, bar);
            __builtin_amdgcn_fence(__ATOMIC_ACQUIRE, "agent");
            asm volatile("s_waitcnt vmcnt(0)" ::: "memory");
        }
    }
    __syncthreads();
}

#ifndef PROBE_DUP
#define PROBE_DUP -1
#endif

__global__ void __launch_bounds__(512, 2) mega_fwd(Params p) {
    extern __shared__ __attribute__((aligned(16))) unsigned char smem[];
    volatile LAS unsigned* st = (volatile LAS unsigned*)(LAS unsigned char*)(smem + LDS_BYTES - 32);
    if (threadIdx.x == 0) { st[0] = 0u; st[1] = 0u; }
    __syncthreads();
    const XcdBarrier xb = xcd_barrier_post((unsigned*)(p.ws + OFF_CTL) + 1024, st);
    for (int ph = p.ph_lo; ph < p.ph_hi; ++ph) {
        if (ph > p.ph_lo) {
            if (p.ph_lo < 0) cg::this_grid().sync();
            xcd_barrier(xb);
        }
        run_phase(p, ph, smem, 0);
        if (PROBE_DUP >= 0 && (ph == 0 ? PROBE_DUP == 100 : (((ph - 1) % 12) == PROBE_DUP && (PROBE_DUP != 5 || ph > 12)))) {
            xcd_barrier(xb);
            run_phase(p, ph, smem, 1);
        }
    }
}

extern "C" void kernel_launch(void* const* d_in, const int* in_sizes, int n_in, void* d_out, int out_size, void* d_ws, size_t ws_size, hipStream_t stream) {
    static int grid = 0;
    if (grid == 0) {
        if (n_in != 21 || ws_size < WS_END) { fprintf(stderr, "kernel_launch: unexpected n_in %d / ws_size %zu (need %zu)\n", n_in, ws_size, (size_t)WS_END); grid = -1; return; }
        int dev = 0, cus = 0, per_cu = 0;
        (void)hipGetDevice(&dev);
        (void)hipDeviceGetAttribute(&cus, hipDeviceAttributeMultiprocessorCount, dev);
        if (hipFuncSetAttribute((const void*)mega_fwd, hipFuncAttributeMaxDynamicSharedMemorySize, LDS_BYTES) != hipSuccess) { fprintf(stderr, "kernel_launch: hipFuncSetAttribute failed\n"); grid = -1; return; }
        if (hipOccupancyMaxActiveBlocksPerMultiprocessor(&per_cu, (const void*)mega_fwd, 512, LDS_BYTES) != hipSuccess || per_cu < 1) { fprintf(stderr, "kernel_launch: occupancy query says %d\n", per_cu); per_cu = 1; }
        (void)hipGetLastError();
        grid = cus * per_cu;
        fprintf(stderr, "kernel_launch: grid %d (cus %d x %d)\n", grid, cus, per_cu);
    }
    if (grid < 0) return;
    (void)in_sizes; (void)out_size;
    (void)hipMemsetAsync((char*)d_ws + OFF_CTL, 0, CTL_BYTES, stream);
    Params p{};
    for (int i = 0; i < 21; ++i) p.in[i] = (const float*)d_in[i];
    p.out = (float*)d_out; p.ws = (unsigned char*)d_ws;
#if MK_N_LAUNCHES == 1
    p.ph_lo = 0; p.ph_hi = NPHASE;
    void* args[] = {&p};
    hipError_t e = hipLaunchCooperativeKernel((const void*)mega_fwd, dim3(grid), dim3(512), args, LDS_BYTES, stream);
    if (e != hipSuccess) fprintf(stderr, "kernel_launch: cooperative launch failed: %s (grid %d)\n", hipGetErrorString(e), grid);
#else
    for (int ph = 0; ph < NPHASE; ++ph) {
        p.ph_lo = ph; p.ph_hi = ph + 1;
        hipLaunchKernelGGL(mega_fwd, dim3(grid), dim3(512), LDS_BYTES, stream, p);
    }
#endif
}
```

```cpp
#include <hip/hip_runtime.h>
#include <hip/hip_cooperative_groups.h>
#include <cstdio>
#include <cstdint>
namespace cg = cooperative_groups;
namespace pg8 {
#define PG8_LAS __attribute__((address_space(3)))
typedef unsigned short bf16_t;
typedef short bf16x8 __attribute__((ext_vector_type(8)));
typedef float f32x4 __attribute__((ext_vector_type(4)));
typedef unsigned u32x4 __attribute__((ext_vector_type(4)));
constexpr int BM = 256, BK = 64, HALF = 128, HTB = HALF * BK * 2  , STAGE_BYTES = 8 * HTB, NXCD = 8, WGM = 8;

__host__ __device__ __forceinline__ int lds_byte(int r, int c) { const int st = (r >> 4) * 2 + (c >> 5), rr = r & 15, cc = c & 31, ob = rr * 64 + cc * 2; return st * 1024 + (ob ^ (((ob >> 9) & 1) << 5)); }
__host__ __device__ __forceinline__ void stage_rc(int b, int& R, int& C) { const int st = b / 1024, sb = b % 1024, swz = sb ^ (((sb >> 9) & 1) << 5); R = (st >> 1) * 16 + swz / 64; C = (st & 1) * 32 + (swz % 64) / 2; }
__host__ __device__ __forceinline__ int perm32(int rho) { const int n = rho >> 4, i = rho & 15; return 8 * (i >> 2) + 4 * n + (i & 3); }

struct Unit { int pm, pn; };
struct Gemm { const bf16_t* A; const bf16_t* Bt; int M, N, K; };

struct StaticOrder {
    int nM, nN, nwg, G, c;
    __host__ __device__ void init(int M, int N, int G_, int c_) { nM = M / BM; nN = N / BM; nwg = nM * nN; G = G_; c = c_; }
    __host__ __device__ bool next(int i, Unit& u) const {
        const long L = (long)i * G + c; if (L >= nwg) return false;
        int wgid = (int)L; { const int q = nwg / NXCD, r = nwg % NXCD, xcd = wgid % NXCD, off = wgid / NXCD; wgid = (xcd < r ? xcd * (q + 1) : r * (q + 1) + (xcd - r) * q) + off; }
        const int nig = WGM * nN, gid = wgid / nig, fm = gid * WGM, gsz = (nM - fm) < WGM ? (nM - fm) : WGM;
        u.pm = fm + ((wgid % nig) % gsz); u.pn = (wgid % nig) / gsz; return true;
    }
    __device__ __forceinline__ void a_ready(const Unit&) const {}
    __device__ __forceinline__ void done(const Unit&) const {}
};
__device__ __forceinline__ unsigned cvt_pk_bf16(float lo, float hi) { unsigned r; asm volatile("v_cvt_pk_bf16_f32 %0, %1, %2" : "=v"(r) : "v"(lo), "v"(hi)); return r; }
template <class Epi, class Sched>
__device__ __forceinline__ void gemm_phase(PG8_LAS unsigned char* lds, const Gemm g, const Sched& S, const Epi& E) {
    int tid_ = threadIdx.x; asm volatile("" : "+v"(tid_)); const int tid = tid_, wid = __builtin_amdgcn_readfirstlane(tid >> 6), lane = tid & 63, wr = wid >> 2, wc = wid & 3, fr = lane & 15, fq = lane >> 4;
    const int K = g.K, nt = K / BK;
    unsigned voffA[2], voffB[2];
#pragma unroll
    for (int i = 0; i < 2; ++i) { int R, C; stage_rc(tid * 16 + i * 8192, R, C); const int Rb = Epi::PERM ? ((R & ~31) + perm32(R & 31)) : R;
        voffA[i] = (unsigned)(R * K + C) * 2u; voffB[i] = (unsigned)(Rb * K + C) * 2u; }
    const size_t kstep = (size_t)(BK * 2);
    const size_t hstep = (size_t)HALF * K * 2;
    const size_t tstep = 2 * hstep;
    const unsigned ldsw = (unsigned)wid * 1024u;
    const int aoff = lds_byte(wr * 64 + fr, fq * 8), boff = lds_byte(wc * 32 + fr, fq * 8);
#define PG8_SA(b, h) (((b) * 2 + (h)) * HTB)
#define PG8_SB(b, h) ((4 + (b) * 2 + (h)) * HTB)
#define PG8_STAGE(bufoff, gbase, voff) do { _Pragma("unroll") for (int _i = 0; _i < 2; ++_i) \
        __builtin_amdgcn_global_load_lds((const unsigned*)((const char*)(gbase) + (voff)[_i]), (PG8_LAS unsigned*)(lds + (bufoff) + ldsw + _i * 8192), 16, 0, 0); } while (0)
#define PG8_LDA(dst, b, h) do { _Pragma("unroll") for (int m = 0; m < 4; ++m) _Pragma("unroll") for (int k = 0; k < 2; ++k) dst[m][k] = *(const PG8_LAS bf16x8*)(lds + PG8_SA(b, h) + aoff + m * 2048 + k * 1024); } while (0)
#define PG8_LDB(dst, b, h) do { _Pragma("unroll") for (int n = 0; n < 2; ++n) _Pragma("unroll") for (int k = 0; k < 2; ++k) dst[n][k] = *(const PG8_LAS bf16x8*)(lds + PG8_SB(b, h) + boff + n * 2048 + k * 1024); } while (0)
#define PG8_MMA(ai, bj, At, Bt) do { __builtin_amdgcn_s_setprio(1); _Pragma("unroll") for (int m = 0; m < 4; ++m) _Pragma("unroll") for (int n = 0; n < 2; ++n) _Pragma("unroll") for (int k = 0; k < 2; ++k) \
        acc[ai][bj][m][n] = __builtin_amdgcn_mfma_f32_16x16x32_bf16(Bt[n][k], At[m][k], acc[ai][bj][m][n], 0, 0, 0); __builtin_amdgcn_s_setprio(0); } while (0)
#define PG8_WAIT_V(n) asm volatile("s_waitcnt vmcnt(" #n ")" ::: "memory")
#define PG8_WAIT_L(n) asm volatile("s_waitcnt lgkmcnt(" #n ")" ::: "memory")
#define PG8_BAR __builtin_amdgcn_s_barrier()
#define PG8_SCHED __builtin_amdgcn_sched_barrier(0)
    Unit cur, nxt; int ui = 0;
    if (!S.next(0, cur)) return;
    f32x4 acc[2][2][4][2];
#pragma unroll
    for (int a = 0; a < 2; ++a)
#pragma unroll
        for (int b = 0; b < 2; ++b)
#pragma unroll
            for (int m = 0; m < 4; ++m)
#pragma unroll
                for (int n = 0; n < 2; ++n) acc[a][b][m][n] = (f32x4){0.f, 0.f, 0.f, 0.f};
    bf16x8 At[4][2], B0[2][2], B1[2][2];
    const char* cA = (const char*)g.A + (size_t)cur.pm * tstep; const char* cB = (const char*)g.Bt + (size_t)cur.pn * tstep;
    S.a_ready(cur);
    PG8_STAGE(PG8_SB(0, 0), cB, voffB); PG8_STAGE(PG8_SA(0, 0), cA, voffA); PG8_STAGE(PG8_SB(0, 1), cB + hstep, voffB); PG8_STAGE(PG8_SA(0, 1), cA + hstep, voffA);
    if (wr == 1) PG8_BAR;
    PG8_WAIT_V(4); PG8_BAR;
    PG8_STAGE(PG8_SB(1, 0), cB + kstep, voffB); PG8_STAGE(PG8_SA(1, 0), cA + kstep, voffA); PG8_STAGE(PG8_SB(1, 1), cB + hstep + kstep, voffB);
    PG8_WAIT_V(6); PG8_BAR;
    for (;;) {
        const bool has_next = S.next(ui + 1, nxt);
        const char* nA = has_next ? (const char*)g.A + (size_t)nxt.pm * tstep : cA; const char* nB = has_next ? (const char*)g.Bt + (size_t)nxt.pn * tstep : cB;
        for (int t = 0; t < nt; t += 2) {
            const bool last = (t == nt - 2);
            const char* a1 = cA + (size_t)(t + 1) * kstep;
            const char* a2 = last ? nA : cA + (size_t)(t + 2) * kstep; const char* b2 = last ? nB : cB + (size_t)(t + 2) * kstep;
            const char* a3 = a2 + kstep; const char* b3 = b2 + kstep;
            if (last && has_next) S.a_ready(nxt);
            PG8_LDB(B0, 0, 0); PG8_SCHED; PG8_LDA(At, 0, 0); PG8_STAGE(PG8_SA(1, 1), a1 + hstep, voffA);
            PG8_WAIT_L(8); PG8_BAR; PG8_WAIT_L(0); PG8_MMA(0, 0, At, B0); PG8_BAR; PG8_SCHED;
            PG8_LDB(B1, 0, 1); PG8_STAGE(PG8_SB(0, 0), b2, voffB);
            PG8_BAR; PG8_WAIT_L(0); PG8_MMA(0, 1, At, B1); PG8_BAR;
            PG8_LDA(At, 0, 1); PG8_STAGE(PG8_SA(0, 0), a2, voffA);
            PG8_BAR; PG8_WAIT_L(0); PG8_MMA(1, 0, At, B0); PG8_BAR; PG8_SCHED;
            PG8_STAGE(PG8_SB(0, 1), b2 + hstep, voffB);
            PG8_WAIT_V(6); PG8_BAR; PG8_MMA(1, 1, At, B1); PG8_BAR;
            PG8_LDB(B0, 1, 0); PG8_SCHED; PG8_LDA(At, 1, 0); PG8_STAGE(PG8_SA(0, 1), a2 + hstep, voffA);
            PG8_WAIT_L(8); PG8_BAR; PG8_WAIT_L(0); PG8_MMA(0, 0, At, B0); PG8_BAR; PG8_SCHED;
            PG8_LDB(B1, 1, 1); PG8_STAGE(PG8_SB(1, 0), b3, voffB);
            PG8_BAR; PG8_WAIT_L(0); PG8_MMA(0, 1, At, B1); PG8_BAR;
            PG8_LDA(At, 1, 1); PG8_STAGE(PG8_SA(1, 0), a3, voffA);
            PG8_BAR; PG8_WAIT_L(0); PG8_MMA(1, 0, At, B0); PG8_BAR; PG8_SCHED;
            PG8_STAGE(PG8_SB(1, 1), b3 + hstep, voffB);
            PG8_WAIT_V(6); PG8_BAR; PG8_MMA(1, 1, At, B1); PG8_BAR;
        }
        if constexpr (!Epi::AFTER_DRAIN) { E(acc, cur, wr, wc, fr, fq); S.done(cur); }
        if (!has_next) break;
#pragma unroll
        for (int a = 0; a < 2; ++a)
#pragma unroll
            for (int b = 0; b < 2; ++b)
#pragma unroll
                for (int m = 0; m < 4; ++m)
#pragma unroll
                    for (int n = 0; n < 2; ++n) acc[a][b][m][n] = (f32x4){0.f, 0.f, 0.f, 0.f};
        cur = nxt; cA = nA; cB = nB; ++ui;
    }
    PG8_WAIT_V(0);
    if (wr == 0) PG8_BAR;
    PG8_BAR;
    if constexpr (Epi::AFTER_DRAIN) { E.fused(acc, cur, wr, wc, fr, fq, lds, wid, lane); S.done(cur); }
#undef PG8_SA
#undef PG8_SB
#undef PG8_STAGE
#undef PG8_LDA
#undef PG8_LDB
#undef PG8_MMA
#undef PG8_WAIT_V
#undef PG8_WAIT_L
#undef PG8_BAR
#undef PG8_SCHED
}
}

using pg8::bf16_t; using pg8::bf16x8; using pg8::f32x4; using pg8::u32x4; using pg8::cvt_pk_bf16;
typedef unsigned u32x2 __attribute__((ext_vector_type(2)));

constexpr int NTOK = 16384, DM = 2048, DFF = 5632, DIN = 5632, SEQ = 4096;
constexpr float LN_EPS = 1e-5f;
constexpr float ALPHA = 1.41421356237f;
constexpr int LDS_BYTES = 147456;
constexpr int NPHASE = 25;

constexpr size_t SZ_GU = (size_t)11264 * 2048 * 2, SZ_DN = (size_t)2048 * 5632 * 2, SZ_IN = (size_t)5632 * 2048 * 2,
                 SZ_OUT = (size_t)2048 * 2048 * 2, SZ_RG = (size_t)4 * 128 * 128 * 2;
constexpr size_t OFF_CTL = 0, CTL_BYTES = 32768, OFF_GU = CTL_BYTES, OFF_DN = OFF_GU + 4 * SZ_GU, OFF_IN = OFF_DN + 4 * SZ_DN, OFF_OUT = OFF_IN + 2 * SZ_IN,
                 OFF_RGA = OFF_OUT + 2 * SZ_OUT, OFF_RGX = OFF_RGA + 2 * SZ_RG, OFF_X = OFF_RGX + 2 * SZ_RG,
                 OFF_XB = OFF_X + (size_t)NTOK * DM * 4, OFF_H = OFF_XB + (size_t)NTOK * DM * 2,
                 OFF_KMEAN = OFF_H + (size_t)NTOK * DFF * 2, OFF_ATILE = OFF_KMEAN + 131072, OFF_HTILE = OFF_ATILE + 524288,
                 OFF_HQS = OFF_HTILE + 524288, OFF_HKDT = OFF_HQS + 16777216, OFF_HVT = OFF_HKDT + 16777216, OFF_HEL = OFF_HVT + 16777216,
                 OFF_HGS = OFF_HEL + 1048576, OFF_STATS = OFF_HGS + 33554432, OFF_GB = OFF_STATS + 131072, WS_END = OFF_GB + 16384;
constexpr size_t OUT_HLOC = 0, OUT_CUMA = 33554432, OUT_VT = 67108864, OUT_OI = 83886080;

struct Params { const float* in[21]; float* out; unsigned char* ws; int ph_lo, ph_hi; };

__device__ __forceinline__ float bf2f(unsigned short u) { return __uint_as_float(((unsigned)u) << 16); }
__device__ __forceinline__ unsigned short f2bf(float f) { unsigned u = __float_as_uint(f); u += 0x7FFFu + ((u >> 16) & 1u); return (unsigned short)(u >> 16); }
__device__ __forceinline__ float sigm(float x) { return __builtin_amdgcn_rcpf(1.0f + __expf(-x)); }
__device__ __forceinline__ bf16x8 pack8(float a0, float a1, float a2, float a3, float a4, float a5, float a6, float a7) {
    u32x4 w; w.x = cvt_pk_bf16(a0, a1); w.y = cvt_pk_bf16(a2, a3); w.z = cvt_pk_bf16(a4, a5); w.w = cvt_pk_bf16(a6, a7);
    return __builtin_bit_cast(bf16x8, w);
}
__device__ __forceinline__ int opaque_tid() { int t = threadIdx.x; asm volatile("" : "+v"(t)); return t; }
__device__ __forceinline__ float row16_sum_to15(float x) {
    x += __int_as_float(__builtin_amdgcn_update_dpp(0, __float_as_int(x), 0x111, 0xf, 0xf, true));
    x += __int_as_float(__builtin_amdgcn_update_dpp(0, __float_as_int(x), 0x112, 0xf, 0xf, true));
    x += __int_as_float(__builtin_amdgcn_update_dpp(0, __float_as_int(x), 0x114, 0xf, 0xf, true));
    x += __int_as_float(__builtin_amdgcn_update_dpp(0, __float_as_int(x), 0x118, 0xf, 0xf, true));
    return x;
}
__device__ __forceinline__ void lds_barrier() { asm volatile("s_waitcnt lgkmcnt(0)" ::: "memory"); __builtin_amdgcn_s_barrier(); asm volatile("" ::: "memory"); }
__device__ __forceinline__ u32x2 pack4(f32x4 v) { u32x2 w; w.x = cvt_pk_bf16(v[0], v[1]); w.y = cvt_pk_bf16(v[2], v[3]); return w; }
__device__ __forceinline__ f32x4 unpack4(u32x2 w) { return (f32x4){__uint_as_float(w.x << 16), __uint_as_float(w.x & 0xffff0000u), __uint_as_float(w.y << 16), __uint_as_float(w.y & 0xffff0000u)}; }
typedef _Float16 h16x4 __attribute__((ext_vector_type(4)));
__device__ __forceinline__ u32x2 pack4h(f32x4 v) { const h16x4 h = __builtin_convertvector(v, h16x4); return __builtin_bit_cast(u32x2, h); }
__device__ __forceinline__ f32x4 unpack4h(u32x2 w) { return __builtin_convertvector(__builtin_bit_cast(h16x4, w), f32x4); }
#define MFMA16(a, b, c) __builtin_amdgcn_mfma_f32_16x16x32_bf16((a), (b), (c), 0, 0, 0)

struct EpiSwiGLU {
    static constexpr bool PERM = true, AFTER_DRAIN = false;
    bf16_t* H;
    __device__ __forceinline__ void operator()(const f32x4 (&acc)[2][2][4][2], const pg8::Unit& u, int wr, int wc, int fr, int fq) const {
        const int row0 = u.pm * 256 + wr * 64 + fr, col0 = u.pn * 128 + wc * 32 + 8 * fq;
#pragma unroll
        for (int ai = 0; ai < 2; ++ai)
#pragma unroll
            for (int m = 0; m < 4; ++m) {
                bf16_t* rowp = H + (size_t)(row0 + ai * 128 + m * 16) * DFF + col0;
                float hv[8];
#pragma unroll
                for (int n = 0; n < 2; ++n)
#pragma unroll
                    for (int j = 0; j < 4; ++j) { const float g = acc[ai][0][m][n][j], up = acc[ai][1][m][n][j]; hv[n * 4 + j] = g * sigm(g) * up; }
                u32x4 w; w.x = cvt_pk_bf16(hv[0], hv[1]); w.y = cvt_pk_bf16(hv[2], hv[3]); w.z = cvt_pk_bf16(hv[4], hv[5]); w.w = cvt_pk_bf16(hv[6], hv[7]);
                *(u32x4*)rowp = w;
            }
    }
};
struct EpiResid {
    static constexpr bool PERM = true, AFTER_DRAIN = false;
    unsigned char* ws; const float* Rraw; float* Oalt; float s;
    __device__ __forceinline__ void operator()(const f32x4 (&acc)[2][2][4][2], const pg8::Unit& u, int wr, int wc, int fr_, int fq_) const {
        int fr = fr_, fq = fq_; asm volatile("" : "+v"(fr), "+v"(fq));
        const int row0 = u.pm * 256 + wr * 64 + fr, col0 = u.pn * 256 + wc * 32 + 8 * fq;
        const bool ln = (Rraw == nullptr);
        bf16_t* Z = (bf16_t*)(ws + OFF_X);
        const float* st = (const float*)(ws + OFF_STATS); const float* gb = (const float*)(ws + OFF_GB);
        if (ln) {
#pragma unroll
            for (int bj = 0; bj < 2; ++bj) {
                f32x4 gv[2], bv[2];
#pragma unroll
                for (int n = 0; n < 2; ++n) { gv[n] = *(const f32x4*)(gb + col0 + bj * 128 + 4 * n); bv[n] = *(const f32x4*)(gb + DM + col0 + bj * 128 + 4 * n); }
                u32x4 r[2][4]; float mu[2][4], rs[2][4];
#pragma unroll
                for (int ai = 0; ai < 2; ++ai)
#pragma unroll
                    for (int m = 0; m < 4; ++m) { const int row = row0 + ai * 128 + m * 16; const unsigned off = (unsigned)row * DM + (unsigned)(col0 + bj * 128);
                        { const float2 ms = *(const float2*)(st + 2u * (unsigned)row); mu[ai][m] = ms.x; rs[ai][m] = ms.y; }
                        r[ai][m] = *(const u32x4*)(Z + off); }
                asm volatile("" ::: "memory");
#pragma unroll
                for (int ai = 0; ai < 2; ++ai)
#pragma unroll
                    for (int m = 0; m < 4; ++m) { const unsigned off = (unsigned)(row0 + ai * 128 + m * 16) * DM + (unsigned)(col0 + bj * 128);
                        u32x2 lo, hi; lo.x = r[ai][m].x; lo.y = r[ai][m].y; hi.x = r[ai][m].z; hi.y = r[ai][m].w;
                        const f32x4 x0 = (unpack4h(lo) - mu[ai][m]) * rs[ai][m] * gv[0] + bv[0], x1 = (unpack4h(hi) - mu[ai][m]) * rs[ai][m] * gv[1] + bv[1];
                        const u32x2 o0 = pack4h(x0 * ALPHA + acc[ai][bj][m][0] * s), o1 = pack4h(x1 * ALPHA + acc[ai][bj][m][1] * s);
                        u32x4 w; w.x = o0.x; w.y = o0.y; w.z = o1.x; w.w = o1.y; *(u32x4*)(Z + off) = w; }
            }
        } else {
#pragma unroll
            for (int bj = 0; bj < 2; ++bj)
#pragma unroll
                for (int ai = 0; ai < 2; ++ai) {
                    f32x4 r[4][2];
#pragma unroll
                    for (int m = 0; m < 4; ++m) { const size_t off = (size_t)(row0 + ai * 128 + m * 16) * DM + col0 + bj * 128;
#pragma unroll
                        for (int n = 0; n < 2; ++n) r[m][n] = *(const f32x4*)(Rraw + off + 4 * n); }
                    asm volatile("" ::: "memory");
#pragma unroll
                    for (int m = 0; m < 4; ++m) { const size_t off = (size_t)(row0 + ai * 128 + m * 16) * DM + col0 + bj * 128;
                        const u32x2 o0 = pack4h(r[m][0] * ALPHA + acc[ai][bj][m][0] * s), o1 = pack4h(r[m][1] * ALPHA + acc[ai][bj][m][1] * s);
                        u32x4 w; w.x = o0.x; w.y = o0.y; w.z = o1.x; w.w = o1.y; *(u32x4*)(Z + off) = w; }
                }
        }
    }
};
struct EpiBf16P {
    static constexpr bool PERM = true, AFTER_DRAIN = false;
    bf16_t* O; int ldc;
    __device__ __forceinline__ void operator()(const f32x4 (&acc)[2][2][4][2], const pg8::Unit& u, int wr, int wc, int fr, int fq) const {
        const int row0 = u.pm * 256 + wr * 64 + fr, col0 = u.pn * 256 + wc * 32 + 8 * fq;
#pragma unroll
        for (int ai = 0; ai < 2; ++ai)
#pragma unroll
            for (int m = 0; m < 4; ++m) {
                bf16_t* rowp = O + (size_t)(row0 + ai * 128 + m * 16) * ldc + col0;
#pragma unroll
                for (int bj = 0; bj < 2; ++bj) { const f32x4 v0 = acc[ai][bj][m][0], v1 = acc[ai][bj][m][1];
                    u32x4 w; w.x = cvt_pk_bf16(v0[0], v0[1]); w.y = cvt_pk_bf16(v0[2], v0[3]); w.z = cvt_pk_bf16(v1[0], v1[1]); w.w = cvt_pk_bf16(v1[2], v1[3]);
                    *(u32x4*)(rowp + bj * 128) = w; }
            }
    }
};

__device__ __forceinline__ void convT_job(const float* __restrict__ src, bf16_t* __restrict__ dst, int K, int N, int mode, float* t) {
    const int tid = opaque_tid(), ntn = N >> 6, ntiles = (K >> 7) * ntn;
    const int lk = tid >> 4, ln4 = (tid & 15) * 4;
    float4 pv[4];
#define CVT_LOAD(tile_) do { const int k0_ = ((tile_) / ntn) << 7, n0_ = ((tile_) % ntn) << 6; \
        _Pragma("unroll") for (int pp = 0; pp < 4; ++pp) pv[pp] = *(const float4*)(src + (size_t)(k0_ + lk + 32 * pp) * N + n0_ + ln4); } while (0)
    int tile = blockIdx.x;
    if (tile < ntiles) CVT_LOAD(tile);
#pragma unroll 1
    for (; tile < ntiles; tile += gridDim.x) {
        const int k0 = (tile / ntn) << 7, n0 = (tile % ntn) << 6;
#pragma unroll
        for (int pp = 0; pp < 4; ++pp) { const int k = lk + 32 * pp; t[k * 65 + ln4] = pv[pp].x; t[k * 65 + ln4 + 1] = pv[pp].y; t[k * 65 + ln4 + 2] = pv[pp].z; t[k * 65 + ln4 + 3] = pv[pp].w; }
        if (tile + (int)gridDim.x < ntiles) CVT_LOAD(tile + (int)gridDim.x);
        lds_barrier();
        const int n = tid >> 3, k16 = (tid & 7) * 16;
        float v[16];
#pragma unroll
        for (int j = 0; j < 16; ++j) v[j] = t[(k16 + j) * 65 + n];
        const int nn = n0 + n;
        const int row = mode == 0 ? nn : (256 * (nn >> 7) + (nn & 127) + (mode == 2 ? 128 : 0));
        u32x4 w0, w1; w0.x = cvt_pk_bf16(v[0], v[1]); w0.y = cvt_pk_bf16(v[2], v[3]); w0.z = cvt_pk_bf16(v[4], v[5]); w0.w = cvt_pk_bf16(v[6], v[7]);
        w1.x = cvt_pk_bf16(v[8], v[9]); w1.y = cvt_pk_bf16(v[10], v[11]); w1.z = cvt_pk_bf16(v[12], v[13]); w1.w = cvt_pk_bf16(v[14], v[15]);
        bf16_t* d = dst + (size_t)row * K + k0 + k16;
        *(u32x4*)d = w0; *(u32x4*)(d + 8) = w1;
        lds_barrier();
    }
#undef CVT_LOAD
}
__device__ __forceinline__ void phase_convert(const Params& p, unsigned char* smem) {
    float* t = (float*)smem;
    for (int l = 0; l < 2; ++l) {
        for (int f = 0; f < 2; ++f) {
            const size_t wo = (size_t)(l * 2 + f) * 2048 * 5632;
            bf16_t* gu = (bf16_t*)(p.ws + OFF_GU + (size_t)(l * 2 + f) * SZ_GU);
            convT_job(p.in[3] + wo, gu, 2048, 5632, 1, t);
            convT_job(p.in[4] + wo, gu, 2048, 5632, 2, t);
            convT_job(p.in[5] + wo, (bf16_t*)(p.ws + OFF_DN + (size_t)(l * 2 + f) * SZ_DN), 5632, 2048, 0, t);
        }
        convT_job(p.in[6] + (size_t)l * 2048 * 5632, (bf16_t*)(p.ws + OFF_IN + (size_t)l * SZ_IN), 2048, 5632, 0, t);
        convT_job(p.in[7] + (size_t)l * 2048 * 2048, (bf16_t*)(p.ws + OFF_OUT + (size_t)l * SZ_OUT), 2048, 2048, 0, t);
        for (int g = 0; g < 4; ++g) {
            convT_job(p.in[10] + (size_t)(l * 4 + g) * 16384, (bf16_t*)(p.ws + OFF_RGA + (size_t)l * SZ_RG) + g * 16384, 128, 128, 0, t);
            convT_job(p.in[12] + (size_t)(l * 4 + g) * 16384, (bf16_t*)(p.ws + OFF_RGX + (size_t)l * SZ_RG) + g * 16384, 128, 128, 0, t);
        }
    }
    const float4* xs = (const float4*)p.in[0]; u32x2* xd = (u32x2*)(p.ws + OFF_XB);
    const size_t n4 = (size_t)NTOK * DM / 4, gstr = (size_t)gridDim.x * 512;
    size_t i = (size_t)blockIdx.x * 512 + opaque_tid();
    for (; i + 7 * gstr < n4; i += 8 * gstr) {
        float4 v[8];
#pragma unroll
        for (int k = 0; k < 8; ++k) v[k] = xs[i + k * gstr];
#pragma unroll
        for (int k = 0; k < 8; ++k) { u32x2 w; w.x = cvt_pk_bf16(v[k].x, v[k].y); w.y = cvt_pk_bf16(v[k].z, v[k].w); xd[i + k * gstr] = w; }
    }
    for (; i < n4; i += gstr) { const float4 v = xs[i]; u32x2 w; w.x = cvt_pk_bf16(v.x, v.y); w.y = cvt_pk_bf16(v.z, v.w); xd[i] = w; }
}

__device__ __forceinline__ void phase_ln(const bf16_t* zin, float* xout, bf16_t* xb, float* stats, float* gbtab, const float* __restrict__ g, const float* __restrict__ b) {
    const int tid_ln = opaque_tid(); const int wave = tid_ln >> 6, lane = tid_ln & 63;
    if (gbtab && blockIdx.x == 0) { for (int i = tid_ln; i < DM; i += 512) { gbtab[i] = g[i]; gbtab[DM + i] = b[i]; } }
    const int rstep = gridDim.x * 8;
    int row = blockIdx.x * 8 + wave;
    u32x4 nv[4];
    if (row < NTOK) { const u32x4* src = (const u32x4*)(zin + (size_t)row * DM);
#pragma unroll
        for (int i = 0; i < 4; ++i) nv[i] = src[lane + 64 * i]; }
#pragma unroll 1
    for (; row < NTOK; row += rstep) {
        f32x4 v[8]; float s = 0.f;
#pragma unroll
        for (int i = 0; i < 4; ++i) { u32x2 lo, hi; lo.x = nv[i].x; lo.y = nv[i].y; hi.x = nv[i].z; hi.y = nv[i].w; v[2 * i] = unpack4h(lo); v[2 * i + 1] = unpack4h(hi); }
#pragma unroll
        for (int i = 0; i < 8; ++i) s += (v[i][0] + v[i][1]) + (v[i][2] + v[i][3]);
        if (row + rstep < NTOK) { const u32x4* src = (const u32x4*)(zin + (size_t)(row + rstep) * DM);
#pragma unroll
            for (int i = 0; i < 4; ++i) nv[i] = src[lane + 64 * i]; }
#pragma unroll
        for (int o = 32; o > 0; o >>= 1) s += __shfl_xor(s, o);
        const float mu = s * (1.0f / DM); float q = 0.f;
#pragma unroll
        for (int i = 0; i < 8; ++i) { const f32x4 d = v[i] - mu; q += (d[0] * d[0] + d[1] * d[1]) + (d[2] * d[2] + d[3] * d[3]); }
#pragma unroll
        for (int o = 32; o > 0; o >>= 1) q += __shfl_xor(q, o);
        const float rstd = rsqrtf(q * (1.0f / DM) + LN_EPS);
        if (stats && lane == 0) { stats[2 * row] = mu; stats[2 * row + 1] = rstd; }
#pragma unroll
        for (int i = 0; i < 4; ++i) {
            const int e0 = (lane + 64 * i) * 8;
            const f32x4 g0 = *(const f32x4*)(g + e0), g1 = *(const f32x4*)(g + e0 + 4), b0 = *(const f32x4*)(b + e0), b1 = *(const f32x4*)(b + e0 + 4);
            const f32x4 y0 = (v[2 * i] - mu) * rstd * g0 + b0, y1 = (v[2 * i + 1] - mu) * rstd * g1 + b1;
            if (xout) { *(f32x4*)(xout + (size_t)row * DM + e0) = y0; *(f32x4*)(xout + (size_t)row * DM + e0 + 4) = y1; }
            if (xb) { const u32x2 w0 = pack4(y0), w1 = pack4(y1); u32x4 w; w.x = w0.x; w.y = w0.y; w.z = w1.x; w.w = w1.y; *(u32x4*)(xb + (size_t)row * DM + e0) = w; }
        }
    }
}

__device__ __forceinline__ void kvpre_item(const Params& p, int item, unsigned char* smem) {
    const int tid = opaque_tid(), dgrp = tid & 15, krow = tid >> 4;
    const int bh = item >> 4, j = item & 15, b = bh >> 2, h = bh & 3;
    const bf16_t* P = (const bf16_t*)(p.ws + OFF_H);
    bf16_t* Vt = (bf16_t*)((unsigned char*)p.out + OUT_VT);
    float* red = (float*)smem;
    bf16_t* Vl = (bf16_t*)(smem + 16384);
    const bf16_t* Kb = P + ((size_t)b * SEQ + j * 256 + krow * 8) * DIN + 512 + h * 128 + dgrp * 8;
    u32x4 kr[8], vr[8];
#pragma unroll
    for (int i = 0; i < 8; ++i) { kr[i] = *(const u32x4*)(Kb + (size_t)i * DIN); vr[i] = *(const u32x4*)(Kb + (size_t)i * DIN + 512); }
    float ks[8] = {0.f, 0.f, 0.f, 0.f, 0.f, 0.f, 0.f, 0.f};
#pragma unroll
    for (int i = 0; i < 8; ++i) {
        ks[0] += __uint_as_float(kr[i].x << 16); ks[1] += __uint_as_float(kr[i].x & 0xffff0000u); ks[2] += __uint_as_float(kr[i].y << 16); ks[3] += __uint_as_float(kr[i].y & 0xffff0000u);
        ks[4] += __uint_as_float(kr[i].z << 16); ks[5] += __uint_as_float(kr[i].z & 0xffff0000u); ks[6] += __uint_as_float(kr[i].w << 16); ks[7] += __uint_as_float(kr[i].w & 0xffff0000u);
    }
    *(f32x4*)(red + krow * 128 + dgrp * 8) = (f32x4){ks[0], ks[1], ks[2], ks[3]}; *(f32x4*)(red + krow * 128 + dgrp * 8 + 4) = (f32x4){ks[4], ks[5], ks[6], ks[7]};
#pragma unroll
    for (int e = 0; e < 8; ++e) {
        unsigned hv[8];
#pragma unroll
        for (int i = 0; i < 8; ++i) { const unsigned wsel = (e >> 1) == 0 ? vr[i].x : ((e >> 1) == 1 ? vr[i].y : ((e >> 1) == 2 ? vr[i].z : vr[i].w)); hv[i] = (e & 1) ? (wsel >> 16) : (wsel & 0xffffu); }
        u32x4 wv; wv.x = hv[0] | (hv[1] << 16); wv.y = hv[2] | (hv[3] << 16); wv.z = hv[4] | (hv[5] << 16); wv.w = hv[6] | (hv[7] << 16);
        const int d = dgrp * 8 + e;
        *(u32x4*)(Vl + d * 256 + ((krow ^ dgrp) << 3)) = wv;
    }
    lds_barrier();
    if (tid < 128) { float s = 0.f;
#pragma unroll 8
        for (int r = 0; r < 32; ++r) s += red[r * 128 + tid];
        ((float*)(p.ws + OFF_KMEAN))[((size_t)bh * 16 + j) * 128 + tid] = s * (1.0f / 256.0f); }
#pragma unroll
    for (int r = 0; r < 8; ++r) {
        const int idx = r * 512 + tid, d = idx >> 5, pc = idx & 31, lc = pc ^ ((d >> 3) & 15);
        const u32x4 wv = *(const u32x4*)(Vl + d * 256 + (pc << 3));
        *(u32x4*)(Vt + ((size_t)bh * 128 + d) * SEQ + j * 256 + (lc << 3)) = wv;
    }
    lds_barrier();
}

__device__ __forceinline__ void rgpre_range(const Params& p, int layer, unsigned char* smem) {
    const int tid = opaque_tid(), c = tid & 127, sg = tid >> 7, w = tid >> 6, lane = tid & 63, fr = lane & 15, fq = lane >> 4;
    const bf16_t* P = (const bf16_t*)(p.ws + OFF_H);
    float* xcf = (float*)smem; bf16_t* xcb = (bf16_t*)(smem + 32768); float* aL = (float*)(smem + 50176); float* uL = (float*)(smem + 82944);
    float* segA = (float*)(smem + 115712); float* segH = (float*)(smem + 117760);
    float* HL = (float*)((unsigned char*)p.out + OUT_HLOC); float* CA = (float*)((unsigned char*)p.out + OUT_CUMA);
    bf16x8 Ba[4], Bx[4];
    int g_loaded = -1;
    float cw0 = 0.f, cw1 = 0.f, cw2 = 0.f, cw3 = 0.f, cb = 0.f, ba = 0.f, bx = 0.f, sp = 0.f;
    unsigned short nx[19];
#define RGP_LOAD(item_) do { const int g_ = (item_) & 3, bt_ = (item_) >> 2, b_ = bt_ >> 6, tau_ = bt_ & 63; const bf16_t* Px_ = P + (size_t)b_ * SEQ * DIN + 2048 + g_ * 128 + c; const int tb_ = tau_ * 64 + sg * 16 - 3; \
        _Pragma("unroll") for (int i = 0; i < 19; ++i) { const int pos_ = tb_ + i; nx[i] = pos_ >= 0 ? Px_[(size_t)pos_ * DIN] : (unsigned short)0; } } while (0)
    int item = blockIdx.x;
    if (item < 1024) RGP_LOAD(item);
#pragma unroll 1
    for (; item < 1024; item += gridDim.x) {
        const int g = item & 3, bt = item >> 2, b = bt >> 6, tau = bt & 63;
        const int ch = g * 128 + c;
        if (g != g_loaded) {
            g_loaded = g;
            const bf16_t* Wa = (const bf16_t*)(p.ws + OFF_RGA + (size_t)layer * SZ_RG) + g * 16384;
            const bf16_t* Wx = (const bf16_t*)(p.ws + OFF_RGX + (size_t)layer * SZ_RG) + g * 16384;
#pragma unroll
            for (int kk = 0; kk < 4; ++kk) { Ba[kk] = *(const bf16x8*)(Wa + (16 * w + fr) * 128 + 32 * kk + 8 * fq); Bx[kk] = *(const bf16x8*)(Wx + (16 * w + fr) * 128 + 32 * kk + 8 * fq); }
            const float* cw = p.in[8] + (size_t)layer * 4 * 512 + ch;
            cw0 = cw[0]; cw1 = cw[512]; cw2 = cw[1024]; cw3 = cw[1536]; cb = p.in[9][layer * 512 + ch];
            const int chl = layer * 512 + g * 128 + 16 * w + fr;
            ba = p.in[11][chl]; bx = p.in[13][chl]; { const float e = __expf(-p.in[14][chl]); sp = e < 0.02f ? e * (1.0f - e * (0.5f - e * 0.33333334f)) : __logf(1.0f + e); }
        }
        {
            float xw[19];
#pragma unroll
            for (int i = 0; i < 19; ++i) xw[i] = bf2f(nx[i]);
#pragma unroll
            for (int i = 0; i < 16; ++i) { const float xc = cb + cw0 * xw[i] + cw1 * xw[i + 1] + cw2 * xw[i + 2] + cw3 * xw[i + 3]; const int t = sg * 16 + i; xcf[t * 128 + c] = xc; xcb[t * 136 + c] = f2bf(xc); }
        }
        if (item + (int)gridDim.x < 1024) RGP_LOAD(item + (int)gridDim.x);
        lds_barrier();
        {
            const int col = 16 * w + fr;
#pragma unroll
            for (int tt = 0; tt < 4; ++tt) {
                f32x4 aa = {0.f, 0.f, 0.f, 0.f}, ax = {0.f, 0.f, 0.f, 0.f};
#pragma unroll
                for (int kk = 0; kk < 4; ++kk) { const bf16x8 a = *(const bf16x8*)(xcb + (16 * tt + fr) * 136 + 32 * kk + 8 * fq); aa = MFMA16(a, Ba[kk], aa); ax = MFMA16(a, Bx[kk], ax); }
#pragma unroll
                for (int j = 0; j < 4; ++j) {
                    const int t = 16 * tt + 4 * fq + j;
                    const float r = sigm(aa[j] + ba), ii = sigm(ax[j] + bx), la = -8.0f * r * sp, x2 = 2.0f * la;
                    const float av = __expf(la);
                    const float ser = -x2 * (1.0f + x2 * (0.5f + x2 * (0.16666667f + x2 * (0.041666668f + x2 * (0.0083333338f + x2 * 0.0013888889f)))));
                    const float om = x2 > -0.25f ? ser : 1.0f - __expf(x2);
                    const float u = __builtin_amdgcn_sqrtf(fmaxf(om, 0.f)) * (ii * xcf[t * 128 + col]);
                    aL[t * 128 + col] = av; uL[t * 128 + col] = u;
                }
            }
        }
        lds_barrier();
        {
            float hh = 0.f, AA = 1.f;
#pragma unroll
            for (int i = 0; i < 16; ++i) { const int t = sg * 16 + i; const float av = aL[t * 128 + c], u = uL[t * 128 + c]; hh = av * hh + u; AA *= av; uL[t * 128 + c] = hh; aL[t * 128 + c] = AA; }
            segA[sg * 128 + c] = AA; segH[sg * 128 + c] = hh;
        }
        lds_barrier();
        {
            float carry = 0.f, cA = 1.f;
            for (int s2 = 0; s2 < sg; ++s2) { const float a2 = segA[s2 * 128 + c]; carry = a2 * carry + segH[s2 * 128 + c]; cA *= a2; }
            float hl = 0.f, ca = 0.f;
#pragma unroll
            for (int i = 0; i < 16; ++i) {
                const int t = sg * 16 + i; const size_t tok = (size_t)b * SEQ + tau * 64 + t;
                const float al = aL[t * 128 + c]; hl = uL[t * 128 + c] + al * carry; ca = al * cA;
                HL[tok * 512 + ch] = hl; CA[tok * 512 + ch] = ca;
            }
            if (sg == 3) { ((float*)(p.ws + OFF_ATILE))[((size_t)b * 64 + tau) * 512 + ch] = ca; ((float*)(p.ws + OFF_HTILE))[((size_t)b * 64 + tau) * 512 + ch] = hl; }
        }
        lds_barrier();
    }
#undef RGP_LOAD
}

__device__ __forceinline__ void convc_item(const Params& p, int layer, int item, unsigned char* smem) {
    const int tid = opaque_tid(), c = tid, w = tid >> 6, lane = tid & 63;
    const int b = item >> 7, tau = item & 127;
    const bf16_t* P = (const bf16_t*)(p.ws + OFF_H);
    bf16_t* Y = (bf16_t*)(p.ws + OFF_XB);
    bf16_t* glu = (bf16_t*)smem;
    float* ubuf = (float*)(smem + 63488); float* stats = (float*)(smem + 63488 + 65536);
    {
        const bf16_t* Pv = P + (size_t)b * SEQ * DIN + 2560;
        u32x4 va[8], ga[8];
#pragma unroll
        for (int r = 0; r < 8; ++r) { const int slot = r * 512 + tid, row = slot >> 6, c8 = (slot & 63) * 8, pos = tau * 32 - 30 + row;
            if (row < 62 && pos >= 0) { const bf16_t* q = Pv + (size_t)pos * DIN + c8; va[r] = *(const u32x4*)q; ga[r] = *(const u32x4*)(q + 512); }
            else { va[r] = (u32x4){0u, 0u, 0u, 0u}; ga[r] = (u32x4){0u, 0u, 0u, 0u}; } }
#pragma unroll
        for (int r = 0; r < 8; ++r) { const int slot = r * 512 + tid, row = slot >> 6, c8 = (slot & 63) * 8;
            if (row < 62) {
                float o[8];
                const unsigned vw[4] = {va[r].x, va[r].y, va[r].z, va[r].w}, gw_[4] = {ga[r].x, ga[r].y, ga[r].z, ga[r].w};
#pragma unroll
                for (int e = 0; e < 4; ++e) { o[2 * e] = __uint_as_float(vw[e] << 16) * sigm(__uint_as_float(gw_[e] << 16)); o[2 * e + 1] = __uint_as_float(vw[e] & 0xffff0000u) * sigm(__uint_as_float(gw_[e] & 0xffff0000u)); }
                *(bf16x8*)(glu + row * 512 + c8) = pack8(o[0], o[1], o[2], o[3], o[4], o[5], o[6], o[7]); } }
    }
    float wk[31];
#pragma unroll
    for (int k = 0; k < 31; ++k) wk[k] = p.in[15][(size_t)layer * 31 * 512 + k * 512 + c];
    const float cb = p.in[16][layer * 512 + c];
    lds_barrier();
    float gw[38];
#pragma unroll
    for (int i = 0; i < 30; ++i) gw[i] = bf2f(glu[i * 512 + c]);
#pragma unroll 1
    for (int tg = 0; tg < 4; ++tg) {
#pragma unroll
        for (int i = 0; i < 8; ++i) gw[30 + i] = bf2f(glu[(30 + tg * 8 + i) * 512 + c]);
#pragma unroll
        for (int o = 0; o < 8; ++o) { float acc = cb;
#pragma unroll
            for (int k = 0; k < 31; ++k) acc += wk[k] * gw[o + k];
            ubuf[(tg * 8 + o) * 512 + c] = acc; }
#pragma unroll
        for (int i = 0; i < 30; ++i) gw[i] = gw[i + 8];
    }
    lds_barrier();
#pragma unroll 1
    for (int i = 0; i < 16; ++i) {
        const int pr = w * 16 + i, t = pr >> 2, grp = pr & 3;
        const float v0 = ubuf[t * 512 + grp * 128 + lane], v1 = ubuf[t * 512 + grp * 128 + 64 + lane];
        float s = v0 + v1;
#pragma unroll
        for (int o = 32; o > 0; o >>= 1) s += __shfl_xor(s, o);
        const float mu = s * (1.0f / 128.0f), d0 = v0 - mu, d1 = v1 - mu; float q = d0 * d0 + d1 * d1;
#pragma unroll
        for (int o = 32; o > 0; o >>= 1) q += __shfl_xor(q, o);
        if (lane == 0) { stats[(t * 4 + grp) * 2] = mu; stats[(t * 4 + grp) * 2 + 1] = rsqrtf(q * (1.0f / 128.0f) + LN_EPS); }
    }
    lds_barrier();
    {
        const float ng = p.in[17][layer * 512 + c], nb = p.in[18][layer * 512 + c]; const int grp = c >> 7;
#pragma unroll 8
        for (int t = 0; t < 32; ++t) {
            const float mu = stats[(t * 4 + grp) * 2], rs = stats[(t * 4 + grp) * 2 + 1];
            const float z = (ubuf[t * 512 + c] - mu) * rs * ng + nb;
            Y[((size_t)b * SEQ + tau * 32 + t) * DM + 1024 + c] = f2bf(z * sigm(z));
        }
    }
    lds_barrier();
}

__device__ __forceinline__ void rgpost_item(const Params& p, int item, unsigned char* smem) {
    const int tid = opaque_tid(), c4 = (tid & 127) * 4, sg = tid >> 7, b = item >> 6, tau = item & 63;
    const bf16_t* P = (const bf16_t*)(p.ws + OFF_H);
    bf16_t* Y = (bf16_t*)(p.ws + OFF_XB);
    const float* AT = (const float*)(p.ws + OFF_ATILE) + (size_t)b * 64 * 512 + c4; const float* HT = (const float*)(p.ws + OFF_HTILE) + (size_t)b * 64 * 512 + c4;
    const float* HL = (const float*)((unsigned char*)p.out + OUT_HLOC); const float* CA = (const float*)((unsigned char*)p.out + OUT_CUMA);
    f32x4 pa = {1.f, 1.f, 1.f, 1.f}, ph = {0.f, 0.f, 0.f, 0.f};
    {
        const int sbeg = sg * 16, send = tau < sbeg + 16 ? tau : sbeg + 16;
#pragma unroll 1
        for (int s0 = sbeg; s0 < send; s0 += 8) {
            f32x4 av[8], hv[8];
#pragma unroll
            for (int i = 0; i < 8; ++i) { const bool ok = s0 + i < send; av[i] = ok ? *(const f32x4*)(AT + (s0 + i) * 512) : (f32x4){1.f, 1.f, 1.f, 1.f}; hv[i] = ok ? *(const f32x4*)(HT + (s0 + i) * 512) : (f32x4){0.f, 0.f, 0.f, 0.f}; }
#pragma unroll
            for (int i = 0; i < 8; ++i) { ph = av[i] * ph + hv[i]; pa = pa * av[i]; }
        }
    }
    f32x4* cs = (f32x4*)smem;
    cs[(sg * 128 + (tid & 127)) * 2] = pa; cs[(sg * 128 + (tid & 127)) * 2 + 1] = ph;
    lds_barrier();
    f32x4 carry = {0.f, 0.f, 0.f, 0.f};
#pragma unroll
    for (int q = 0; q < 4; ++q) { const f32x4 a = cs[(q * 128 + (tid & 127)) * 2], hq = cs[(q * 128 + (tid & 127)) * 2 + 1]; carry = a * carry + hq; }
    lds_barrier();
    const size_t tok0 = (size_t)b * SEQ + tau * 64 + sg * 16;
#pragma unroll 1
    for (int t0 = 0; t0 < 16; t0 += 8) {
        f32x4 hl[8], ca[8]; u32x2 gt[8];
#pragma unroll
        for (int i = 0; i < 8; ++i) { const size_t tok = tok0 + t0 + i; hl[i] = *(const f32x4*)(HL + tok * 512 + c4); ca[i] = *(const f32x4*)(CA + tok * 512 + c4); gt[i] = *(const u32x2*)(P + tok * DIN + 1536 + c4); }
#pragma unroll
        for (int i = 0; i < 8; ++i) {
            const f32x4 hv = hl[i] + ca[i] * carry;
            float x[4] = {__uint_as_float(gt[i].x << 16), __uint_as_float(gt[i].x & 0xffff0000u), __uint_as_float(gt[i].y << 16), __uint_as_float(gt[i].y & 0xffff0000u)};
            float y[4];
#pragma unroll
            for (int e = 0; e < 4; ++e) { const float u = 0.7978845608f * (x[e] + 0.044715f * x[e] * x[e] * x[e]); const float th = 1.0f - 2.0f * __builtin_amdgcn_rcpf(__expf(2.0f * u) + 1.0f); y[e] = hv[e] * 0.5f * x[e] * (1.0f + th); }
            u32x2 w2; w2.x = cvt_pk_bf16(y[0], y[1]); w2.y = cvt_pk_bf16(y[2], y[3]);
            *(u32x2*)(Y + (tok0 + t0 + i) * DM + 512 + c4) = w2;
        }
    }
}

__device__ __forceinline__ void attn_item(const Params& p, int item, unsigned char* smem) {
    const int tid = opaque_tid(), w = tid >> 6, lane = tid & 63, fr = lane & 15, fq = lane >> 4;
    const int qt = 31 - (item >> 4), bh = item & 15, b = bh >> 2, h = bh & 3;
    const int blk = qt >> 1, o = (qt & 1) * 128, q0 = blk * 256 + o;
    const bf16_t* P = (const bf16_t*)(p.ws + OFF_H);
    const bf16_t* Vt = (const bf16_t*)((unsigned char*)p.out + OUT_VT) + (size_t)bh * 128 * SEQ;
    const float* kmean = (const float*)(p.ws + OFF_KMEAN) + (size_t)bh * 16 * 128;
    bf16_t* Y = (bf16_t*)(p.ws + OFF_XB);
    bf16_t* Ks = (bf16_t*)smem; bf16_t* Vs = (bf16_t*)(smem + 34816);
    float* kms = (float*)(smem + 71680); float* gts = (float*)(smem + 79872);
    unsigned* sels = (unsigned*)(smem + 88576); int* tiles = (int*)(smem + 89088); unsigned* um = (unsigned*)(smem + 89344);
    const bf16_t* Pb = P + (size_t)b * SEQ * DIN;

    bf16x8 Qf[4];
    { const bf16_t* qrow = Pb + (size_t)(q0 + 16 * w + fr) * DIN + h * 128;
#pragma unroll
      for (int kk = 0; kk < 4; ++kk) Qf[kk] = *(const bf16x8*)(qrow + 32 * kk + 8 * fq); }
    for (int i = tid; i < blk * 128; i += 512) kms[i] = kmean[i];
    if (tid == 0) um[0] = 0u;
    lds_barrier();
    {
        const int qi = tid & 127, jg = tid >> 7;
        float g4[4] = {0.f, 0.f, 0.f, 0.f};
        if (jg * 4 < blk) {
            const bf16_t* qr = Pb + (size_t)(q0 + qi) * DIN + h * 128;
#pragma unroll 1
            for (int ch = 0; ch < 2; ++ch) {
            u32x4 qraw[8];
#pragma unroll
            for (int c8 = 0; c8 < 8; ++c8) qraw[c8] = *(const u32x4*)(qr + 64 * ch + 8 * c8);
#pragma unroll
            for (int c8 = 0; c8 < 8; ++c8) {
                const int cc = ch * 8 + c8;
                const u32x4 raw = qraw[c8];
                float qv[8];
                qv[0] = __uint_as_float(raw.x << 16); qv[1] = __uint_as_float(raw.x & 0xffff0000u); qv[2] = __uint_as_float(raw.y << 16); qv[3] = __uint_as_float(raw.y & 0xffff0000u);
                qv[4] = __uint_as_float(raw.z << 16); qv[5] = __uint_as_float(raw.z & 0xffff0000u); qv[6] = __uint_as_float(raw.w << 16); qv[7] = __uint_as_float(raw.w & 0xffff0000u);
#pragma unroll
                for (int jj = 0; jj < 4; ++jj) { const int j = jg * 4 + jj; if (j < blk) { const float* km = kms + j * 128 + 8 * cc;
#pragma unroll
                    for (int e = 0; e < 8; ++e) g4[jj] += qv[e] * km[e]; } }
            }
            }
        }
#pragma unroll
        for (int jj = 0; jj < 4; ++jj) gts[qi * 17 + jg * 4 + jj] = g4[jj];
    }
    lds_barrier();
    if (tid < 128) {
        unsigned m = 0u; const int nsel = blk < 3 ? blk : 3;
        for (int s = 0; s < nsel; ++s) { float best = -3.0e38f; int bi = 0;
            for (int j = 0; j < blk; ++j) { const float v = gts[tid * 17 + j]; if (!((m >> j) & 1u) && v > best) { best = v; bi = j; } }
            m |= 1u << bi; }
        sels[tid] = m; if (m) atomicOr(um, m);
    }
    lds_barrier();
    if (tid == 0) { int n = 0; const unsigned u0 = um[0];
        for (int t = 0; t < o / 64 + 2; ++t) tiles[n++] = blk * 256 + t * 64;
        for (int j = 0; j < blk; ++j) if ((u0 >> j) & 1u) for (int t = 0; t < 4; ++t) tiles[n++] = j * 256 + t * 64;
        um[1] = (unsigned)n; }
    lds_barrier();
    const unsigned msel = sels[16 * w + fr]; const int ntiles = (int)um[1];
    const int qpos = q0 + 16 * w + fr;
    const float SC = 0.12751743f;

    f32x4 oacc[8];
#pragma unroll
    for (int dt = 0; dt < 8; ++dt) oacc[dt] = (f32x4){0.f, 0.f, 0.f, 0.f};
    float m_run = -1.0e30f, l_run = 0.f;
    struct KVStage { u32x4 k0, k1, v0, v1; };
    KVStage s0, s1, s2;
    const int lr = tid >> 3, lc = (tid & 7) * 16, vr = tid >> 2, vc = (tid & 3) * 16;
    const int lrp = (lr & 32) + ((lr >> 2) & 1) * 16 + ((lr >> 3) & 3) * 4 + (lr & 3);
#define ATT_GLOAD(st_, kpos_) do { const bf16_t* kp_ = Pb + (size_t)((kpos_) + lr) * DIN + 512 + h * 128 + lc; st_.k0 = *(const u32x4*)kp_; st_.k1 = *(const u32x4*)(kp_ + 8); \
        const bf16_t* vp_ = Vt + (size_t)vr * SEQ + (kpos_) + vc; st_.v0 = *(const u32x4*)vp_; st_.v1 = *(const u32x4*)(vp_ + 8); } while (0)
#define ATT_LSTORE(st_, buf_) do { bf16_t* kd_ = Ks + (buf_) * 8704 + lrp * 136 + lc; *(u32x4*)kd_ = st_.k0; *(u32x4*)(kd_ + 8) = st_.k1; \
        bf16_t* vd_ = Vs + (buf_) * 9216 + vr * 72 + vc; *(u32x4*)vd_ = st_.v0; *(u32x4*)(vd_ + 8) = st_.v1; } while (0)
    ATT_GLOAD(s0, tiles[0]); ATT_LSTORE(s0, 0);
    if (1 < ntiles) ATT_GLOAD(s1, tiles[1]);
    if (2 < ntiles) ATT_GLOAD(s2, tiles[2]);
    if (3 < ntiles) ATT_GLOAD(s0, tiles[3]);
    lds_barrier();
#define ATT_BODY(it_, stn_) do { \
        const int buf = (it_) & 1, kpos = tiles[(it_)]; \
        const bf16_t* Kb = Ks + buf * 8704; const bf16_t* Vb = Vs + buf * 9216; \
        const bool own = kpos >= blk * 256; const bool selok = (msel >> (kpos >> 8)) & 1u; \
        if (own || __any(selok)) { \
        f32x4 sacc[4]; \
        _Pragma("unroll") for (int T = 0; T < 4; ++T) { \
            const int krow = 32 * (T >> 1) + 16 * (T & 1) + fr; \
            sacc[T] = (f32x4){0.f, 0.f, 0.f, 0.f}; \
            _Pragma("unroll") for (int kk = 0; kk < 4; ++kk) { const bf16x8 a = *(const bf16x8*)(Kb + krow * 136 + 32 * kk + 8 * fq); sacc[T] = MFMA16(a, Qf[kk], sacc[T]); } \
        } \
        float mx = m_run; \
        _Pragma("unroll") for (int T = 0; T < 4; ++T) \
            _Pragma("unroll") for (int j = 0; j < 4; ++j) { const int key = kpos + 32 * (T >> 1) + 8 * fq + 4 * (T & 1) + j; const bool ok = own ? (key <= qpos) : selok; \
                const float sv = ok ? sacc[T][j] * SC : -1.0e30f; sacc[T][j] = sv; mx = fmaxf(mx, sv); } \
        mx = fmaxf(mx, __shfl_xor(mx, 16)); mx = fmaxf(mx, __shfl_xor(mx, 32)); \
        const float al = __builtin_amdgcn_exp2f(m_run - mx); m_run = mx; \
        float ps = 0.f; \
        _Pragma("unroll") for (int T = 0; T < 4; ++T) \
            _Pragma("unroll") for (int j = 0; j < 4; ++j) { const float pv = __builtin_amdgcn_exp2f(sacc[T][j] - mx); sacc[T][j] = pv; ps += pv; } \
        l_run = l_run * al + ps; \
        _Pragma("unroll") for (int dt = 0; dt < 8; ++dt) oacc[dt] *= al; \
        _Pragma("unroll") for (int G = 0; G < 2; ++G) { \
            const bf16x8 pb = pack8(sacc[2 * G][0], sacc[2 * G][1], sacc[2 * G][2], sacc[2 * G][3], sacc[2 * G + 1][0], sacc[2 * G + 1][1], sacc[2 * G + 1][2], sacc[2 * G + 1][3]); \
            _Pragma("unroll") for (int dt = 0; dt < 8; ++dt) { const bf16x8 a = *(const bf16x8*)(Vb + (16 * dt + fr) * 72 + 32 * G + 8 * fq); oacc[dt] = MFMA16(a, pb, oacc[dt]); } \
        } \
        } \
        if ((it_) + 1 < ntiles) ATT_LSTORE(stn_, buf ^ 1); \
        if ((it_) + 4 < ntiles) ATT_GLOAD(stn_, tiles[(it_) + 4]); \
        lds_barrier(); \
    } while (0)
#pragma unroll 1
    for (int it = 0; it < ntiles; it += 3) {
        ATT_BODY(it, s1);
        if (it + 1 >= ntiles) break;
        ATT_BODY(it + 1, s2);
        if (it + 2 >= ntiles) break;
        ATT_BODY(it + 2, s0);
    }
#undef ATT_BODY
#undef ATT_GLOAD
#undef ATT_LSTORE
    float l = l_run + __shfl_xor(l_run, 16); l += __shfl_xor(l, 32);
    const float inv = 1.0f / l;
    bf16_t* yrow = Y + ((size_t)b * SEQ + qpos) * DM + h * 128 + 4 * fq;
#pragma unroll
    for (int dt = 0; dt < 8; ++dt) { u32x2 w2; w2.x = cvt_pk_bf16(oacc[dt][0] * inv, oacc[dt][1] * inv); w2.y = cvt_pk_bf16(oacc[dt][2] * inv, oacc[dt][3] * inv); *(u32x2*)(yrow + 16 * dt) = w2; }
}

__device__ __forceinline__ void hgpre_range(const Params& p, int layer, unsigned char* smem) {
    const int tid = opaque_tid(), c = tid & 127, sg = tid >> 7, w = tid >> 6, lane = tid & 63, fr = lane & 15, fq = lane >> 4;
    const bf16_t* P = (const bf16_t*)(p.ws + OFF_H);
    bf16_t* qs = (bf16_t*)smem; bf16_t* ks = (bf16_t*)(smem + 8704); bf16_t* vT = (bf16_t*)(smem + 17408);
    bf16_t* att = (bf16_t*)(smem + 27648); float* seg = (float*)(smem + 30208);
    bf16_t* raw = (bf16_t*)(smem + 32768);
    const int lrow = tid >> 4, lcol = (tid & 15) * 8;
    u32x4 pq, pf, pv, pg;
#define HGP_LOAD(item_) do { const int bh_ = (item_) >> 7, chn_ = (item_) & 127; const bf16_t* Pq_ = P + ((size_t)(bh_ >> 2) * SEQ + chn_ * 32 + lrow) * DIN + 3584 + (bh_ & 3) * 128 + lcol; \
        pq = *(const u32x4*)Pq_; pf = *(const u32x4*)(Pq_ + 512); pv = *(const u32x4*)(Pq_ + 1024); pg = *(const u32x4*)(Pq_ + 1536); } while (0)
    int item = blockIdx.x;
    if (item < 2048) HGP_LOAD(item);
#pragma unroll 1
    for (; item < 2048; item += gridDim.x) {
        const int bh = item >> 7, chn = item & 127, h = bh & 3;
        const size_t cidx = (size_t)bh * 128 + chn;
        bf16_t* gQS = (bf16_t*)(p.ws + OFF_HQS) + cidx * 4096; bf16_t* gKDT = (bf16_t*)(p.ws + OFF_HKDT) + cidx * 4096; bf16_t* gVT = (bf16_t*)(p.ws + OFF_HVT) + cidx * 4096;
        float* gEL = (float*)(p.ws + OFF_HEL) + cidx * 128;
        f32x4* gOI = (f32x4*)((unsigned char*)p.out + OUT_OI) + cidx * 1024; f32x4* gGS = (f32x4*)(p.ws + OFF_HGS) + cidx * 1024;
        float lb = 0.f;
        if (layer == 1) lb = sigm(p.in[19][512 + h * 128 + c] - p.in[19][h * 128 + c]);
        const float omlb = 1.0f - lb;
        const float ngv = p.in[20][layer * 512 + h * 128 + 16 * w + fr];
        *(u32x4*)(raw + lrow * 128 + lcol) = pq; *(u32x4*)(raw + 4096 + lrow * 128 + lcol) = pf; *(u32x4*)(raw + 8192 + lrow * 128 + lcol) = pv; *(u32x4*)(raw + 12288 + lrow * 128 + lcol) = pg;
        if (item + (int)gridDim.x < 2048) HGP_LOAD(item + (int)gridDim.x);
        lds_barrier();
        unsigned short nq[8], nf[8], nv[8], ng[8];
#pragma unroll
        for (int i = 0; i < 8; ++i) { const int o_ = (8 * sg + i) * 128 + c; nq[i] = raw[o_]; nf[i] = raw[4096 + o_]; nv[i] = raw[8192 + o_]; }
#pragma unroll
        for (int i = 0; i < 8; ++i) ng[i] = raw[12288 + (16 * (i >> 2) + 4 * fq + (i & 3)) * 128 + 16 * w + fr];
        float qv[8], kv[8], bl[8], gsv[8]; float run = 0.f;
#pragma unroll
        for (int i = 0; i < 8; ++i) { const float sg_ = sigm(bf2f(nf[i])); const float f = lb + omlb * sg_; run += __logf(f); bl[i] = run; kv[i] = omlb * (1.0f - sg_); qv[i] = bf2f(nq[i]); }
#pragma unroll
        for (int i = 0; i < 8; ++i) { const float gg = bf2f(ng[i]); gsv[i] = gg * sigm(gg) * ngv; }
        seg[sg * 128 + c] = run;
        { u32x4 wv; wv.x = nv[0] | ((unsigned)nv[1] << 16); wv.y = nv[2] | ((unsigned)nv[3] << 16); wv.z = nv[4] | ((unsigned)nv[5] << 16); wv.w = nv[6] | ((unsigned)nv[7] << 16);
          *(u32x4*)(vT + c * 40 + sg * 8) = wv; *(u32x4*)(gVT + c * 32 + sg * 8) = wv; }
        lds_barrier();
        {
            const float s0 = seg[c], s1 = seg[128 + c], s2 = seg[256 + c], s3 = seg[384 + c];
            const float off = (sg > 0 ? s0 : 0.f) + (sg > 1 ? s1 : 0.f) + (sg > 2 ? s2 : 0.f), btot = (s0 + s1) + (s2 + s3);
            float kd[8];
#pragma unroll
            for (int i = 0; i < 8; ++i) { const float bt = off + bl[i]; const unsigned short qb = f2bf(qv[i] * __expf(bt));
                qs[(8 * sg + i) * 136 + c] = qb; gQS[(8 * sg + i) * 128 + c] = qb; ks[(8 * sg + i) * 136 + c] = f2bf(kv[i] * __expf(fminf(-bt, 80.0f)));        kd[i] = kv[i] * __expf(btot - bt); }
            *(bf16x8*)(gKDT + c * 32 + sg * 8) = pack8(kd[0], kd[1], kd[2], kd[3], kd[4], kd[5], kd[6], kd[7]);
            if (sg == 0) gEL[c] = __expf(btot);
        }
        lds_barrier();
        if (w < 3) {
            const int tt = (w + 1) >> 1, st = (w == 2) ? 1 : 0;
            f32x4 aa = {0.f, 0.f, 0.f, 0.f};
#pragma unroll
            for (int kk = 0; kk < 4; ++kk) { const bf16x8 a = *(const bf16x8*)(qs + (16 * tt + fr) * 136 + 32 * kk + 8 * fq); const bf16x8 bb = *(const bf16x8*)(ks + (16 * st + fr) * 136 + 32 * kk + 8 * fq); aa = MFMA16(a, bb, aa); }
#pragma unroll
            for (int j = 0; j < 4; ++j) { const int t = 16 * tt + 4 * fq + j, s = 16 * st + fr; att[t * 40 + s] = f2bf(s <= t ? aa[j] : 0.f); }
        } else if (w == 3) {
#pragma unroll
            for (int j = 0; j < 4; ++j) att[(4 * fq + j) * 40 + 16 + fr] = 0;
        }
        lds_barrier();
        {
            const bf16x8 bv = *(const bf16x8*)(vT + (16 * w + fr) * 40 + 8 * fq);
#pragma unroll
            for (int tt = 0; tt < 2; ++tt) {
                const bf16x8 a = *(const bf16x8*)(att + (16 * tt + fr) * 40 + 8 * fq);
                const f32x4 oi = MFMA16(a, bv, ((f32x4){0.f, 0.f, 0.f, 0.f}));
                gOI[(w * 2 + tt) * 64 + lane] = oi;
                gGS[(w * 2 + tt) * 64 + lane] = (f32x4){gsv[4 * tt], gsv[4 * tt + 1], gsv[4 * tt + 2], gsv[4 * tt + 3]};
            }
        }
        lds_barrier();
    }
#undef HGP_LOAD
}

__device__ __forceinline__ void hgrn_item(const Params& p, int layer, int bh, unsigned char* smem, int rep) {
    const int tid = opaque_tid(), w = tid >> 6, lane = tid & 63, fr = lane & 15, fq = lane >> 4;
    (void)layer;
    const bf16_t* gQS = (const bf16_t*)(p.ws + OFF_HQS) + (size_t)bh * 128 * 4096 + tid * 8;
    const bf16_t* gKDT = (const bf16_t*)(p.ws + OFF_HKDT) + (size_t)bh * 128 * 4096 + tid * 8;
    const bf16_t* gVT = (const bf16_t*)(p.ws + OFF_HVT) + (size_t)bh * 128 * 4096 + tid * 8;
    const float* gEL = (const float*)(p.ws + OFF_HEL) + (size_t)bh * 128 * 128 + (tid & 31) * 4;
    f32x4* gOI = (f32x4*)((unsigned char*)p.out + OUT_OI) + (size_t)bh * 128 * 1024 + w * 128 + lane;
    f32x4* gOW = rep ? (f32x4*)(p.ws + OFF_GU) + (size_t)bh * 128 * 1024 + w * 128 + lane : gOI;
    const int oq = (tid >> 4) * 136 + (tid & 15) * 8, ok = (tid >> 2) * 40 + (tid & 3) * 8;
    f32x4 S[8];
#pragma unroll
    for (int kt = 0; kt < 8; ++kt) S[kt] = (f32x4){0.f, 0.f, 0.f, 0.f};
    struct Stage { u32x4 q, k, v; f32x4 e, o0, o1; };
    Stage sa, sb;
#define HG_GLOAD(st_, ch_) do { const size_t co_ = (size_t)(ch_) * 4096; st_.q = *(const u32x4*)(gQS + co_); st_.k = *(const u32x4*)(gKDT + co_); st_.v = *(const u32x4*)(gVT + co_); \
        st_.e = *(const f32x4*)(gEL + (size_t)(ch_) * 128); st_.o0 = gOI[(size_t)(ch_) * 1024]; st_.o1 = gOI[(size_t)(ch_) * 1024 + 64]; } while (0)
#define HG_LSTORE(st_, buf_) do { unsigned char* lb_ = smem + (buf_) * 29696; *(u32x4*)((bf16_t*)lb_ + oq) = st_.q; *(u32x4*)((bf16_t*)(lb_ + 8704) + ok) = st_.k; *(u32x4*)((bf16_t*)(lb_ + 18944) + ok) = st_.v; \
        if (tid < 32) *(f32x4*)((float*)(lb_ + 29184) + tid * 4) = st_.e; } while (0)
    f32x4 oc0, oc1;
    HG_GLOAD(sa, 0); HG_LSTORE(sa, 0); oc0 = sa.o0; oc1 = sa.o1;
    HG_GLOAD(sa, 1); HG_GLOAD(sb, 2);
    __syncthreads();
#define HG_BODY(chn_, stn_) do { \
        const int buf_ = (chn_) & 1; const unsigned char* lb_ = smem + buf_ * 29696; \
        const bf16_t* qs_ = (const bf16_t*)lb_; const bf16_t* kdT_ = (const bf16_t*)(lb_ + 8704); const bf16_t* vT_ = (const bf16_t*)(lb_ + 18944); const float* eL_ = (const float*)(lb_ + 29184); \
        f32x4 oacc0 = oc0, oacc1 = oc1; \
        u32x4 qa0[4], qa1[4]; bf16x8 ka[4], kb[4]; f32x4 e4[4], e5[4]; \
        _Pragma("unroll") for (int kp = 0; kp < 4; ++kp) { \
            const u32x2 lo0 = *(const u32x2*)(qs_ + fr * 136 + 32 * kp + 4 * fq), hi0 = *(const u32x2*)(qs_ + fr * 136 + 32 * kp + 16 + 4 * fq); qa0[kp].x = lo0.x; qa0[kp].y = lo0.y; qa0[kp].z = hi0.x; qa0[kp].w = hi0.y; \
            const u32x2 lo1 = *(const u32x2*)(qs_ + (16 + fr) * 136 + 32 * kp + 4 * fq), hi1 = *(const u32x2*)(qs_ + (16 + fr) * 136 + 32 * kp + 16 + 4 * fq); qa1[kp].x = lo1.x; qa1[kp].y = lo1.y; qa1[kp].z = hi1.x; qa1[kp].w = hi1.y; } \
        const bf16x8 bv = *(const bf16x8*)(vT_ + (16 * w + fr) * 40 + 8 * fq); \
        _Pragma("unroll") for (int kt = 0; kt < 4; ++kt) { ka[kt] = *(const bf16x8*)(kdT_ + (16 * kt + fr) * 40 + 8 * fq); e4[kt] = *(const f32x4*)(eL_ + 16 * kt + 4 * fq); } \
        _Pragma("unroll") for (int kp = 0; kp < 4; ++kp) { \
            const bf16x8 bS = pack8(S[2 * kp][0], S[2 * kp][1], S[2 * kp][2], S[2 * kp][3], S[2 * kp + 1][0], S[2 * kp + 1][1], S[2 * kp + 1][2], S[2 * kp + 1][3]); \
            oacc0 = MFMA16(__builtin_bit_cast(bf16x8, qa0[kp]), bS, oacc0); oacc1 = MFMA16(__builtin_bit_cast(bf16x8, qa1[kp]), bS, oacc1); } \
        __builtin_amdgcn_sched_barrier(0); \
        _Pragma("unroll") for (int kt = 0; kt < 4; ++kt) { kb[kt] = *(const bf16x8*)(kdT_ + (16 * (kt + 4) + fr) * 40 + 8 * fq); e5[kt] = *(const f32x4*)(eL_ + 16 * (kt + 4) + 4 * fq); } \
        _Pragma("unroll") for (int kt = 0; kt < 4; ++kt) { S[kt] = S[kt] * e4[kt]; S[kt] = MFMA16(ka[kt], bv, S[kt]); } \
        _Pragma("unroll") for (int kt = 0; kt < 4; ++kt) { S[kt + 4] = S[kt + 4] * e5[kt]; S[kt + 4] = MFMA16(kb[kt], bv, S[kt + 4]); } \
        gOW[(size_t)(chn_) * 1024] = oacc0; gOW[(size_t)(chn_) * 1024 + 64] = oacc1; \
        if ((chn_) + 1 < 128) { HG_LSTORE(stn_, buf_ ^ 1); oc0 = stn_.o0; oc1 = stn_.o1; } \
        if ((chn_) + 3 < 128) HG_GLOAD(stn_, (chn_) + 3); \
        asm volatile("s_waitcnt lgkmcnt(0)" ::: "memory"); __builtin_amdgcn_s_barrier(); asm volatile("" ::: "memory"); \
    } while (0)
#pragma unroll 1
    for (int chn = 0; chn < 128; chn += 2) {
        HG_BODY(chn, sa);
        HG_BODY(chn + 1, sb);
    }
#undef HG_BODY
#undef HG_GLOAD
#undef HG_LSTORE
    __syncthreads();
}

__device__ __forceinline__ void hgpost_range(const Params& p, unsigned char* smem) {
    const int tid = opaque_tid(), w = tid >> 6, lane = tid & 63, fr = lane & 15, fq = lane >> 4;
    float* red = (float*)smem;
    bf16_t* Yb = (bf16_t*)(p.ws + OFF_XB);
    int item = blockIdx.x;
    f32x4 o0, o1, g0, g1;
#define HPO_LOAD(item_) do { const f32x4* a_ = (const f32x4*)((unsigned char*)p.out + OUT_OI) + (size_t)(item_) * 1024 + w * 128 + lane; const f32x4* b_ = (const f32x4*)(p.ws + OFF_HGS) + (size_t)(item_) * 1024 + w * 128 + lane; \
        o0 = a_[0]; o1 = a_[64]; g0 = b_[0]; g1 = b_[64]; } while (0)
    if (item < 2048) HPO_LOAD(item);
    int par = 0;
#pragma unroll 1
    for (; item < 2048; item += gridDim.x, par ^= 1) {
        const int bh = item >> 7, chn = item & 127;
        const f32x4 c0 = o0, c1 = o1, h0 = g0, h1 = g1;
        if (item + (int)gridDim.x < 2048) HPO_LOAD(item + (int)gridDim.x);
#pragma unroll
        for (int j = 0; j < 4; ++j) { const float s0 = row16_sum_to15(c0[j] * c0[j]), s1 = row16_sum_to15(c1[j] * c1[j]);
            if (fr == 15) { red[par * 256 + (4 * fq + j) * 8 + w] = s0; red[par * 256 + (16 + 4 * fq + j) * 8 + w] = s1; } }
        lds_barrier();
        bf16_t* Y = Yb + ((size_t)(bh >> 2) * SEQ + chn * 32) * DM + 1536 + (bh & 3) * 128 + 16 * w + fr;
#pragma unroll
        for (int j = 0; j < 4; ++j) {
            { const int t = 4 * fq + j; const f32x4 r0 = *(const f32x4*)(red + par * 256 + t * 8), r1 = *(const f32x4*)(red + par * 256 + t * 8 + 4);
              const float ss = ((r0[0] + r0[1]) + (r0[2] + r0[3])) + ((r1[0] + r1[1]) + (r1[2] + r1[3])); const float rs = rsqrtf(ss * (1.0f / 128.0f) + LN_EPS);
              Y[(size_t)t * DM] = f2bf(c0[j] * rs * h0[j]); }
            { const int t = 16 + 4 * fq + j; const f32x4 r0 = *(const f32x4*)(red + par * 256 + t * 8), r1 = *(const f32x4*)(red + par * 256 + t * 8 + 4);
              const float ss = ((r0[0] + r0[1]) + (r0[2] + r0[3])) + ((r1[0] + r1[1]) + (r1[2] + r1[3])); const float rs = rsqrtf(ss * (1.0f / 128.0f) + LN_EPS);
              Y[(size_t)t * DM] = f2bf(c1[j] * rs * h1[j]); }
        }
    }
#undef HPO_LOAD
    lds_barrier();
}

#define PH_NOINLINE __forceinline__
__device__ PH_NOINLINE void gemm_gu(const bf16_t* A, const bf16_t* Bt, bf16_t* H) {
    extern __shared__ __attribute__((aligned(16))) unsigned char smem[];
    pg8::Gemm g{A, Bt, NTOK, 11264, 2048}; pg8::StaticOrder S; S.init(NTOK, 11264, (int)gridDim.x, (int)blockIdx.x); EpiSwiGLU E{H};
    pg8::gemm_phase((PG8_LAS unsigned char*)smem, g, S, E);
}
__device__ PH_NOINLINE void gemm_res(const bf16_t* A, const bf16_t* Bt, int K, unsigned char* ws, const float* Rraw, float* Oalt, float s) {
    extern __shared__ __attribute__((aligned(16))) unsigned char smem[];
    pg8::Gemm g{A, Bt, NTOK, 2048, K}; pg8::StaticOrder S; S.init(NTOK, 2048, (int)gridDim.x, (int)blockIdx.x); EpiResid E{ws, Rraw, Oalt, s};
    pg8::gemm_phase((PG8_LAS unsigned char*)smem, g, S, E);
}
__device__ PH_NOINLINE void gemm_in(const bf16_t* A, const bf16_t* Bt, bf16_t* O) {
    extern __shared__ __attribute__((aligned(16))) unsigned char smem[];
    pg8::Gemm g{A, Bt, NTOK, 5632, 2048}; pg8::StaticOrder S; S.init(NTOK, 5632, (int)gridDim.x, (int)blockIdx.x); EpiBf16P E{O, DIN};
    pg8::gemm_phase((PG8_LAS unsigned char*)smem, g, S, E);
}
__device__ __forceinline__ void run_phase(const Params& p, int ph, unsigned char* smem, int rep) {
    if (ph == 0) { phase_convert(p, smem); return; }
    const int l = (ph - 1) / 12, k = (ph - 1) % 12;
    bf16_t* XB = (bf16_t*)(p.ws + OFF_XB); bf16_t* H = (bf16_t*)(p.ws + OFF_H); float* X = (float*)(p.ws + OFF_X); float* STATS = (float*)(p.ws + OFF_STATS);
    if (k == 0 || k == 9) {
        const int f = (k == 9);
        gemm_gu(XB, (const bf16_t*)(p.ws + OFF_GU + (size_t)(l * 2 + f) * SZ_GU), H);
    } else if (k == 1 || k == 10) {
        const int f = (k == 10);
        gemm_res(H, (const bf16_t*)(p.ws + OFF_DN + (size_t)(l * 2 + f) * SZ_DN), 5632, p.ws, (l == 0 && f == 0) ? p.in[0] : nullptr, rep ? p.out : nullptr, 0.5f);
    } else if (k == 2 || k == 8 || k == 11) {
        const int i = (k == 2) ? 0 : (k == 8 ? 1 : 2);
        const bool last = (l == 1 && i == 2);
        if (rep) { phase_ln((const bf16_t*)X, nullptr, H, (float*)(p.ws + OFF_HGS), nullptr, p.in[1] + (size_t)(l * 3 + i) * DM, p.in[2] + (size_t)(l * 3 + i) * DM); return; }
        phase_ln((const bf16_t*)X, last ? p.out : nullptr, last ? nullptr : XB, last ? nullptr : STATS, last ? nullptr : (float*)(p.ws + OFF_GB), p.in[1] + (size_t)(l * 3 + i) * DM, p.in[2] + (size_t)(l * 3 + i) * DM);
    } else if (k == 3) {
        gemm_in(XB, (const bf16_t*)(p.ws + OFF_IN + (size_t)l * SZ_IN), H);
    } else if (k == 4) {
#ifndef PROBE_SUB4
#define PROBE_SUB4 0
#endif
        if (rep == 0 || PROBE_SUB4 == 0 || PROBE_SUB4 == 1) hgpre_range(p, l, smem);
        if (rep == 0 || PROBE_SUB4 == 0 || PROBE_SUB4 == 4) rgpre_range(p, l, smem);
        for (int it = blockIdx.x; it < 768; it += gridDim.x) {
            if (it < 256) { if (rep == 0 || PROBE_SUB4 == 0 || PROBE_SUB4 == 2) kvpre_item(p, it, smem); }
            else { if (rep == 0 || PROBE_SUB4 == 0 || PROBE_SUB4 == 3) convc_item(p, l, it - 256, smem); }
        }
    } else if (k == 5) {
        unsigned* ctr = (unsigned*)(p.ws + OFF_CTL) + l * 64 + rep * 128;
        int* s_item = (int*)(smem + LDS_BYTES - 16);
        for (;;) {
            __syncthreads();
            if (threadIdx.x == 0) *s_item = (int)atomicAdd(ctr, 1u);
            __syncthreads();
            const int it = *s_item;
            if (it >= 784) break;
#ifdef PROBE_SUB
            if (rep == 1 && !((PROBE_SUB == 1 && it < 16) || (PROBE_SUB == 2 && it >= 16 && it < 528) || (PROBE_SUB == 3 && it >= 528) || (PROBE_SUB == 4 && it >= 16))) continue;
#endif
            if (it < 16) hgrn_item(p, l, it, smem, rep);
            else if (it < 528) attn_item(p, it - 16, smem);
            else rgpost_item(p, it - 528, smem);
        }
    } else if (k == 6) {
        hgpost_range(p, smem);
    } else if (k == 7) {
        gemm_res(XB, (const bf16_t*)(p.ws + OFF_OUT + (size_t)l * SZ_OUT), 2048, p.ws, nullptr, nullptr, 1.0f);
    }
}

#ifndef MK_N_LAUNCHES
#define MK_N_LAUNCHES 1
#endif

#define XB_TMO      128
#define XB_XCNT(j)  (256  + 64 * (j))
#define XB_XSUB(j)  (1280 + 64 * (j))
#define XB_XGEN(j)  (2304 + 64 * (j))
#define XB_TOP      3328
#define XB_TOPGEN   3392
#define XCD_BAR_WORDS 3456
#define XB_SPIN_CAP (1u << 18)
#define LAS __attribute__((address_space(3)))

__device__ __forceinline__ unsigned xb_ld(unsigned* p)              { return __hip_atomic_load(p, __ATOMIC_RELAXED, __HIP_MEMORY_SCOPE_AGENT); }
__device__ __forceinline__ unsigned xb_add(unsigned* p, unsigned v) { return __hip_atomic_fetch_add(p, v, __ATOMIC_RELAXED, __HIP_MEMORY_SCOPE_AGENT); }
__device__ __forceinline__ unsigned xb_xcc_id() { return (unsigned)__builtin_amdgcn_s_getreg((3 << 11) | 20) & 0xFu; }
#define XB_SPIN(cond, bar) do { unsigned _sp = 0; while (cond) { __builtin_amdgcn_s_sleep(1); \
    if ((++_sp & 255u) == 0u) { if (xb_ld(&(bar)[XB_TMO])) break; if (_sp > XB_SPIN_CAP) { atomicAdd(&(bar)[XB_TMO], 1u); break; } } } } while (0)

struct XcdBarrier {
    unsigned* bar; unsigned x;
    volatile LAS unsigned* st;
};

__device__ __forceinline__ XcdBarrier xcd_barrier_post(unsigned* bar, volatile LAS unsigned* st) {
    XcdBarrier b; b.bar = bar; b.x = xb_xcc_id(); b.st = st;
    if (threadIdx.x == 0) (void)xb_add(&bar[XB_XCNT(b.x)], 1u);
    return b;
}
__device__ __forceinline__ void xcd_barrier_complete(unsigned* bar, unsigned x, unsigned& nloc, unsigned& nx) {
    const unsigned G = gridDim.x * gridDim.y * gridDim.z;
    unsigned sum, cnt, mine, sp = 0u;
    for (;;) {
        sum = 0u; cnt = 0u; mine = 0u;
#pragma unroll
        for (unsigned j = 0; j < 16; ++j) { const unsigned c = xb_ld(&bar[XB_XCNT(j)]); sum += c; cnt += (c > 0u) ? 1u : 0u; mine = (j == x) ? c : mine; }
        if (sum == G) break;
        __builtin_amdgcn_s_sleep(1);
        if ((++sp & 255u) == 0u) { if (xb_ld(&bar[XB_TMO])) break; if (sp > XB_SPIN_CAP) { atomicAdd(&bar[XB_TMO], 1u); break; } }
    }
    nloc = mine > 0u ? mine : 1u; nx = cnt > 0u ? cnt : 1u;
}

__device__ __forceinline__ void xcd_barrier(const XcdBarrier& b) {
    asm volatile("s_waitcnt vmcnt(0)" ::: "memory");
    __syncthreads();
    if (threadIdx.x == 0) {
        unsigned* bar = b.bar;
        __builtin_amdgcn_s_waitcnt(0);
        unsigned nloc = b.st[0], nx = b.st[1];
        if (nloc == 0u) { xcd_barrier_complete(bar, b.x, nloc, nx); b.st[0] = nloc; b.st[1] = nx; }
        const unsigned old = xb_add(&bar[XB_XSUB(b.x)], 1u);
        const unsigned gen = old / nloc;
        if (old + 1u == (gen + 1u) * nloc) {
            __builtin_amdgcn_fence(__ATOMIC_RELEASE, "agent");
            asm volatile("s_waitcnt vmcnt(0)" ::: "memory");
            const unsigned og = xb_add(&bar[XB_TOP], 1u);
            const unsigned tg = og / nx;
            if (og + 1u == (tg + 1u) * nx) xb_add(&bar[XB_TOPGEN], 1u);
            else XB_SPIN(xb_ld(&bar[XB_TOPGEN]) == tg, bar);
            __builtin_amdgcn_fence(__ATOMIC_ACQUIRE, "agent");
            xb_add(&bar[XB_XGEN(b.x)], 1u);
            asm volatile("s_waitcnt vmcnt(0)" ::: "memory");
        } else {
            XB_SPIN(xb_ld(&bar[XB_XGEN(b.x)]) == gen, bar);
            __builtin_amdgcn_fence(__ATOMIC_ACQUIRE, "agent");
            asm volatile("s_waitcnt vmcnt(0)" ::: "memory");
        }
    }
    __syncthreads();
}

#ifndef PROBE_DUP
#define PROBE_DUP -1
#endif

__global__ void __launch_bounds__(512, 2) mega_fwd(Params p) {
    extern __shared__ __attribute__((aligned(16))) unsigned char smem[];
    volatile LAS unsigned* st = (volatile LAS unsigned*)(LAS unsigned char*)(smem + LDS_BYTES - 32);
    if (threadIdx.x == 0) { st[0] = 0u; st[1] = 0u; }
    __syncthreads();
    const XcdBarrier xb = xcd_barrier_post((unsigned*)(p.ws + OFF_CTL) + 1024, st);
    for (int ph = p.ph_lo; ph < p.ph_hi; ++ph) {
        if (ph > p.ph_lo) {
            if (p.ph_lo < 0) cg::this_grid().sync();
            xcd_barrier(xb);
        }
        run_phase(p, ph, smem, 0);
        if (PROBE_DUP >= 0 && (ph == 0 ? PROBE_DUP == 100 : (((ph - 1) % 12) == PROBE_DUP && (PROBE_DUP != 5 || ph > 12)))) {
            xcd_barrier(xb);
            run_phase(p, ph, smem, 1);
        }
    }
}

extern "C" void kernel_launch(void* const* d_in, const int* in_sizes, int n_in, void* d_out, int out_size, void* d_ws, size_t ws_size, hipStream_t stream) {
    static int grid = 0;
    if (grid == 0) {
        if (n_in != 21 || ws_size < WS_END) { fprintf(stderr, "kernel_launch: unexpected n_in %d / ws_size %zu (need %zu)\n", n_in, ws_size, (size_t)WS_END); grid = -1; return; }
        int dev = 0, cus = 0, per_cu = 0;
        (void)hipGetDevice(&dev);
        (void)hipDeviceGetAttribute(&cus, hipDeviceAttributeMultiprocessorCount, dev);
        if (hipFuncSetAttribute((const void*)mega_fwd, hipFuncAttributeMaxDynamicSharedMemorySize, LDS_BYTES) != hipSuccess) { fprintf(stderr, "kernel_launch: hipFuncSetAttribute failed\n"); grid = -1; return; }
        if (hipOccupancyMaxActiveBlocksPerMultiprocessor(&per_cu, (const void*)mega_fwd, 512, LDS_BYTES) != hipSuccess || per_cu < 1) { fprintf(stderr, "kernel_launch: occupancy query says %d\n", per_cu); per_cu = 1; }
        (void)hipGetLastError();
        grid = cus * per_cu;
        fprintf(stderr, "kernel_launch: grid %d (cus %d x %d)\n", grid, cus, per_cu);
    }
    if (grid < 0) return;
    (void)in_sizes; (void)out_size;
    (void)hipMemsetAsync((char*)d_ws + OFF_CTL, 0, CTL_BYTES, stream);
    Params p{};
    for (int i = 0; i < 21; ++i) p.in[i] = (const float*)d_in[i];
    p.out = (float*)d_out; p.ws = (unsigned char*)d_ws;
#if MK_N_LAUNCHES == 1
    p.ph_lo = 0; p.ph_hi = NPHASE;
    void* args[] = {&p};
    hipError_t e = hipLaunchCooperativeKernel((const void*)mega_fwd, dim3(grid), dim3(512), args, LDS_BYTES, stream);
    if (e != hipSuccess) fprintf(stderr, "kernel_launch: cooperative launch failed: %s (grid %d)\n", hipGetErrorString(e), grid);
#else
    for (int ph = 0; ph < NPHASE; ++ph) {
        p.ph_lo = ph; p.ph_hi = ph + 1;
        hipLaunchKernelGGL(mega_fwd, dim3(grid), dim3(512), LDS_BYTES, stream, p);
    }
#endif
}
```

```cpp
#include <hip/hip_runtime.h>
#include <hip/hip_cooperative_groups.h>
#include <cstdio>
#include <cstdint>
namespace cg = cooperative_groups;
namespace pg8 {
#define PG8_LAS __attribute__((address_space(3)))
typedef unsigned short bf16_t;
typedef short bf16x8 __attribute__((ext_vector_type(8)));
typedef float f32x4 __attribute__((ext_vector_type(4)));
typedef unsigned u32x4 __attribute__((ext_vector_type(4)));
constexpr int BM = 256, BK = 64, HALF = 128, HTB = HALF * BK * 2  , STAGE_BYTES = 8 * HTB, NXCD = 8, WGM = 8;

__host__ __device__ __forceinline__ int lds_byte(int r, int c) { const int st = (r >> 4) * 2 + (c >> 5), rr = r & 15, cc = c & 31, ob = rr * 64 + cc * 2; return st * 1024 + (ob ^ (((ob >> 9) & 1) << 5)); }
__host__ __device__ __forceinline__ void stage_rc(int b, int& R, int& C) { const int st = b / 1024, sb = b % 1024, swz = sb ^ (((sb >> 9) & 1) << 5); R = (st >> 1) * 16 + swz / 64; C = (st & 1) * 32 + (swz % 64) / 2; }
__host__ __device__ __forceinline__ int perm32(int rho) { const int n = rho >> 4, i = rho & 15; return 8 * (i >> 2) + 4 * n + (i & 3); }

struct Unit { int pm, pn; };
struct Gemm { const bf16_t* A; const bf16_t* Bt; int M, N, K; };

struct StaticOrder {
    int nM, nN, nwg, G, c;
    __host__ __device__ void init(int M, int N, int G_, int c_) { nM = M / BM; nN = N / BM; nwg = nM * nN; G = G_; c = c_; }
    __host__ __device__ bool next(int i, Unit& u) const {
        const long L = (long)i * G + c; if (L >= nwg) return false;
        int wgid = (int)L; { const int q = nwg / NXCD, r = nwg % NXCD, xcd = wgid % NXCD, off = wgid / NXCD; wgid = (xcd < r ? xcd * (q + 1) : r * (q + 1) + (xcd - r) * q) + off; }
        const int nig = WGM * nN, gid = wgid / nig, fm = gid * WGM, gsz = (nM - fm) < WGM ? (nM - fm) : WGM;
        u.pm = fm + ((wgid % nig) % gsz); u.pn = (wgid % nig) / gsz; return true;
    }
    __device__ __forceinline__ void a_ready(const Unit&) const {}
    __device__ __forceinline__ void done(const Unit&) const {}
};
__device__ __forceinline__ unsigned cvt_pk_bf16(float lo, float hi) { unsigned r; asm volatile("v_cvt_pk_bf16_f32 %0, %1, %2" : "=v"(r) : "v"(lo), "v"(hi)); return r; }
template <class Epi, class Sched>
__device__ __forceinline__ void gemm_phase(PG8_LAS unsigned char* lds, const Gemm g, const Sched& S, const Epi& E) {
    int tid_ = threadIdx.x; asm volatile("" : "+v"(tid_)); const int tid = tid_, wid = __builtin_amdgcn_readfirstlane(tid >> 6), lane = tid & 63, wr = wid >> 2, wc = wid & 3, fr = lane & 15, fq = lane >> 4;
    const int K = g.K, nt = K / BK;
    unsigned voffA[2], voffB[2];
#pragma unroll
    for (int i = 0; i < 2; ++i) { int R, C; stage_rc(tid * 16 + i * 8192, R, C); const int Rb = Epi::PERM ? ((R & ~31) + perm32(R & 31)) : R;
        voffA[i] = (unsigned)(R * K + C) * 2u; voffB[i] = (unsigned)(Rb * K + C) * 2u; }
    const size_t kstep = (size_t)(BK * 2);
    const size_t hstep = (size_t)HALF * K * 2;
    const size_t tstep = 2 * hstep;
    const unsigned ldsw = (unsigned)wid * 1024u;
    const int aoff = lds_byte(wr * 64 + fr, fq * 8), boff = lds_byte(wc * 32 + fr, fq * 8);
#define PG8_SA(b, h) (((b) * 2 + (h)) * HTB)
#define PG8_SB(b, h) ((4 + (b) * 2 + (h)) * HTB)
#define PG8_STAGE(bufoff, gbase, voff) do { _Pragma("unroll") for (int _i = 0; _i < 2; ++_i) \
        __builtin_amdgcn_global_load_lds((const unsigned*)((const char*)(gbase) + (voff)[_i]), (PG8_LAS unsigned*)(lds + (bufoff) + ldsw + _i * 8192), 16, 0, 0); } while (0)
#define PG8_LDA(dst, b, h) do { _Pragma("unroll") for (int m = 0; m < 4; ++m) _Pragma("unroll") for (int k = 0; k < 2; ++k) dst[m][k] = *(const PG8_LAS bf16x8*)(lds + PG8_SA(b, h) + aoff + m * 2048 + k * 1024); } while (0)
#define PG8_LDB(dst, b, h) do { _Pragma("unroll") for (int n = 0; n < 2; ++n) _Pragma("unroll") for (int k = 0; k < 2; ++k) dst[n][k] = *(const PG8_LAS bf16x8*)(lds + PG8_SB(b, h) + boff + n * 2048 + k * 1024); } while (0)
#define PG8_MMA(ai, bj, At, Bt) do { __builtin_amdgcn_s_setprio(1); _Pragma("unroll") for (int m = 0; m < 4; ++m) _Pragma("unroll") for (int n = 0; n < 2; ++n) _Pragma("unroll") for (int k = 0; k < 2; ++k) \
        acc[ai][bj][m][n] = __builtin_amdgcn_mfma_f32_16x16x32_bf16(Bt[n][k], At[m][k], acc[ai][bj][m][n], 0, 0, 0); __builtin_amdgcn_s_setprio(0); } while (0)
#define PG8_WAIT_V(n) asm volatile("s_waitcnt vmcnt(" #n ")" ::: "memory")
#define PG8_WAIT_L(n) asm volatile("s_waitcnt lgkmcnt(" #n ")" ::: "memory")
#define PG8_BAR __builtin_amdgcn_s_barrier()
#define PG8_SCHED __builtin_amdgcn_sched_barrier(0)
    Unit cur, nxt; int ui = 0;
    if (!S.next(0, cur)) return;
    f32x4 acc[2][2][4][2];
#pragma unroll
    for (int a = 0; a < 2; ++a)
#pragma unroll
        for (int b = 0; b < 2; ++b)
#pragma unroll
            for (int m = 0; m < 4; ++m)
#pragma unroll
                for (int n = 0; n < 2; ++n) acc[a][b][m][n] = (f32x4){0.f, 0.f, 0.f, 0.f};
    bf16x8 At[4][2], B0[2][2], B1[2][2];
    const char* cA = (const char*)g.A + (size_t)cur.pm * tstep; const char* cB = (const char*)g.Bt + (size_t)cur.pn * tstep;
    S.a_ready(cur);
    PG8_STAGE(PG8_SB(0, 0), cB, voffB); PG8_STAGE(PG8_SA(0, 0), cA, voffA); PG8_STAGE(PG8_SB(0, 1), cB + hstep, voffB); PG8_STAGE(PG8_SA(0, 1), cA + hstep, voffA);
    if (wr == 1) PG8_BAR;
    PG8_WAIT_V(4); PG8_BAR;
    PG8_STAGE(PG8_SB(1, 0), cB + kstep, voffB); PG8_STAGE(PG8_SA(1, 0), cA + kstep, voffA); PG8_STAGE(PG8_SB(1, 1), cB + hstep + kstep, voffB);
    PG8_WAIT_V(6); PG8_BAR;
    for (;;) {
        const bool has_next = S.next(ui + 1, nxt);
        const char* nA = has_next ? (const char*)g.A + (size_t)nxt.pm * tstep : cA; const char* nB = has_next ? (const char*)g.Bt + (size_t)nxt.pn * tstep : cB;
        for (int t = 0; t < nt; t += 2) {
            const bool last = (t == nt - 2);
            const char* a1 = cA + (size_t)(t + 1) * kstep;
            const char* a2 = last ? nA : cA + (size_t)(t + 2) * kstep; const char* b2 = last ? nB : cB + (size_t)(t + 2) * kstep;
            const char* a3 = a2 + kstep; const char* b3 = b2 + kstep;
            if (last && has_next) S.a_ready(nxt);
            PG8_LDB(B0, 0, 0); PG8_SCHED; PG8_LDA(At, 0, 0); PG8_STAGE(PG8_SA(1, 1), a1 + hstep, voffA);
            PG8_WAIT_L(8); PG8_BAR; PG8_WAIT_L(0); PG8_MMA(0, 0, At, B0); PG8_BAR; PG8_SCHED;
            PG8_LDB(B1, 0, 1); PG8_STAGE(PG8_SB(0, 0), b2, voffB);
            PG8_BAR; PG8_WAIT_L(0); PG8_MMA(0, 1, At, B1); PG8_BAR;
            PG8_LDA(At, 0, 1); PG8_STAGE(PG8_SA(0, 0), a2, voffA);
            PG8_BAR; PG8_WAIT_L(0); PG8_MMA(1, 0, At, B0); PG8_BAR; PG8_SCHED;
            PG8_STAGE(PG8_SB(0, 1), b2 + hstep, voffB);
            PG8_WAIT_V(6); PG8_BAR; PG8_MMA(1, 1, At, B1); PG8_BAR;
            PG8_LDB(B0, 1, 0); PG8_SCHED; PG8_LDA(At, 1, 0); PG8_STAGE(PG8_SA(0, 1), a2 + hstep, voffA);
            PG8_WAIT_L(8); PG8_BAR; PG8_WAIT_L(0); PG8_MMA(0, 0, At, B0); PG8_BAR; PG8_SCHED;
            PG8_LDB(B1, 1, 1); PG8_STAGE(PG8_SB(1, 0), b3, voffB);
            PG8_BAR; PG8_WAIT_L(0); PG8_MMA(0, 1, At, B1); PG8_BAR;
            PG8_LDA(At, 1, 1); PG8_STAGE(PG8_SA(1, 0), a3, voffA);
            PG8_BAR; PG8_WAIT_L(0); PG8_MMA(1, 0, At, B0); PG8_BAR; PG8_SCHED;
            PG8_STAGE(PG8_SB(1, 1), b3 + hstep, voffB);
            PG8_WAIT_V(6); PG8_BAR; PG8_MMA(1, 1, At, B1); PG8_BAR;
        }
        if constexpr (!Epi::AFTER_DRAIN) { E(acc, cur, wr, wc, fr, fq); S.done(cur); }
        if (!has_next) break;
#pragma unroll
        for (int a = 0; a < 2; ++a)
#pragma unroll
            for (int b = 0; b < 2; ++b)
#pragma unroll
                for (int m = 0; m < 4; ++m)
#pragma unroll
                    for (int n = 0; n < 2; ++n) acc[a][b][m][n] = (f32x4){0.f, 0.f, 0.f, 0.f};
        cur = nxt; cA = nA; cB = nB; ++ui;
    }
    PG8_WAIT_V(0);
    if (wr == 0) PG8_BAR;
    PG8_BAR;
    if constexpr (Epi::AFTER_DRAIN) { E.fused(acc, cur, wr, wc, fr, fq, lds, wid, lane); S.done(cur); }
#undef PG8_SA
#undef PG8_SB
#undef PG8_STAGE
#undef PG8_LDA
#undef PG8_LDB
#undef PG8_MMA
#undef PG8_WAIT_V
#undef PG8_WAIT_L
#undef PG8_BAR
#undef PG8_SCHED
}
}

using pg8::bf16_t; using pg8::bf16x8; using pg8::f32x4; using pg8::u32x4; using pg8::cvt_pk_bf16;
typedef unsigned u32x2 __attribute__((ext_vector_type(2)));

constexpr int NTOK = 16384, DM = 2048, DFF = 5632, DIN = 5632, SEQ = 4096;
constexpr float LN_EPS = 1e-5f;
constexpr float ALPHA = 1.41421356237f;
constexpr int LDS_BYTES = 147456;
constexpr int NPHASE = 25;

constexpr size_t SZ_GU = (size_t)11264 * 2048 * 2, SZ_DN = (size_t)2048 * 5632 * 2, SZ_IN = (size_t)5632 * 2048 * 2,
                 SZ_OUT = (size_t)2048 * 2048 * 2, SZ_RG = (size_t)4 * 128 * 128 * 2;
constexpr size_t OFF_CTL = 0, CTL_BYTES = 32768, OFF_GU = CTL_BYTES, OFF_DN = OFF_GU + 4 * SZ_GU, OFF_IN = OFF_DN + 4 * SZ_DN, OFF_OUT = OFF_IN + 2 * SZ_IN,
                 OFF_RGA = OFF_OUT + 2 * SZ_OUT, OFF_RGX = OFF_RGA + 2 * SZ_RG, OFF_X = OFF_RGX + 2 * SZ_RG,
                 OFF_XB = OFF_X + (size_t)NTOK * DM * 4, OFF_H = OFF_XB + (size_t)NTOK * DM * 2,
                 OFF_KMEAN = OFF_H + (size_t)NTOK * DFF * 2, OFF_ATILE = OFF_KMEAN + 131072, OFF_HTILE = OFF_ATILE + 524288,
                 OFF_HQS = OFF_HTILE + 524288, OFF_HKDT = OFF_HQS + 16777216, OFF_HVT = OFF_HKDT + 16777216, OFF_HEL = OFF_HVT + 16777216,
                 OFF_HGS = OFF_HEL + 1048576, OFF_STATS = OFF_HGS + 33554432, OFF_GB = OFF_STATS + 131072, WS_END = OFF_GB + 16384;
constexpr size_t OUT_HLOC = 0, OUT_CUMA = 33554432, OUT_VT = 67108864, OUT_OI = 83886080;

struct Params { const float* in[21]; float* out; unsigned char* ws; int ph_lo, ph_hi; };

__device__ __forceinline__ float bf2f(unsigned short u) { return __uint_as_float(((unsigned)u) << 16); }
__device__ __forceinline__ unsigned short f2bf(float f) { unsigned u = __float_as_uint(f); u += 0x7FFFu + ((u >> 16) & 1u); return (unsigned short)(u >> 16); }
__device__ __forceinline__ float sigm(float x) { return __builtin_amdgcn_rcpf(1.0f + __expf(-x)); }
__device__ __forceinline__ bf16x8 pack8(float a0, float a1, float a2, float a3, float a4, float a5, float a6, float a7) {
    u32x4 w; w.x = cvt_pk_bf16(a0, a1); w.y = cvt_pk_bf16(a2, a3); w.z = cvt_pk_bf16(a4, a5); w.w = cvt_pk_bf16(a6, a7);
    return __builtin_bit_cast(bf16x8, w);
}
__device__ __forceinline__ int opaque_tid() { int t = threadIdx.x; asm volatile("" : "+v"(t)); return t; }
__device__ __forceinline__ float row16_sum_to15(float x) {
    x += __int_as_float(__builtin_amdgcn_update_dpp(0, __float_as_int(x), 0x111, 0xf, 0xf, true));
    x += __int_as_float(__builtin_amdgcn_update_dpp(0, __float_as_int(x), 0x112, 0xf, 0xf, true));
    x += __int_as_float(__builtin_amdgcn_update_dpp(0, __float_as_int(x), 0x114, 0xf, 0xf, true));
    x += __int_as_float(__builtin_amdgcn_update_dpp(0, __float_as_int(x), 0x118, 0xf, 0xf, true));
    return x;
}
__device__ __forceinline__ void lds_barrier() { asm volatile("s_waitcnt lgkmcnt(0)" ::: "memory"); __builtin_amdgcn_s_barrier(); asm volatile("" ::: "memory"); }
__device__ __forceinline__ u32x2 pack4(f32x4 v) { u32x2 w; w.x = cvt_pk_bf16(v[0], v[1]); w.y = cvt_pk_bf16(v[2], v[3]); return w; }
__device__ __forceinline__ f32x4 unpack4(u32x2 w) { return (f32x4){__uint_as_float(w.x << 16), __uint_as_float(w.x & 0xffff0000u), __uint_as_float(w.y << 16), __uint_as_float(w.y & 0xffff0000u)}; }
typedef _Float16 h16x4 __attribute__((ext_vector_type(4)));
__device__ __forceinline__ u32x2 pack4h(f32x4 v) { const h16x4 h = __builtin_convertvector(v, h16x4); return __builtin_bit_cast(u32x2, h); }
__device__ __forceinline__ f32x4 unpack4h(u32x2 w) { return __builtin_convertvector(__builtin_bit_cast(h16x4, w), f32x4); }
#define MFMA16(a, b, c) __builtin_amdgcn_mfma_f32_16x16x32_bf16((a), (b), (c), 0, 0, 0)

struct EpiSwiGLU {
    static constexpr bool PERM = true, AFTER_DRAIN = false;
    bf16_t* H;
    __device__ __forceinline__ void operator()(const f32x4 (&acc)[2][2][4][2], const pg8::Unit& u, int wr, int wc, int fr, int fq) const {
        const int row0 = u.pm * 256 + wr * 64 + fr, col0 = u.pn * 128 + wc * 32 + 8 * fq;
#pragma unroll
        for (int ai = 0; ai < 2; ++ai)
#pragma unroll
            for (int m = 0; m < 4; ++m) {
                bf16_t* rowp = H + (size_t)(row0 + ai * 128 + m * 16) * DFF + col0;
                float hv[8];
#pragma unroll
                for (int n = 0; n < 2; ++n)
#pragma unroll
                    for (int j = 0; j < 4; ++j) { const float g = acc[ai][0][m][n][j], up = acc[ai][1][m][n][j]; hv[n * 4 + j] = g * sigm(g) * up; }
                u32x4 w; w.x = cvt_pk_bf16(hv[0], hv[1]); w.y = cvt_pk_bf16(hv[2], hv[3]); w.z = cvt_pk_bf16(hv[4], hv[5]); w.w = cvt_pk_bf16(hv[6], hv[7]);
                *(u32x4*)rowp = w;
            }
    }
};
struct EpiResid {
    static constexpr bool PERM = true, AFTER_DRAIN = false;
    unsigned char* ws; const float* Rraw; float* Oalt; float s;
    __device__ __forceinline__ void operator()(const f32x4 (&acc)[2][2][4][2], const pg8::Unit& u, int wr, int wc, int fr_, int fq_) const {
        int fr = fr_, fq = fq_; asm volatile("" : "+v"(fr), "+v"(fq));
        const int row0 = u.pm * 256 + wr * 64 + fr, col0 = u.pn * 256 + wc * 32 + 8 * fq;
        const bool ln = (Rraw == nullptr);
        bf16_t* Z = (bf16_t*)(ws + OFF_X);
        const float* st = (const float*)(ws + OFF_STATS); const float* gb = (const float*)(ws + OFF_GB);
        if (ln) {
#pragma unroll
            for (int bj = 0; bj < 2; ++bj) {
                f32x4 gv[2], bv[2];
#pragma unroll
                for (int n = 0; n < 2; ++n) { gv[n] = *(const f32x4*)(gb + col0 + bj * 128 + 4 * n); bv[n] = *(const f32x4*)(gb + DM + col0 + bj * 128 + 4 * n); }
                u32x4 r[2][4]; float mu[2][4], rs[2][4];
#pragma unroll
                for (int ai = 0; ai < 2; ++ai)
#pragma unroll
                    for (int m = 0; m < 4; ++m) { const int row = row0 + ai * 128 + m * 16; const unsigned off = (unsigned)row * DM + (unsigned)(col0 + bj * 128);
                        { const float2 ms = *(const float2*)(st + 2u * (unsigned)row); mu[ai][m] = ms.x; rs[ai][m] = ms.y; }
                        r[ai][m] = *(const u32x4*)(Z + off); }
                asm volatile("" ::: "memory");
#pragma unroll
                for (int ai = 0; ai < 2; ++ai)
#pragma unroll
                    for (int m = 0; m < 4; ++m) { const unsigned off = (unsigned)(row0 + ai * 128 + m * 16) * DM + (unsigned)(col0 + bj * 128);
                        u32x2 lo, hi; lo.x = r[ai][m].x; lo.y = r[ai][m].y; hi.x = r[ai][m].z; hi.y = r[ai][m].w;
                        const f32x4 x0 = (unpack4h(lo) - mu[ai][m]) * rs[ai][m] * gv[0] + bv[0], x1 = (unpack4h(hi) - mu[ai][m]) * rs[ai][m] * gv[1] + bv[1];
                        const u32x2 o0 = pack4h(x0 * ALPHA + acc[ai][bj][m][0] * s), o1 = pack4h(x1 * ALPHA + acc[ai][bj][m][1] * s);
                        u32x4 w; w.x = o0.x; w.y = o0.y; w.z = o1.x; w.w = o1.y; *(u32x4*)(Z + off) = w; }
            }
        } else {
#pragma unroll
            for (int bj = 0; bj < 2; ++bj)
#pragma unroll
                for (int ai = 0; ai < 2; ++ai) {
                    f32x4 r[4][2];
#pragma unroll
                    for (int m = 0; m < 4; ++m) { const size_t off = (size_t)(row0 + ai * 128 + m * 16) * DM + col0 + bj * 128;
#pragma unroll
                        for (int n = 0; n < 2; ++n) r[m][n] = *(const f32x4*)(Rraw + off + 4 * n); }
                    asm volatile("" ::: "memory");
#pragma unroll
                    for (int m = 0; m < 4; ++m) { const size_t off = (size_t)(row0 + ai * 128 + m * 16) * DM + col0 + bj * 128;
                        const u32x2 o0 = pack4h(r[m][0] * ALPHA + acc[ai][bj][m][0] * s), o1 = pack4h(r[m][1] * ALPHA + acc[ai][bj][m][1] * s);
                        u32x4 w; w.x = o0.x; w.y = o0.y; w.z = o1.x; w.w = o1.y; *(u32x4*)(Z + off) = w; }
                }
        }
    }
};
struct EpiBf16P {
    static constexpr bool PERM = true, AFTER_DRAIN = false;
    bf16_t* O; int ldc;
    __device__ __forceinline__ void operator()(const f32x4 (&acc)[2][2][4][2], const pg8::Unit& u, int wr, int wc, int fr, int fq) const {
        const int row0 = u.pm * 256 + wr * 64 + fr, col0 = u.pn * 256 + wc * 32 + 8 * fq;
#pragma unroll
        for (int ai = 0; ai < 2; ++ai)
#pragma unroll
            for (int m = 0; m < 4; ++m) {
                bf16_t* rowp = O + (size_t)(row0 + ai * 128 + m * 16) * ldc + col0;
#pragma unroll
                for (int bj = 0; bj < 2; ++bj) { const f32x4 v0 = acc[ai][bj][m][0], v1 = acc[ai][bj][m][1];
                    u32x4 w; w.x = cvt_pk_bf16(v0[0], v0[1]); w.y = cvt_pk_bf16(v0[2], v0[3]); w.z = cvt_pk_bf16(v1[0], v1[1]); w.w = cvt_pk_bf16(v1[2], v1[3]);
                    *(u32x4*)(rowp + bj * 128) = w; }
            }
    }
};

__device__ __forceinline__ void convT_job(const float* __restrict__ src, bf16_t* __restrict__ dst, int K, int N, int mode, float* t) {
    const int tid = opaque_tid(), ntn = N >> 6, ntiles = (K >> 7) * ntn;
    const int lk = tid >> 4, ln4 = (tid & 15) * 4;
    float4 pv[4];
#define CVT_LOAD(tile_) do { const int k0_ = ((tile_) / ntn) << 7, n0_ = ((tile_) % ntn) << 6; \
        _Pragma("unroll") for (int pp = 0; pp < 4; ++pp) pv[pp] = *(const float4*)(src + (size_t)(k0_ + lk + 32 * pp) * N + n0_ + ln4); } while (0)
    int tile = blockIdx.x;
    if (tile < ntiles) CVT_LOAD(tile);
#pragma unroll 1
    for (; tile < ntiles; tile += gridDim.x) {
        const int k0 = (tile / ntn) << 7, n0 = (tile % ntn) << 6;
#pragma unroll
        for (int pp = 0; pp < 4; ++pp) { const int k = lk + 32 * pp; t[k * 65 + ln4] = pv[pp].x; t[k * 65 + ln4 + 1] = pv[pp].y; t[k * 65 + ln4 + 2] = pv[pp].z; t[k * 65 + ln4 + 3] = pv[pp].w; }
        if (tile + (int)gridDim.x < ntiles) CVT_LOAD(tile + (int)gridDim.x);
        lds_barrier();
        const int n = tid >> 3, k16 = (tid & 7) * 16;
        float v[16];
#pragma unroll
        for (int j = 0; j < 16; ++j) v[j] = t[(k16 + j) * 65 + n];
        const int nn = n0 + n;
        const int row = mode == 0 ? nn : (256 * (nn >> 7) + (nn & 127) + (mode == 2 ? 128 : 0));
        u32x4 w0, w1; w0.x = cvt_pk_bf16(v[0], v[1]); w0.y = cvt_pk_bf16(v[2], v[3]); w0.z = cvt_pk_bf16(v[4], v[5]); w0.w = cvt_pk_bf16(v[6], v[7]);
        w1.x = cvt_pk_bf16(v[8], v[9]); w1.y = cvt_pk_bf16(v[10], v[11]); w1.z = cvt_pk_bf16(v[12], v[13]); w1.w = cvt_pk_bf16(v[14], v[15]);
        bf16_t* d = dst + (size_t)row * K + k0 + k16;
        *(u32x4*)d = w0; *(u32x4*)(d + 8) = w1;
        lds_barrier();
    }
#undef CVT_LOAD
}
__device__ __forceinline__ void phase_convert(const Params& p, unsigned char* smem) {
    float* t = (float*)smem;
    for (int l = 0; l < 2; ++l) {
        for (int f = 0; f < 2; ++f) {
            const size_t wo = (size_t)(l * 2 + f) * 2048 * 5632;
            bf16_t* gu = (bf16_t*)(p.ws + OFF_GU + (size_t)(l * 2 + f) * SZ_GU);
            convT_job(p.in[3] + wo, gu, 2048, 5632, 1, t);
            convT_job(p.in[4] + wo, gu, 2048, 5632, 2, t);
            convT_job(p.in[5] + wo, (bf16_t*)(p.ws + OFF_DN + (size_t)(l * 2 + f) * SZ_DN), 5632, 2048, 0, t);
        }
        convT_job(p.in[6] + (size_t)l * 2048 * 5632, (bf16_t*)(p.ws + OFF_IN + (size_t)l * SZ_IN), 2048, 5632, 0, t);
        convT_job(p.in[7] + (size_t)l * 2048 * 2048, (bf16_t*)(p.ws + OFF_OUT + (size_t)l * SZ_OUT), 2048, 2048, 0, t);
        for (int g = 0; g < 4; ++g) {
            convT_job(p.in[10] + (size_t)(l * 4 + g) * 16384, (bf16_t*)(p.ws + OFF_RGA + (size_t)l * SZ_RG) + g * 16384, 128, 128, 0, t);
            convT_job(p.in[12] + (size_t)(l * 4 + g) * 16384, (bf16_t*)(p.ws + OFF_RGX + (size_t)l * SZ_RG) + g * 16384, 128, 128, 0, t);
        }
    }
    const float4* xs = (const float4*)p.in[0]; u32x2* xd = (u32x2*)(p.ws + OFF_XB);
    const size_t n4 = (size_t)NTOK * DM / 4, gstr = (size_t)gridDim.x * 512;
    size_t i = (size_t)blockIdx.x * 512 + opaque_tid();
    for (; i + 7 * gstr < n4; i += 8 * gstr) {
        float4 v[8];
#pragma unroll
        for (int k = 0; k < 8; ++k) v[k] = xs[i + k * gstr];
#pragma unroll
        for (int k = 0; k < 8; ++k) { u32x2 w; w.x = cvt_pk_bf16(v[k].x, v[k].y); w.y = cvt_pk_bf16(v[k].z, v[k].w); xd[i + k * gstr] = w; }
    }
    for (; i < n4; i += gstr) { const float4 v = xs[i]; u32x2 w; w.x = cvt_pk_bf16(v.x, v.y); w.y = cvt_pk_bf16(v.z, v.w); xd[i] = w; }
}

__device__ __forceinline__ void phase_ln(const bf16_t* zin, float* xout, bf16_t* xb, float* stats, float* gbtab, const float* __restrict__ g, const float* __restrict__ b) {
    const int tid_ln = opaque_tid(); const int wave = tid_ln >> 6, lane = tid_ln & 63;
    if (gbtab && blockIdx.x == 0) { for (int i = tid_ln; i < DM; i += 512) { gbtab[i] = g[i]; gbtab[DM + i] = b[i]; } }
    const int rstep = gridDim.x * 8;
    int row = blockIdx.x * 8 + wave;
    f32x4 gh[4][2], bh[4][2];
#pragma unroll
    for (int i = 0; i < 4; ++i) { const int e0 = (lane + 64 * i) * 8; gh[i][0] = *(const f32x4*)(g + e0); gh[i][1] = *(const f32x4*)(g + e0 + 4); bh[i][0] = *(const f32x4*)(b + e0); bh[i][1] = *(const f32x4*)(b + e0 + 4); }
    u32x4 nv[4];
    if (row < NTOK) { const u32x4* src = (const u32x4*)(zin + (size_t)row * DM);
#pragma unroll
        for (int i = 0; i < 4; ++i) nv[i] = src[lane + 64 * i]; }
#pragma unroll 1
    for (; row < NTOK; row += rstep) {
        f32x4 v[8]; float s = 0.f;
#pragma unroll
        for (int i = 0; i < 4; ++i) { u32x2 lo, hi; lo.x = nv[i].x; lo.y = nv[i].y; hi.x = nv[i].z; hi.y = nv[i].w; v[2 * i] = unpack4h(lo); v[2 * i + 1] = unpack4h(hi); }
#pragma unroll
        for (int i = 0; i < 8; ++i) s += (v[i][0] + v[i][1]) + (v[i][2] + v[i][3]);
        if (row + rstep < NTOK) { const u32x4* src = (const u32x4*)(zin + (size_t)(row + rstep) * DM);
#pragma unroll
            for (int i = 0; i < 4; ++i) nv[i] = src[lane + 64 * i]; }
#pragma unroll
        for (int o = 32; o > 0; o >>= 1) s += __shfl_xor(s, o);
        const float mu = s * (1.0f / DM); float q = 0.f;
#pragma unroll
        for (int i = 0; i < 8; ++i) { const f32x4 d = v[i] - mu; q += (d[0] * d[0] + d[1] * d[1]) + (d[2] * d[2] + d[3] * d[3]); }
#pragma unroll
        for (int o = 32; o > 0; o >>= 1) q += __shfl_xor(q, o);
        const float rstd = rsqrtf(q * (1.0f / DM) + LN_EPS);
        if (stats && lane == 0) { stats[2 * row] = mu; stats[2 * row + 1] = rstd; }
#pragma unroll
        for (int i = 0; i < 4; ++i) {
            const int e0 = (lane + 64 * i) * 8;
            const f32x4 g0 = gh[i][0], g1 = gh[i][1], b0 = bh[i][0], b1 = bh[i][1];
            const f32x4 y0 = (v[2 * i] - mu) * rstd * g0 + b0, y1 = (v[2 * i + 1] - mu) * rstd * g1 + b1;
            if (xout) { *(f32x4*)(xout + (size_t)row * DM + e0) = y0; *(f32x4*)(xout + (size_t)row * DM + e0 + 4) = y1; }
            if (xb) { const u32x2 w0 = pack4(y0), w1 = pack4(y1); u32x4 w; w.x = w0.x; w.y = w0.y; w.z = w1.x; w.w = w1.y; *(u32x4*)(xb + (size_t)row * DM + e0) = w; }
        }
    }
}

__device__ __forceinline__ void kvpre_item(const Params& p, int item, unsigned char* smem) {
    const int tid = opaque_tid(), dgrp = tid & 15, krow = tid >> 4;
    const int bh = item >> 4, j = item & 15, b = bh >> 2, h = bh & 3;
    const bf16_t* P = (const bf16_t*)(p.ws + OFF_H);
    bf16_t* Vt = (bf16_t*)((unsigned char*)p.out + OUT_VT);
    float* red = (float*)smem;
    bf16_t* Vl = (bf16_t*)(smem + 16384);
    const bf16_t* Kb = P + ((size_t)b * SEQ + j * 256 + krow * 8) * DIN + 512 + h * 128 + dgrp * 8;
    u32x4 kr[8], vr[8];
#pragma unroll
    for (int i = 0; i < 8; ++i) { kr[i] = *(const u32x4*)(Kb + (size_t)i * DIN); vr[i] = *(const u32x4*)(Kb + (size_t)i * DIN + 512); }
    float ks[8] = {0.f, 0.f, 0.f, 0.f, 0.f, 0.f, 0.f, 0.f};
#pragma unroll
    for (int i = 0; i < 8; ++i) {
        ks[0] += __uint_as_float(kr[i].x << 16); ks[1] += __uint_as_float(kr[i].x & 0xffff0000u); ks[2] += __uint_as_float(kr[i].y << 16); ks[3] += __uint_as_float(kr[i].y & 0xffff0000u);
        ks[4] += __uint_as_float(kr[i].z << 16); ks[5] += __uint_as_float(kr[i].z & 0xffff0000u); ks[6] += __uint_as_float(kr[i].w << 16); ks[7] += __uint_as_float(kr[i].w & 0xffff0000u);
    }
    *(f32x4*)(red + krow * 128 + dgrp * 8) = (f32x4){ks[0], ks[1], ks[2], ks[3]}; *(f32x4*)(red + krow * 128 + dgrp * 8 + 4) = (f32x4){ks[4], ks[5], ks[6], ks[7]};
#pragma unroll
    for (int e = 0; e < 8; ++e) {
        unsigned hv[8];
#pragma unroll
        for (int i = 0; i < 8; ++i) { const unsigned wsel = (e >> 1) == 0 ? vr[i].x : ((e >> 1) == 1 ? vr[i].y : ((e >> 1) == 2 ? vr[i].z : vr[i].w)); hv[i] = (e & 1) ? (wsel >> 16) : (wsel & 0xffffu); }
        u32x4 wv; wv.x = hv[0] | (hv[1] << 16); wv.y = hv[2] | (hv[3] << 16); wv.z = hv[4] | (hv[5] << 16); wv.w = hv[6] | (hv[7] << 16);
        const int d = dgrp * 8 + e;
        *(u32x4*)(Vl + d * 256 + ((krow ^ dgrp) << 3)) = wv;
    }
    lds_barrier();
    if (tid < 128) { float s = 0.f;
#pragma unroll 8
        for (int r = 0; r < 32; ++r) s += red[r * 128 + tid];
        ((float*)(p.ws + OFF_KMEAN))[((size_t)bh * 16 + j) * 128 + tid] = s * (1.0f / 256.0f); }
#pragma unroll
    for (int r = 0; r < 8; ++r) {
        const int idx = r * 512 + tid, d = idx >> 5, pc = idx & 31, lc = pc ^ ((d >> 3) & 15);
        const u32x4 wv = *(const u32x4*)(Vl + d * 256 + (pc << 3));
        *(u32x4*)(Vt + ((size_t)bh * 128 + d) * SEQ + j * 256 + (lc << 3)) = wv;
    }
    lds_barrier();
}

__device__ __forceinline__ void rgpre_range(const Params& p, int layer, unsigned char* smem) {
    const int tid = opaque_tid(), c = tid & 127, sg = tid >> 7, w = tid >> 6, lane = tid & 63, fr = lane & 15, fq = lane >> 4;
    const bf16_t* P = (const bf16_t*)(p.ws + OFF_H);
    float* xcf = (float*)smem; bf16_t* xcb = (bf16_t*)(smem + 32768); float* aL = (float*)(smem + 50176); float* uL = (float*)(smem + 82944);
    float* segA = (float*)(smem + 115712); float* segH = (float*)(smem + 117760);
    float* HL = (float*)((unsigned char*)p.out + OUT_HLOC); float* CA = (float*)((unsigned char*)p.out + OUT_CUMA);
    bf16x8 Ba[4], Bx[4];
    int g_loaded = -1;
    float cw0 = 0.f, cw1 = 0.f, cw2 = 0.f, cw3 = 0.f, cb = 0.f, ba = 0.f, bx = 0.f, sp = 0.f;
    unsigned short nx[19];
#define RGP_LOAD(item_) do { const int g_ = (item_) & 3, bt_ = (item_) >> 2, b_ = bt_ >> 6, tau_ = bt_ & 63; const bf16_t* Px_ = P + (size_t)b_ * SEQ * DIN + 2048 + g_ * 128 + c; const int tb_ = tau_ * 64 + sg * 16 - 3; \
        _Pragma("unroll") for (int i = 0; i < 19; ++i) { const int pos_ = tb_ + i; nx[i] = pos_ >= 0 ? Px_[(size_t)pos_ * DIN] : (unsigned short)0; } } while (0)
    int item = blockIdx.x;
    if (item < 1024) RGP_LOAD(item);
#pragma unroll 1
    for (; item < 1024; item += gridDim.x) {
        const int g = item & 3, bt = item >> 2, b = bt >> 6, tau = bt & 63;
        const int ch = g * 128 + c;
        if (g != g_loaded) {
            g_loaded = g;
            const bf16_t* Wa = (const bf16_t*)(p.ws + OFF_RGA + (size_t)layer * SZ_RG) + g * 16384;
            const bf16_t* Wx = (const bf16_t*)(p.ws + OFF_RGX + (size_t)layer * SZ_RG) + g * 16384;
#pragma unroll
            for (int kk = 0; kk < 4; ++kk) { Ba[kk] = *(const bf16x8*)(Wa + (16 * w + fr) * 128 + 32 * kk + 8 * fq); Bx[kk] = *(const bf16x8*)(Wx + (16 * w + fr) * 128 + 32 * kk + 8 * fq); }
            const float* cw = p.in[8] + (size_t)layer * 4 * 512 + ch;
            cw0 = cw[0]; cw1 = cw[512]; cw2 = cw[1024]; cw3 = cw[1536]; cb = p.in[9][layer * 512 + ch];
            const int chl = layer * 512 + g * 128 + 16 * w + fr;
            ba = p.in[11][chl]; bx = p.in[13][chl]; { const float e = __expf(-p.in[14][chl]); sp = e < 0.02f ? e * (1.0f - e * (0.5f - e * 0.33333334f)) : __logf(1.0f + e); }
        }
        {
            float xw[19];
#pragma unroll
            for (int i = 0; i < 19; ++i) xw[i] = bf2f(nx[i]);
#pragma unroll
            for (int i = 0; i < 16; ++i) { const float xc = cb + cw0 * xw[i] + cw1 * xw[i + 1] + cw2 * xw[i + 2] + cw3 * xw[i + 3]; const int t = sg * 16 + i; xcf[t * 128 + c] = xc; xcb[t * 136 + c] = f2bf(xc); }
        }
        if (item + (int)gridDim.x < 1024) RGP_LOAD(item + (int)gridDim.x);
        lds_barrier();
        {
            const int col = 16 * w + fr;
#pragma unroll
            for (int tt = 0; tt < 4; ++tt) {
                f32x4 aa = {0.f, 0.f, 0.f, 0.f}, ax = {0.f, 0.f, 0.f, 0.f};
#pragma unroll
                for (int kk = 0; kk < 4; ++kk) { const bf16x8 a = *(const bf16x8*)(xcb + (16 * tt + fr) * 136 + 32 * kk + 8 * fq); aa = MFMA16(a, Ba[kk], aa); ax = MFMA16(a, Bx[kk], ax); }
#pragma unroll
                for (int j = 0; j < 4; ++j) {
                    const int t = 16 * tt + 4 * fq + j;
                    const float r = sigm(aa[j] + ba), ii = sigm(ax[j] + bx), la = -8.0f * r * sp, x2 = 2.0f * la;
                    const float av = __expf(la);
                    const float ser = -x2 * (1.0f + x2 * (0.5f + x2 * (0.16666667f + x2 * (0.041666668f + x2 * (0.0083333338f + x2 * 0.0013888889f)))));
                    const float om = x2 > -0.25f ? ser : 1.0f - __expf(x2);
                    const float u = __builtin_amdgcn_sqrtf(fmaxf(om, 0.f)) * (ii * xcf[t * 128 + col]);
                    aL[t * 128 + col] = av; uL[t * 128 + col] = u;
                }
            }
        }
        lds_barrier();
        {
            float hh = 0.f, AA = 1.f;
#pragma unroll
            for (int i = 0; i < 16; ++i) { const int t = sg * 16 + i; const float av = aL[t * 128 + c], u = uL[t * 128 + c]; hh = av * hh + u; AA *= av; uL[t * 128 + c] = hh; aL[t * 128 + c] = AA; }
            segA[sg * 128 + c] = AA; segH[sg * 128 + c] = hh;
        }
        lds_barrier();
        {
            float carry = 0.f, cA = 1.f;
            for (int s2 = 0; s2 < sg; ++s2) { const float a2 = segA[s2 * 128 + c]; carry = a2 * carry + segH[s2 * 128 + c]; cA *= a2; }
            float hl = 0.f, ca = 0.f;
#pragma unroll
            for (int i = 0; i < 16; ++i) {
                const int t = sg * 16 + i; const size_t tok = (size_t)b * SEQ + tau * 64 + t;
                const float al = aL[t * 128 + c]; hl = uL[t * 128 + c] + al * carry; ca = al * cA;
                HL[tok * 512 + ch] = hl; CA[tok * 512 + ch] = ca;
            }
            if (sg == 3) { ((float*)(p.ws + OFF_ATILE))[((size_t)b * 64 + tau) * 512 + ch] = ca; ((float*)(p.ws + OFF_HTILE))[((size_t)b * 64 + tau) * 512 + ch] = hl; }
        }
        lds_barrier();
    }
#undef RGP_LOAD
}

__device__ __forceinline__ void convc_item(const Params& p, int layer, int item, unsigned char* smem) {
    const int tid = opaque_tid(), c = tid, w = tid >> 6, lane = tid & 63;
    const int b = item >> 7, tau = item & 127;
    const bf16_t* P = (const bf16_t*)(p.ws + OFF_H);
    bf16_t* Y = (bf16_t*)(p.ws + OFF_XB);
    bf16_t* glu = (bf16_t*)smem;
    float* ubuf = (float*)(smem + 63488); float* stats = (float*)(smem + 63488 + 65536);
    {
        const bf16_t* Pv = P + (size_t)b * SEQ * DIN + 2560;
        u32x4 va[8], ga[8];
#pragma unroll
        for (int r = 0; r < 8; ++r) { const int slot = r * 512 + tid, row = slot >> 6, c8 = (slot & 63) * 8, pos = tau * 32 - 30 + row;
            if (row < 62 && pos >= 0) { const bf16_t* q = Pv + (size_t)pos * DIN + c8; va[r] = *(const u32x4*)q; ga[r] = *(const u32x4*)(q + 512); }
            else { va[r] = (u32x4){0u, 0u, 0u, 0u}; ga[r] = (u32x4){0u, 0u, 0u, 0u}; } }
#pragma unroll
        for (int r = 0; r < 8; ++r) { const int slot = r * 512 + tid, row = slot >> 6, c8 = (slot & 63) * 8;
            if (row < 62) {
                float o[8];
                const unsigned vw[4] = {va[r].x, va[r].y, va[r].z, va[r].w}, gw_[4] = {ga[r].x, ga[r].y, ga[r].z, ga[r].w};
#pragma unroll
                for (int e = 0; e < 4; ++e) { o[2 * e] = __uint_as_float(vw[e] << 16) * sigm(__uint_as_float(gw_[e] << 16)); o[2 * e + 1] = __uint_as_float(vw[e] & 0xffff0000u) * sigm(__uint_as_float(gw_[e] & 0xffff0000u)); }
                *(bf16x8*)(glu + row * 512 + c8) = pack8(o[0], o[1], o[2], o[3], o[4], o[5], o[6], o[7]); } }
    }
    float wk[31];
#pragma unroll
    for (int k = 0; k < 31; ++k) wk[k] = p.in[15][(size_t)layer * 31 * 512 + k * 512 + c];
    const float cb = p.in[16][layer * 512 + c];
    lds_barrier();
    float gw[38];
#pragma unroll
    for (int i = 0; i < 30; ++i) gw[i] = bf2f(glu[i * 512 + c]);
#pragma unroll 1
    for (int tg = 0; tg < 4; ++tg) {
#pragma unroll
        for (int i = 0; i < 8; ++i) gw[30 + i] = bf2f(glu[(30 + tg * 8 + i) * 512 + c]);
#pragma unroll
        for (int o = 0; o < 8; ++o) { float acc = cb;
#pragma unroll
            for (int k = 0; k < 31; ++k) acc += wk[k] * gw[o + k];
            ubuf[(tg * 8 + o) * 512 + c] = acc; }
#pragma unroll
        for (int i = 0; i < 30; ++i) gw[i] = gw[i + 8];
    }
    lds_barrier();
#pragma unroll 1
    for (int i = 0; i < 16; ++i) {
        const int pr = w * 16 + i, t = pr >> 2, grp = pr & 3;
        const float v0 = ubuf[t * 512 + grp * 128 + lane], v1 = ubuf[t * 512 + grp * 128 + 64 + lane];
        float s = v0 + v1;
#pragma unroll
        for (int o = 32; o > 0; o >>= 1) s += __shfl_xor(s, o);
        const float mu = s * (1.0f / 128.0f), d0 = v0 - mu, d1 = v1 - mu; float q = d0 * d0 + d1 * d1;
#pragma unroll
        for (int o = 32; o > 0; o >>= 1) q += __shfl_xor(q, o);
        if (lane == 0) { stats[(t * 4 + grp) * 2] = mu; stats[(t * 4 + grp) * 2 + 1] = rsqrtf(q * (1.0f / 128.0f) + LN_EPS); }
    }
    lds_barrier();
    {
        const float ng = p.in[17][layer * 512 + c], nb = p.in[18][layer * 512 + c]; const int grp = c >> 7;
#pragma unroll 8
        for (int t = 0; t < 32; ++t) {
            const float mu = stats[(t * 4 + grp) * 2], rs = stats[(t * 4 + grp) * 2 + 1];
            const float z = (ubuf[t * 512 + c] - mu) * rs * ng + nb;
            Y[((size_t)b * SEQ + tau * 32 + t) * DM + 1024 + c] = f2bf(z * sigm(z));
        }
    }
    lds_barrier();
}

__device__ __forceinline__ void rgpost_item(const Params& p, int item, unsigned char* smem) {
    const int tid = opaque_tid(), c4 = (tid & 127) * 4, sg = tid >> 7, b = item >> 6, tau = item & 63;
    const bf16_t* P = (const bf16_t*)(p.ws + OFF_H);
    bf16_t* Y = (bf16_t*)(p.ws + OFF_XB);
    const float* AT = (const float*)(p.ws + OFF_ATILE) + (size_t)b * 64 * 512 + c4; const float* HT = (const float*)(p.ws + OFF_HTILE) + (size_t)b * 64 * 512 + c4;
    const float* HL = (const float*)((unsigned char*)p.out + OUT_HLOC); const float* CA = (const float*)((unsigned char*)p.out + OUT_CUMA);
    f32x4 pa = {1.f, 1.f, 1.f, 1.f}, ph = {0.f, 0.f, 0.f, 0.f};
    {
        const int sbeg = sg * 16, send = tau < sbeg + 16 ? tau : sbeg + 16;
#pragma unroll 1
        for (int s0 = sbeg; s0 < send; s0 += 8) {
            f32x4 av[8], hv[8];
#pragma unroll
            for (int i = 0; i < 8; ++i) { const bool ok = s0 + i < send; av[i] = ok ? *(const f32x4*)(AT + (s0 + i) * 512) : (f32x4){1.f, 1.f, 1.f, 1.f}; hv[i] = ok ? *(const f32x4*)(HT + (s0 + i) * 512) : (f32x4){0.f, 0.f, 0.f, 0.f}; }
#pragma unroll
            for (int i = 0; i < 8; ++i) { ph = av[i] * ph + hv[i]; pa = pa * av[i]; }
        }
    }
    f32x4* cs = (f32x4*)smem;
    cs[(sg * 128 + (tid & 127)) * 2] = pa; cs[(sg * 128 + (tid & 127)) * 2 + 1] = ph;
    lds_barrier();
    f32x4 carry = {0.f, 0.f, 0.f, 0.f};
#pragma unroll
    for (int q = 0; q < 4; ++q) { const f32x4 a = cs[(q * 128 + (tid & 127)) * 2], hq = cs[(q * 128 + (tid & 127)) * 2 + 1]; carry = a * carry + hq; }
    lds_barrier();
    const size_t tok0 = (size_t)b * SEQ + tau * 64 + sg * 16;
#pragma unroll 1
    for (int t0 = 0; t0 < 16; t0 += 8) {
        f32x4 hl[8], ca[8]; u32x2 gt[8];
#pragma unroll
        for (int i = 0; i < 8; ++i) { const size_t tok = tok0 + t0 + i; hl[i] = *(const f32x4*)(HL + tok * 512 + c4); ca[i] = *(const f32x4*)(CA + tok * 512 + c4); gt[i] = *(const u32x2*)(P + tok * DIN + 1536 + c4); }
#pragma unroll
        for (int i = 0; i < 8; ++i) {
            const f32x4 hv = hl[i] + ca[i] * carry;
            float x[4] = {__uint_as_float(gt[i].x << 16), __uint_as_float(gt[i].x & 0xffff0000u), __uint_as_float(gt[i].y << 16), __uint_as_float(gt[i].y & 0xffff0000u)};
            float y[4];
#pragma unroll
            for (int e = 0; e < 4; ++e) { const float u = 0.7978845608f * (x[e] + 0.044715f * x[e] * x[e] * x[e]); const float th = 1.0f - 2.0f * __builtin_amdgcn_rcpf(__expf(2.0f * u) + 1.0f); y[e] = hv[e] * 0.5f * x[e] * (1.0f + th); }
            u32x2 w2; w2.x = cvt_pk_bf16(y[0], y[1]); w2.y = cvt_pk_bf16(y[2], y[3]);
            *(u32x2*)(Y + (tok0 + t0 + i) * DM + 512 + c4) = w2;
        }
    }
}

__device__ __forceinline__ void attn_item(const Params& p, int item, unsigned char* smem) {
    const int tid = opaque_tid(), w = tid >> 6, lane = tid & 63, fr = lane & 15, fq = lane >> 4;
    const int qt = 31 - (item >> 4), bh = item & 15, b = bh >> 2, h = bh & 3;
    const int blk = qt >> 1, o = (qt & 1) * 128, q0 = blk * 256 + o;
    const bf16_t* P = (const bf16_t*)(p.ws + OFF_H);
    const bf16_t* Vt = (const bf16_t*)((unsigned char*)p.out + OUT_VT) + (size_t)bh * 128 * SEQ;
    const float* kmean = (const float*)(p.ws + OFF_KMEAN) + (size_t)bh * 16 * 128;
    bf16_t* Y = (bf16_t*)(p.ws + OFF_XB);
    bf16_t* Ks = (bf16_t*)smem; bf16_t* Vs = (bf16_t*)(smem + 34816);
    float* kms = (float*)(smem + 71680); float* gts = (float*)(smem + 79872);
    unsigned* sels = (unsigned*)(smem + 88576); int* tiles = (int*)(smem + 89088); unsigned* um = (unsigned*)(smem + 89344);
    const bf16_t* Pb = P + (size_t)b * SEQ * DIN;

    bf16x8 Qf[4];
    { const bf16_t* qrow = Pb + (size_t)(q0 + 16 * w + fr) * DIN + h * 128;
#pragma unroll
      for (int kk = 0; kk < 4; ++kk) Qf[kk] = *(const bf16x8*)(qrow + 32 * kk + 8 * fq); }
    for (int i = tid; i < blk * 128; i += 512) kms[i] = kmean[i];
    if (tid == 0) um[0] = 0u;
    lds_barrier();
    {
        const int qi = tid & 127, jg = tid >> 7;
        float g4[4] = {0.f, 0.f, 0.f, 0.f};
        if (jg * 4 < blk) {
            const bf16_t* qr = Pb + (size_t)(q0 + qi) * DIN + h * 128;
#pragma unroll 1
            for (int ch = 0; ch < 2; ++ch) {
            u32x4 qraw[8];
#pragma unroll
            for (int c8 = 0; c8 < 8; ++c8) qraw[c8] = *(const u32x4*)(qr + 64 * ch + 8 * c8);
#pragma unroll
            for (int c8 = 0; c8 < 8; ++c8) {
                const int cc = ch * 8 + c8;
                const u32x4 raw = qraw[c8];
                float qv[8];
                qv[0] = __uint_as_float(raw.x << 16); qv[1] = __uint_as_float(raw.x & 0xffff0000u); qv[2] = __uint_as_float(raw.y << 16); qv[3] = __uint_as_float(raw.y & 0xffff0000u);
                qv[4] = __uint_as_float(raw.z << 16); qv[5] = __uint_as_float(raw.z & 0xffff0000u); qv[6] = __uint_as_float(raw.w << 16); qv[7] = __uint_as_float(raw.w & 0xffff0000u);
#pragma unroll
                for (int jj = 0; jj < 4; ++jj) { const int j = jg * 4 + jj; if (j < blk) { const float* km = kms + j * 128 + 8 * cc;
#pragma unroll
                    for (int e = 0; e < 8; ++e) g4[jj] += qv[e] * km[e]; } }
            }
            }
        }
#pragma unroll
        for (int jj = 0; jj < 4; ++jj) gts[qi * 17 + jg * 4 + jj] = g4[jj];
    }
    lds_barrier();
    if (tid < 128) {
        unsigned m = 0u; const int nsel = blk < 3 ? blk : 3;
        for (int s = 0; s < nsel; ++s) { float best = -3.0e38f; int bi = 0;
            for (int j = 0; j < blk; ++j) { const float v = gts[tid * 17 + j]; if (!((m >> j) & 1u) && v > best) { best = v; bi = j; } }
            m |= 1u << bi; }
        sels[tid] = m; if (m) atomicOr(um, m);
    }
    lds_barrier();
    if (tid == 0) { int n = 0; const unsigned u0 = um[0];
        for (int t = 0; t < o / 64 + 2; ++t) tiles[n++] = blk * 256 + t * 64;
        for (int j = 0; j < blk; ++j) if ((u0 >> j) & 1u) for (int t = 0; t < 4; ++t) tiles[n++] = j * 256 + t * 64;
        um[1] = (unsigned)n; }
    lds_barrier();
    const unsigned msel = sels[16 * w + fr]; const int ntiles = (int)um[1];
    const int qpos = q0 + 16 * w + fr;
    const float SC = 0.12751743f;

    f32x4 oacc[8];
#pragma unroll
    for (int dt = 0; dt < 8; ++dt) oacc[dt] = (f32x4){0.f, 0.f, 0.f, 0.f};
    float m_run = -1.0e30f, l_run = 0.f;
    struct KVStage { u32x4 k0, k1, v0, v1; };
    KVStage s0, s1, s2;
    const int lr = tid >> 3, lc = (tid & 7) * 16, vr = tid >> 2, vc = (tid & 3) * 16;
    const int lrp = (lr & 32) + ((lr >> 2) & 1) * 16 + ((lr >> 3) & 3) * 4 + (lr & 3);
#define ATT_GLOAD(st_, kpos_) do { const bf16_t* kp_ = Pb + (size_t)((kpos_) + lr) * DIN + 512 + h * 128 + lc; st_.k0 = *(const u32x4*)kp_; st_.k1 = *(const u32x4*)(kp_ + 8); \
        const bf16_t* vp_ = Vt + (size_t)vr * SEQ + (kpos_) + vc; st_.v0 = *(const u32x4*)vp_; st_.v1 = *(const u32x4*)(vp_ + 8); } while (0)
#define ATT_LSTORE(st_, buf_) do { bf16_t* kd_ = Ks + (buf_) * 8704 + lrp * 136 + lc; *(u32x4*)kd_ = st_.k0; *(u32x4*)(kd_ + 8) = st_.k1; \
        bf16_t* vd_ = Vs + (buf_) * 9216 + vr * 72 + vc; *(u32x4*)vd_ = st_.v0; *(u32x4*)(vd_ + 8) = st_.v1; } while (0)
    ATT_GLOAD(s0, tiles[0]); ATT_LSTORE(s0, 0);
    if (1 < ntiles) ATT_GLOAD(s1, tiles[1]);
    if (2 < ntiles) ATT_GLOAD(s2, tiles[2]);
    if (3 < ntiles) ATT_GLOAD(s0, tiles[3]);
    lds_barrier();
#define ATT_BODY(it_, stn_) do { \
        const int buf = (it_) & 1, kpos = tiles[(it_)]; \
        const bf16_t* Kb = Ks + buf * 8704; const bf16_t* Vb = Vs + buf * 9216; \
        const bool own = kpos >= blk * 256; const bool selok = (msel >> (kpos >> 8)) & 1u; \
        if (own ? (kpos <= q0 + 16 * w + 15) : __any(selok)) {        \
        f32x4 sacc[4]; \
        _Pragma("unroll") for (int T = 0; T < 4; ++T) { \
            const int krow = 32 * (T >> 1) + 16 * (T & 1) + fr; \
            sacc[T] = (f32x4){0.f, 0.f, 0.f, 0.f}; \
            _Pragma("unroll") for (int kk = 0; kk < 4; ++kk) { const bf16x8 a = *(const bf16x8*)(Kb + krow * 136 + 32 * kk + 8 * fq); sacc[T] = MFMA16(a, Qf[kk], sacc[T]); } \
        } \
        float mx = m_run; \
        _Pragma("unroll") for (int T = 0; T < 4; ++T) \
            _Pragma("unroll") for (int j = 0; j < 4; ++j) { const int key = kpos + 32 * (T >> 1) + 8 * fq + 4 * (T & 1) + j; const bool ok = own ? (key <= qpos) : selok; \
                const float sv = ok ? sacc[T][j] * SC : -1.0e30f; sacc[T][j] = sv; mx = fmaxf(mx, sv); } \
        mx = fmaxf(mx, __shfl_xor(mx, 16)); mx = fmaxf(mx, __shfl_xor(mx, 32)); \
        const float al = __builtin_amdgcn_exp2f(m_run - mx); m_run = mx; \
        float ps = 0.f; \
        _Pragma("unroll") for (int T = 0; T < 4; ++T) \
            _Pragma("unroll") for (int j = 0; j < 4; ++j) { const float pv = __builtin_amdgcn_exp2f(sacc[T][j] - mx); sacc[T][j] = pv; ps += pv; } \
        l_run = l_run * al + ps; \
        _Pragma("unroll") for (int dt = 0; dt < 8; ++dt) oacc[dt] *= al; \
        _Pragma("unroll") for (int G = 0; G < 2; ++G) { \
            const bf16x8 pb = pack8(sacc[2 * G][0], sacc[2 * G][1], sacc[2 * G][2], sacc[2 * G][3], sacc[2 * G + 1][0], sacc[2 * G + 1][1], sacc[2 * G + 1][2], sacc[2 * G + 1][3]); \
            _Pragma("unroll") for (int dt = 0; dt < 8; ++dt) { const bf16x8 a = *(const bf16x8*)(Vb + (16 * dt + fr) * 72 + 32 * G + 8 * fq); oacc[dt] = MFMA16(a, pb, oacc[dt]); } \
        } \
        } \
        if ((it_) + 1 < ntiles) ATT_LSTORE(stn_, buf ^ 1); \
        if ((it_) + 4 < ntiles) ATT_GLOAD(stn_, tiles[(it_) + 4]); \
        lds_barrier(); \
    } while (0)
#pragma unroll 1
    for (int it = 0; it < ntiles; it += 3) {
        ATT_BODY(it, s1);
        if (it + 1 >= ntiles) break;
        ATT_BODY(it + 1, s2);
        if (it + 2 >= ntiles) break;
        ATT_BODY(it + 2, s0);
    }
#undef ATT_BODY
#undef ATT_GLOAD
#undef ATT_LSTORE
    float l = l_run + __shfl_xor(l_run, 16); l += __shfl_xor(l, 32);
    const float inv = 1.0f / l;
    bf16_t* yrow = Y + ((size_t)b * SEQ + qpos) * DM + h * 128 + 4 * fq;
#pragma unroll
    for (int dt = 0; dt < 8; ++dt) { u32x2 w2; w2.x = cvt_pk_bf16(oacc[dt][0] * inv, oacc[dt][1] * inv); w2.y = cvt_pk_bf16(oacc[dt][2] * inv, oacc[dt][3] * inv); *(u32x2*)(yrow + 16 * dt) = w2; }
}

__device__ __forceinline__ void hgpre_range(const Params& p, int layer, unsigned char* smem) {
    const int tid = opaque_tid(), c = tid & 127, sg = tid >> 7, w = tid >> 6, lane = tid & 63, fr = lane & 15, fq = lane >> 4;
    const bf16_t* P = (const bf16_t*)(p.ws + OFF_H);
    bf16_t* qs = (bf16_t*)smem; bf16_t* ks = (bf16_t*)(smem + 8704); bf16_t* vT = (bf16_t*)(smem + 17408);
    bf16_t* att = (bf16_t*)(smem + 27648); float* seg = (float*)(smem + 30208);
    bf16_t* raw = (bf16_t*)(smem + 32768);
    const int lrow = tid >> 4, lcol = (tid & 15) * 8;
    u32x4 pq, pf, pv, pg;
#define HGP_LOAD(item_) do { const int bh_ = (item_) >> 7, chn_ = (item_) & 127; const bf16_t* Pq_ = P + ((size_t)(bh_ >> 2) * SEQ + chn_ * 32 + lrow) * DIN + 3584 + (bh_ & 3) * 128 + lcol; \
        pq = *(const u32x4*)Pq_; pf = *(const u32x4*)(Pq_ + 512); pv = *(const u32x4*)(Pq_ + 1024); pg = *(const u32x4*)(Pq_ + 1536); } while (0)
    int item = blockIdx.x;
    if (item < 2048) HGP_LOAD(item);
#pragma unroll 1
    for (; item < 2048; item += gridDim.x) {
        const int bh = item >> 7, chn = item & 127, h = bh & 3;
        const size_t cidx = (size_t)bh * 128 + chn;
        bf16_t* gQS = (bf16_t*)(p.ws + OFF_HQS) + cidx * 4096; bf16_t* gKDT = (bf16_t*)(p.ws + OFF_HKDT) + cidx * 4096; bf16_t* gVT = (bf16_t*)(p.ws + OFF_HVT) + cidx * 4096;
        float* gEL = (float*)(p.ws + OFF_HEL) + cidx * 128;
        f32x4* gOI = (f32x4*)((unsigned char*)p.out + OUT_OI) + cidx * 1024; f32x4* gGS = (f32x4*)(p.ws + OFF_HGS) + cidx * 1024;
        float lb = 0.f;
        if (layer == 1) lb = sigm(p.in[19][512 + h * 128 + c] - p.in[19][h * 128 + c]);
        const float omlb = 1.0f - lb;
        const float ngv = p.in[20][layer * 512 + h * 128 + 16 * w + fr];
        *(u32x4*)(raw + lrow * 128 + lcol) = pq; *(u32x4*)(raw + 4096 + lrow * 128 + lcol) = pf; *(u32x4*)(raw + 8192 + lrow * 128 + lcol) = pv; *(u32x4*)(raw + 12288 + lrow * 128 + lcol) = pg;
        if (item + (int)gridDim.x < 2048) HGP_LOAD(item + (int)gridDim.x);
        lds_barrier();
        unsigned short nq[8], nf[8], nv[8], ng[8];
#pragma unroll
        for (int i = 0; i < 8; ++i) { const int o_ = (8 * sg + i) * 128 + c; nq[i] = raw[o_]; nf[i] = raw[4096 + o_]; nv[i] = raw[8192 + o_]; }
#pragma unroll
        for (int i = 0; i < 8; ++i) ng[i] = raw[12288 + (16 * (i >> 2) + 4 * fq + (i & 3)) * 128 + 16 * w + fr];
        float qv[8], kv[8], bl[8], gsv[8]; float run = 0.f;
#pragma unroll
        for (int i = 0; i < 8; ++i) { const float sg_ = sigm(bf2f(nf[i])); const float f = lb + omlb * sg_; run += __logf(f); bl[i] = run; kv[i] = omlb * (1.0f - sg_); qv[i] = bf2f(nq[i]); }
#pragma unroll
        for (int i = 0; i < 8; ++i) { const float gg = bf2f(ng[i]); gsv[i] = gg * sigm(gg) * ngv; }
        seg[sg * 128 + c] = run;
        { u32x4 wv; wv.x = nv[0] | ((unsigned)nv[1] << 16); wv.y = nv[2] | ((unsigned)nv[3] << 16); wv.z = nv[4] | ((unsigned)nv[5] << 16); wv.w = nv[6] | ((unsigned)nv[7] << 16);
          *(u32x4*)(vT + c * 40 + sg * 8) = wv; *(u32x4*)(gVT + c * 32 + sg * 8) = wv; }
        lds_barrier();
        {
            const float s0 = seg[c], s1 = seg[128 + c], s2 = seg[256 + c], s3 = seg[384 + c];
            const float off = (sg > 0 ? s0 : 0.f) + (sg > 1 ? s1 : 0.f) + (sg > 2 ? s2 : 0.f), btot = (s0 + s1) + (s2 + s3);
            float kd[8];
#pragma unroll
            for (int i = 0; i < 8; ++i) { const float bt = off + bl[i]; const unsigned short qb = f2bf(qv[i] * __expf(bt));
                qs[(8 * sg + i) * 136 + c] = qb; gQS[(8 * sg + i) * 128 + c] = qb; ks[(8 * sg + i) * 136 + c] = f2bf(kv[i] * __expf(fminf(-bt, 80.0f)));        kd[i] = kv[i] * __expf(btot - bt); }
            *(bf16x8*)(gKDT + c * 32 + sg * 8) = pack8(kd[0], kd[1], kd[2], kd[3], kd[4], kd[5], kd[6], kd[7]);
            if (sg == 0) gEL[c] = __expf(btot);
        }
        lds_barrier();
        if (w < 3) {
            const int tt = (w + 1) >> 1, st = (w == 2) ? 1 : 0;
            f32x4 aa = {0.f, 0.f, 0.f, 0.f};
#pragma unroll
            for (int kk = 0; kk < 4; ++kk) { const bf16x8 a = *(const bf16x8*)(qs + (16 * tt + fr) * 136 + 32 * kk + 8 * fq); const bf16x8 bb = *(const bf16x8*)(ks + (16 * st + fr) * 136 + 32 * kk + 8 * fq); aa = MFMA16(a, bb, aa); }
#pragma unroll
            for (int j = 0; j < 4; ++j) { const int t = 16 * tt + 4 * fq + j, s = 16 * st + fr; att[t * 40 + s] = f2bf(s <= t ? aa[j] : 0.f); }
        } else if (w == 3) {
#pragma unroll
            for (int j = 0; j < 4; ++j) att[(4 * fq + j) * 40 + 16 + fr] = 0;
        }
        lds_barrier();
        {
            const bf16x8 bv = *(const bf16x8*)(vT + (16 * w + fr) * 40 + 8 * fq);
#pragma unroll
            for (int tt = 0; tt < 2; ++tt) {
                const bf16x8 a = *(const bf16x8*)(att + (16 * tt + fr) * 40 + 8 * fq);
                const f32x4 oi = MFMA16(a, bv, ((f32x4){0.f, 0.f, 0.f, 0.f}));
                gOI[(w * 2 + tt) * 64 + lane] = oi;
                gGS[(w * 2 + tt) * 64 + lane] = (f32x4){gsv[4 * tt], gsv[4 * tt + 1], gsv[4 * tt + 2], gsv[4 * tt + 3]};
            }
        }
        lds_barrier();
    }
#undef HGP_LOAD
}

__device__ __forceinline__ void hgrn_item(const Params& p, int layer, int bh, unsigned char* smem, int rep) {
    const int tid = opaque_tid(), w = tid >> 6, lane = tid & 63, fr = lane & 15, fq = lane >> 4;
    (void)layer;
    const bf16_t* gQS = (const bf16_t*)(p.ws + OFF_HQS) + (size_t)bh * 128 * 4096 + tid * 8;
    const bf16_t* gKDT = (const bf16_t*)(p.ws + OFF_HKDT) + (size_t)bh * 128 * 4096 + tid * 8;
    const bf16_t* gVT = (const bf16_t*)(p.ws + OFF_HVT) + (size_t)bh * 128 * 4096 + tid * 8;
    const float* gEL = (const float*)(p.ws + OFF_HEL) + (size_t)bh * 128 * 128 + (tid & 31) * 4;
    f32x4* gOI = (f32x4*)((unsigned char*)p.out + OUT_OI) + (size_t)bh * 128 * 1024 + w * 128 + lane;
    f32x4* gOW = rep ? (f32x4*)(p.ws + OFF_GU) + (size_t)bh * 128 * 1024 + w * 128 + lane : gOI;
    const int oq = (tid >> 4) * 136 + (tid & 15) * 8, ok = (tid >> 2) * 40 + (tid & 3) * 8;
    f32x4 S[8];
#pragma unroll
    for (int kt = 0; kt < 8; ++kt) S[kt] = (f32x4){0.f, 0.f, 0.f, 0.f};
    struct Stage { u32x4 q, k, v; f32x4 e, o0, o1; };
    Stage sa, sb;
#define HG_GLOAD(st_, ch_) do { const size_t co_ = (size_t)(ch_) * 4096; st_.q = *(const u32x4*)(gQS + co_); st_.k = *(const u32x4*)(gKDT + co_); st_.v = *(const u32x4*)(gVT + co_); \
        st_.e = *(const f32x4*)(gEL + (size_t)(ch_) * 128); st_.o0 = gOI[(size_t)(ch_) * 1024]; st_.o1 = gOI[(size_t)(ch_) * 1024 + 64]; } while (0)
#define HG_LSTORE(st_, buf_) do { unsigned char* lb_ = smem + (buf_) * 29696; *(u32x4*)((bf16_t*)lb_ + oq) = st_.q; *(u32x4*)((bf16_t*)(lb_ + 8704) + ok) = st_.k; *(u32x4*)((bf16_t*)(lb_ + 18944) + ok) = st_.v; \
        if (tid < 32) *(f32x4*)((float*)(lb_ + 29184) + tid * 4) = st_.e; } while (0)
    f32x4 oc0, oc1;
    HG_GLOAD(sa, 0); HG_LSTORE(sa, 0); oc0 = sa.o0; oc1 = sa.o1;
    HG_GLOAD(sa, 1); HG_GLOAD(sb, 2);
    __syncthreads();
#define HG_BODY(chn_, stn_) do { \
        const int buf_ = (chn_) & 1; const unsigned char* lb_ = smem + buf_ * 29696; \
        const bf16_t* qs_ = (const bf16_t*)lb_; const bf16_t* kdT_ = (const bf16_t*)(lb_ + 8704); const bf16_t* vT_ = (const bf16_t*)(lb_ + 18944); const float* eL_ = (const float*)(lb_ + 29184); \
        f32x4 oacc0 = oc0, oacc1 = oc1; \
        u32x4 qa0[4], qa1[4]; bf16x8 ka[4], kb[4]; f32x4 e4[4], e5[4]; \
        _Pragma("unroll") for (int kp = 0; kp < 4; ++kp) { \
            const u32x2 lo0 = *(const u32x2*)(qs_ + fr * 136 + 32 * kp + 4 * fq), hi0 = *(const u32x2*)(qs_ + fr * 136 + 32 * kp + 16 + 4 * fq); qa0[kp].x = lo0.x; qa0[kp].y = lo0.y; qa0[kp].z = hi0.x; qa0[kp].w = hi0.y; \
            const u32x2 lo1 = *(const u32x2*)(qs_ + (16 + fr) * 136 + 32 * kp + 4 * fq), hi1 = *(const u32x2*)(qs_ + (16 + fr) * 136 + 32 * kp + 16 + 4 * fq); qa1[kp].x = lo1.x; qa1[kp].y = lo1.y; qa1[kp].z = hi1.x; qa1[kp].w = hi1.y; } \
        const bf16x8 bv = *(const bf16x8*)(vT_ + (16 * w + fr) * 40 + 8 * fq); \
        _Pragma("unroll") for (int kt = 0; kt < 4; ++kt) { ka[kt] = *(const bf16x8*)(kdT_ + (16 * kt + fr) * 40 + 8 * fq); e4[kt] = *(const f32x4*)(eL_ + 16 * kt + 4 * fq); } \
        _Pragma("unroll") for (int kp = 0; kp < 4; ++kp) { \
            const bf16x8 bS = pack8(S[2 * kp][0], S[2 * kp][1], S[2 * kp][2], S[2 * kp][3], S[2 * kp + 1][0], S[2 * kp + 1][1], S[2 * kp + 1][2], S[2 * kp + 1][3]); \
            oacc0 = MFMA16(__builtin_bit_cast(bf16x8, qa0[kp]), bS, oacc0); oacc1 = MFMA16(__builtin_bit_cast(bf16x8, qa1[kp]), bS, oacc1); } \
        __builtin_amdgcn_sched_barrier(0); \
        _Pragma("unroll") for (int kt = 0; kt < 4; ++kt) { kb[kt] = *(const bf16x8*)(kdT_ + (16 * (kt + 4) + fr) * 40 + 8 * fq); e5[kt] = *(const f32x4*)(eL_ + 16 * (kt + 4) + 4 * fq); } \
        _Pragma("unroll") for (int kt = 0; kt < 4; ++kt) { S[kt] = S[kt] * e4[kt]; S[kt] = MFMA16(ka[kt], bv, S[kt]); } \
        _Pragma("unroll") for (int kt = 0; kt < 4; ++kt) { S[kt + 4] = S[kt + 4] * e5[kt]; S[kt + 4] = MFMA16(kb[kt], bv, S[kt + 4]); } \
        gOW[(size_t)(chn_) * 1024] = oacc0; gOW[(size_t)(chn_) * 1024 + 64] = oacc1; \
        if ((chn_) + 1 < 128) { HG_LSTORE(stn_, buf_ ^ 1); oc0 = stn_.o0; oc1 = stn_.o1; } \
        if ((chn_) + 3 < 128) HG_GLOAD(stn_, (chn_) + 3); \
        asm volatile("s_waitcnt lgkmcnt(0)" ::: "memory"); __builtin_amdgcn_s_barrier(); asm volatile("" ::: "memory"); \
    } while (0)
#pragma unroll 1
    for (int chn = 0; chn < 128; chn += 2) {
        HG_BODY(chn, sa);
        HG_BODY(chn + 1, sb);
    }
#undef HG_BODY
#undef HG_GLOAD
#undef HG_LSTORE
    __syncthreads();
}

__device__ __forceinline__ void hgpost_range(const Params& p, unsigned char* smem) {
    const int tid = opaque_tid(), w = tid >> 6, lane = tid & 63, fr = lane & 15, fq = lane >> 4;
    float* red = (float*)smem;
    bf16_t* Yb = (bf16_t*)(p.ws + OFF_XB);
    int item = blockIdx.x;
    f32x4 o0, o1, g0, g1;
#define HPO_LOAD(item_) do { const f32x4* a_ = (const f32x4*)((unsigned char*)p.out + OUT_OI) + (size_t)(item_) * 1024 + w * 128 + lane; const f32x4* b_ = (const f32x4*)(p.ws + OFF_HGS) + (size_t)(item_) * 1024 + w * 128 + lane; \
        o0 = a_[0]; o1 = a_[64]; g0 = b_[0]; g1 = b_[64]; } while (0)
    if (item < 2048) HPO_LOAD(item);
    int par = 0;
#pragma unroll 1
    for (; item < 2048; item += gridDim.x, par ^= 1) {
        const int bh = item >> 7, chn = item & 127;
        const f32x4 c0 = o0, c1 = o1, h0 = g0, h1 = g1;
        if (item + (int)gridDim.x < 2048) HPO_LOAD(item + (int)gridDim.x);
#pragma unroll
        for (int j = 0; j < 4; ++j) { const float s0 = row16_sum_to15(c0[j] * c0[j]), s1 = row16_sum_to15(c1[j] * c1[j]);
            if (fr == 15) { red[par * 256 + (4 * fq + j) * 8 + w] = s0; red[par * 256 + (16 + 4 * fq + j) * 8 + w] = s1; } }
        lds_barrier();
        bf16_t* Y = Yb + ((size_t)(bh >> 2) * SEQ + chn * 32) * DM + 1536 + (bh & 3) * 128 + 16 * w + fr;
#pragma unroll
        for (int j = 0; j < 4; ++j) {
            { const int t = 4 * fq + j; const f32x4 r0 = *(const f32x4*)(red + par * 256 + t * 8), r1 = *(const f32x4*)(red + par * 256 + t * 8 + 4);
              const float ss = ((r0[0] + r0[1]) + (r0[2] + r0[3])) + ((r1[0] + r1[1]) + (r1[2] + r1[3])); const float rs = rsqrtf(ss * (1.0f / 128.0f) + LN_EPS);
              Y[(size_t)t * DM] = f2bf(c0[j] * rs * h0[j]); }
            { const int t = 16 + 4 * fq + j; const f32x4 r0 = *(const f32x4*)(red + par * 256 + t * 8), r1 = *(const f32x4*)(red + par * 256 + t * 8 + 4);
              const float ss = ((r0[0] + r0[1]) + (r0[2] + r0[3])) + ((r1[0] + r1[1]) + (r1[2] + r1[3])); const float rs = rsqrtf(ss * (1.0f / 128.0f) + LN_EPS);
              Y[(size_t)t * DM] = f2bf(c1[j] * rs * h1[j]); }
        }
    }
#undef HPO_LOAD
    lds_barrier();
}

#define PH_NOINLINE __forceinline__
__device__ PH_NOINLINE void gemm_gu(const bf16_t* A, const bf16_t* Bt, bf16_t* H) {
    extern __shared__ __attribute__((aligned(16))) unsigned char smem[];
    pg8::Gemm g{A, Bt, NTOK, 11264, 2048}; pg8::StaticOrder S; S.init(NTOK, 11264, (int)gridDim.x, (int)blockIdx.x); EpiSwiGLU E{H};
    pg8::gemm_phase((PG8_LAS unsigned char*)smem, g, S, E);
}
__device__ PH_NOINLINE void gemm_res(const bf16_t* A, const bf16_t* Bt, int K, unsigned char* ws, const float* Rraw, float* Oalt, float s) {
    extern __shared__ __attribute__((aligned(16))) unsigned char smem[];
    pg8::Gemm g{A, Bt, NTOK, 2048, K}; pg8::StaticOrder S; S.init(NTOK, 2048, (int)gridDim.x, (int)blockIdx.x); EpiResid E{ws, Rraw, Oalt, s};
    pg8::gemm_phase((PG8_LAS unsigned char*)smem, g, S, E);
}
__device__ PH_NOINLINE void gemm_in(const bf16_t* A, const bf16_t* Bt, bf16_t* O) {
    extern __shared__ __attribute__((aligned(16))) unsigned char smem[];
    pg8::Gemm g{A, Bt, NTOK, 5632, 2048}; pg8::StaticOrder S; S.init(NTOK, 5632, (int)gridDim.x, (int)blockIdx.x); EpiBf16P E{O, DIN};
    pg8::gemm_phase((PG8_LAS unsigned char*)smem, g, S, E);
}
__device__ __forceinline__ void run_phase(const Params& p, int ph, unsigned char* smem, int rep) {
    if (ph == 0) { phase_convert(p, smem); return; }
    const int l = (ph - 1) / 12, k = (ph - 1) % 12;
    bf16_t* XB = (bf16_t*)(p.ws + OFF_XB); bf16_t* H = (bf16_t*)(p.ws + OFF_H); float* X = (float*)(p.ws + OFF_X); float* STATS = (float*)(p.ws + OFF_STATS);
    if (k == 0 || k == 9) {
        const int f = (k == 9);
        gemm_gu(XB, (const bf16_t*)(p.ws + OFF_GU + (size_t)(l * 2 + f) * SZ_GU), H);
    } else if (k == 1 || k == 10) {
        const int f = (k == 10);
        gemm_res(H, (const bf16_t*)(p.ws + OFF_DN + (size_t)(l * 2 + f) * SZ_DN), 5632, p.ws, (l == 0 && f == 0) ? p.in[0] : nullptr, rep ? p.out : nullptr, 0.5f);
    } else if (k == 2 || k == 8 || k == 11) {
        const int i = (k == 2) ? 0 : (k == 8 ? 1 : 2);
        const bool last = (l == 1 && i == 2);
        if (rep) { phase_ln((const bf16_t*)X, nullptr, H, (float*)(p.ws + OFF_HGS), nullptr, p.in[1] + (size_t)(l * 3 + i) * DM, p.in[2] + (size_t)(l * 3 + i) * DM); return; }
        phase_ln((const bf16_t*)X, last ? p.out : nullptr, last ? nullptr : XB, last ? nullptr : STATS, last ? nullptr : (float*)(p.ws + OFF_GB), p.in[1] + (size_t)(l * 3 + i) * DM, p.in[2] + (size_t)(l * 3 + i) * DM);
    } else if (k == 3) {
        gemm_in(XB, (const bf16_t*)(p.ws + OFF_IN + (size_t)l * SZ_IN), H);
    } else if (k == 4) {
#ifndef PROBE_SUB4
#define PROBE_SUB4 0
#endif
        if (rep == 0 || PROBE_SUB4 == 0 || PROBE_SUB4 == 1) hgpre_range(p, l, smem);
        if (rep == 0 || PROBE_SUB4 == 0 || PROBE_SUB4 == 4) rgpre_range(p, l, smem);
        for (int it = blockIdx.x; it < 768; it += gridDim.x) {
            if (it < 256) { if (rep == 0 || PROBE_SUB4 == 0 || PROBE_SUB4 == 2) kvpre_item(p, it, smem); }
            else { if (rep == 0 || PROBE_SUB4 == 0 || PROBE_SUB4 == 3) convc_item(p, l, it - 256, smem); }
        }
    } else if (k == 5) {
        unsigned* ctr = (unsigned*)(p.ws + OFF_CTL) + l * 64 + rep * 128;
        int* s_item = (int*)(smem + LDS_BYTES - 16);
        for (;;) {
            __syncthreads();
            if (threadIdx.x == 0) *s_item = (int)atomicAdd(ctr, 1u);
            __syncthreads();
            const int it = *s_item;
            if (it >= 784) break;
#ifdef PROBE_SUB
            if (rep == 1 && !((PROBE_SUB == 1 && it < 16) || (PROBE_SUB == 2 && it >= 16 && it < 528) || (PROBE_SUB == 3 && it >= 528) || (PROBE_SUB == 4 && it >= 16))) continue;
#endif
            if (it < 16) hgrn_item(p, l, it, smem, rep);
            else if (it < 528) attn_item(p, it - 16, smem);
            else rgpost_item(p, it - 528, smem);
        }
    } else if (k == 6) {
        hgpost_range(p, smem);
    } else if (k == 7) {
        gemm_res(XB, (const bf16_t*)(p.ws + OFF_OUT + (size_t)l * SZ_OUT), 2048, p.ws, nullptr, nullptr, 1.0f);
    }
}

#ifndef MK_N_LAUNCHES
#define MK_N_LAUNCHES 1
#endif

#define XB_TMO      128
#define XB_XCNT(j)  (256  + 64 * (j))
#define XB_XSUB(j)  (1280 + 64 * (j))
#define XB_XGEN(j)  (2304 + 64 * (j))
#define XB_TOP      3328
#define XB_TOPGEN   3392
#define XCD_BAR_WORDS 3456
#define XB_SPIN_CAP (1u << 18)
#define LAS __attribute__((address_space(3)))

__device__ __forceinline__ unsigned xb_ld(unsigned* p)              { return __hip_atomic_load(p, __ATOMIC_RELAXED, __HIP_MEMORY_SCOPE_AGENT); }
__device__ __forceinline__ unsigned xb_add(unsigned* p, unsigned v) { return __hip_atomic_fetch_add(p, v, __ATOMIC_RELAXED, __HIP_MEMORY_SCOPE_AGENT); }
__device__ __forceinline__ unsigned xb_xcc_id() { return (unsigned)__builtin_amdgcn_s_getreg((3 << 11) | 20) & 0xFu; }
#define XB_SPIN(cond, bar) do { unsigned _sp = 0; while (cond) { __builtin_amdgcn_s_sleep(1); \
    if ((++_sp & 255u) == 0u) { if (xb_ld(&(bar)[XB_TMO])) break; if (_sp > XB_SPIN_CAP) { atomicAdd(&(bar)[XB_TMO], 1u); break; } } } } while (0)

struct XcdBarrier {
    unsigned* bar; unsigned x;
    volatile LAS unsigned* st;
};

__device__ __forceinline__ XcdBarrier xcd_barrier_post(unsigned* bar, volatile LAS unsigned* st) {
    XcdBarrier b; b.bar = bar; b.x = xb_xcc_id(); b.st = st;
    if (threadIdx.x == 0) (void)xb_add(&bar[XB_XCNT(b.x)], 1u);
    return b;
}
__device__ __forceinline__ void xcd_barrier_complete(unsigned* bar, unsigned x, unsigned& nloc, unsigned& nx) {
    const unsigned G = gridDim.x * gridDim.y * gridDim.z;
    unsigned sum, cnt, mine, sp = 0u;
    for (;;) {
        sum = 0u; cnt = 0u; mine = 0u;
#pragma unroll
        for (unsigned j = 0; j < 16; ++j) { const unsigned c = xb_ld(&bar[XB_XCNT(j)]); sum += c; cnt += (c > 0u) ? 1u : 0u; mine = (j == x) ? c : mine; }
        if (sum == G) break;
        __builtin_amdgcn_s_sleep(1);
        if ((++sp & 255u) == 0u) { if (xb_ld(&bar[XB_TMO])) break; if (sp > XB_SPIN_CAP) { atomicAdd(&bar[XB_TMO], 1u); break; } }
    }
    nloc = mine > 0u ? mine : 1u; nx = cnt > 0u ? cnt : 1u;
}

__device__ __forceinline__ void xcd_barrier(const XcdBarrier& b) {
    asm volatile("s_waitcnt vmcnt(0)" ::: "memory");
    __syncthreads();
    if (threadIdx.x == 0) {
        unsigned* bar = b.bar;
        __builtin_amdgcn_s_waitcnt(0);
        unsigned nloc = b.st[0], nx = b.st[1];
        if (nloc == 0u) { xcd_barrier_complete(bar, b.x, nloc, nx); b.st[0] = nloc; b.st[1] = nx; }
        const unsigned old = xb_add(&bar[XB_XSUB(b.x)], 1u);
        const unsigned gen = old / nloc;
        if (old + 1u == (gen + 1u) * nloc) {
            __builtin_amdgcn_fence(__ATOMIC_RELEASE, "agent");
            asm volatile("s_waitcnt vmcnt(0)" ::: "memory");
            const unsigned og = xb_add(&bar[XB_TOP], 1u);
            const unsigned tg = og / nx;
            if (og + 1u == (tg + 1u) * nx) xb_add(&bar[XB_TOPGEN], 1u);
            else XB_SPIN(xb_ld(&bar[XB_TOPGEN]) == tg, bar);
            __builtin_amdgcn_fence(__ATOMIC_ACQUIRE, "agent");
            xb_add(&bar[XB_XGEN(b.x)], 1u);
            asm volatile("s_waitcnt vmcnt(0)" ::: "memory");
        } else {
            XB_SPIN(xb_ld(&bar[XB_XGEN(b.x)]) == gen, bar);
            __builtin_amdgcn_fence(__ATOMIC_ACQUIRE, "agent");
            asm volatile("s_waitcnt vmcnt(0)" ::: "memory");
        }
    }
    __syncthreads();
}

#ifndef PROBE_DUP
#define PROBE_DUP -1
#endif

__global__ void __launch_bounds__(512, 2) mega_fwd(Params p) {
    extern __shared__ __attribute__((aligned(16))) unsigned char smem[];
    volatile LAS unsigned* st = (volatile LAS unsigned*)(LAS unsigned char*)(smem + LDS_BYTES - 32);
    if (threadIdx.x == 0) { st[0] = 0u; st[1] = 0u; }
    __syncthreads();
    const XcdBarrier xb = xcd_barrier_post((unsigned*)(p.ws + OFF_CTL) + 1024, st);
    for (int ph = p.ph_lo; ph < p.ph_hi; ++ph) {
        if (ph > p.ph_lo) {
            if (p.ph_lo < 0) cg::this_grid().sync();
            xcd_barrier(xb);
        }
        run_phase(p, ph, smem, 0);
        if (PROBE_DUP >= 0 && (ph == 0 ? PROBE_DUP == 100 : (((ph - 1) % 12) == PROBE_DUP && (PROBE_DUP != 5 || ph > 12)))) {
            xcd_barrier(xb);
            run_phase(p, ph, smem, 1);
        }
    }
}

extern "C" void kernel_launch(void* const* d_in, const int* in_sizes, int n_in, void* d_out, int out_size, void* d_ws, size_t ws_size, hipStream_t stream) {
    static int grid = 0;
    if (grid == 0) {
        if (n_in != 21 || ws_size < WS_END) { fprintf(stderr, "kernel_launch: unexpected n_in %d / ws_size %zu (need %zu)\n", n_in, ws_size, (size_t)WS_END); grid = -1; return; }
        int dev = 0, cus = 0, per_cu = 0;
        (void)hipGetDevice(&dev);
        (void)hipDeviceGetAttribute(&cus, hipDeviceAttributeMultiprocessorCount, dev);
        if (hipFuncSetAttribute((const void*)mega_fwd, hipFuncAttributeMaxDynamicSharedMemorySize, LDS_BYTES) != hipSuccess) { fprintf(stderr, "kernel_launch: hipFuncSetAttribute failed\n"); grid = -1; return; }
        if (hipOccupancyMaxActiveBlocksPerMultiprocessor(&per_cu, (const void*)mega_fwd, 512, LDS_BYTES) != hipSuccess || per_cu < 1) { fprintf(stderr, "kernel_launch: occupancy query says %d\n", per_cu); per_cu = 1; }
        (void)hipGetLastError();
        grid = cus * per_cu;
        fprintf(stderr, "kernel_launch: grid %d (cus %d x %d)\n", grid, cus, per_cu);
    }
    if (grid < 0) return;
    (void)in_sizes; (void)out_size;
    (void)hipMemsetAsync((char*)d_ws + OFF_CTL, 0, CTL_BYTES, stream);
    Params p{};
    for (int i = 0; i < 21; ++i) p.in[i] = (const float*)d_in[i];
    p.out = (float*)d_out; p.ws = (unsigned char*)d_ws;
#if MK_N_LAUNCHES == 1
    p.ph_lo = 0; p.ph_hi = NPHASE;
    void* args[] = {&p};
    hipError_t e = hipLaunchCooperativeKernel((const void*)mega_fwd, dim3(grid), dim3(512), args, LDS_BYTES, stream);
    if (e != hipSuccess) fprintf(stderr, "kernel_launch: cooperative launch failed: %s (grid %d)\n", hipGetErrorString(e), grid);
#else
    for (int ph = 0; ph < NPHASE; ++ph) {
        p.ph_lo = ph; p.ph_hi = ph + 1;
        hipLaunchKernelGGL(mega_fwd, dim3(grid), dim3(512), LDS_BYTES, stream, p);
    }
#endif
}
```
